# Optimizing an MI355X kernel written in HIP

```python
import jax, jax.numpy as jnp
from jax import lax
import numpy as np

D_MODEL = 4096
BATCH = 4
SEQ = 4096
DEPTH = 1

HEAD_DIM = 128
MLA_HEADS = 16
MLA_Q_RANK = 1024
MLA_KV_RANK = 512
MLA_NOPE = 128
MLA_ROPE = 64
MLA_V = 128
DIL_HEADS = 8
DIL_PATTERNS = ((128, 1), (512, 4), (2048, 16))
DIL_GROUPS = len(DIL_PATTERNS)
N_BRANCHES = 2
D_FF = -(-8 * D_MODEL // (3 * 256)) * 256
ROPE_THETA = 10000.0
NORM_EPS = 1e-6
Q_BLOCK = 128
N_MOD = 6

IN_Q = MLA_Q_RANK
IN_KV = MLA_KV_RANK
IN_KR = MLA_ROPE
IN_DIL = 3 * DIL_GROUPS * DIL_HEADS * HEAD_DIM
IN_GATE = N_BRANCHES * D_MODEL
IN_TOTAL = IN_Q + IN_KV + IN_KR + IN_DIL + IN_GATE
IN_SPLITS = (IN_Q, IN_Q + IN_KV, IN_Q + IN_KV + IN_KR, IN_Q + IN_KV + IN_KR + IN_DIL)

kernel_name = 'hybrid_mla_dilated_adaln_block'


def rmsnorm(x, g):
    xf = x.astype(jnp.float32)
    y = xf * lax.rsqrt(jnp.mean(xf * xf, axis=-1, keepdims=True) + NORM_EPS)
    return (y * g.astype(jnp.float32)).astype(x.dtype)


def modulate(h, shift, scale):
    return h * (1 + scale[:, None, :]) + shift[:, None, :]


def rope_tables(positions, dim):
    inv = ROPE_THETA ** (-jnp.arange(0, dim, 2, dtype=jnp.float32) / dim)
    ang = positions.astype(jnp.float32)[..., None] * inv
    return jnp.cos(ang), jnp.sin(ang)


def apply_rope(x, cos, sin):
    half = x.shape[-1] // 2
    shp = cos.shape[:2] + (1,) * (x.ndim - 3) + (half,)
    cos = cos.reshape(shp).astype(x.dtype)
    sin = sin.reshape(shp).astype(x.dtype)
    x1, x2 = x[..., :half], x[..., half:]
    return jnp.concatenate([x1 * cos - x2 * sin, x2 * cos + x1 * sin], axis=-1)


def mla_attention(q_nope, q_rope, k_nope, k_rope, v):
    B, S, H, _ = q_nope.shape
    scale = (MLA_NOPE + MLA_ROPE) ** -0.5

    def block(i):
        start = i * Q_BLOCK
        qn = lax.dynamic_slice_in_dim(q_nope, start, Q_BLOCK, axis=1)
        qr = lax.dynamic_slice_in_dim(q_rope, start, Q_BLOCK, axis=1)
        s = (jnp.einsum('bqhd,bkhd->bhqk', qn, k_nope)
             + jnp.einsum('bqhr,bkr->bhqk', qr, k_rope)).astype(jnp.float32) * scale
        p = jax.nn.softmax(s, axis=-1)
        return jnp.einsum('bhqk,bkhd->bqhd', p.astype(v.dtype), v)

    out = lax.map(block, jnp.arange(S // Q_BLOCK))
    return out.transpose(1, 0, 2, 3, 4).reshape(B, S, H * MLA_V)


def dilated_attention(q, k, v):
    B, S, G, H, dh = q.shape
    scale = dh ** -0.5

    def block(i):
        start = i * Q_BLOCK
        qpos = start + jnp.arange(Q_BLOCK)
        qb = lax.dynamic_slice_in_dim(q, start, Q_BLOCK, axis=1)
        ms, ls, nums = [], [], []
        for g, (w, d) in enumerate(DIL_PATTERNS):
            n_side = w // (2 * d)
            offs = jnp.arange(-n_side, n_side + 1) * d
            idx = qpos[:, None] + offs[None, :]
            valid = (idx >= 0) & (idx < S)
            idx = jnp.clip(idx, 0, S - 1)
            kg = jnp.take(k[:, :, g], idx, axis=1)
            vg = jnp.take(v[:, :, g], idx, axis=1)
            s = jnp.einsum('bqhd,bqkhd->bhqk', qb[:, :, g], kg).astype(jnp.float32) * scale
            s = jnp.where(valid[None, None], s, -jnp.inf)
            m = jnp.max(s, axis=-1)
            p = jnp.exp(s - m[..., None])
            ms.append(m)
            ls.append(jnp.sum(p, axis=-1))
            nums.append(jnp.einsum('bhqk,bqkhd->bhqd', p, vg.astype(jnp.float32)))
        m_all = jnp.stack(ms)
        wts = jnp.exp(m_all - jnp.max(m_all, axis=0))
        den = jnp.sum(wts * jnp.stack(ls), axis=0)
        num = jnp.sum(wts[..., None] * jnp.stack(nums), axis=0)
        return (num / den[..., None]).astype(q.dtype)

    out = lax.map(block, jnp.arange(S // Q_BLOCK))
    return out.transpose(1, 0, 3, 2, 4).reshape(B, S, H * dh)


def setup_inputs(seed: int = 0) -> dict:
    key = jax.random.key(seed)
    ks = jax.random.split(key, 24)

    def nrm(k, shape, fan_in):
        return jax.random.normal(k, shape, jnp.float32) * (fan_in ** -0.5)

    def gain(k, shape):
        return 1.0 + 0.02 * jax.random.normal(k, shape, jnp.float32)

    L = DEPTH
    return {
        'x': jax.random.normal(ks[0], (BATCH, SEQ, D_MODEL), jnp.float32),
        'c': jax.random.normal(ks[1], (BATCH, D_MODEL), jnp.float32),
        'positions': jnp.broadcast_to(jnp.arange(SEQ, dtype=jnp.int32), (BATCH, SEQ)),
        'w_ada': nrm(ks[2], (L, D_MODEL, N_MOD * D_MODEL), D_MODEL),
        'b_ada': 0.02 * jax.random.normal(ks[3], (L, N_MOD * D_MODEL), jnp.float32),
        'norm1_g': gain(ks[4], (L, D_MODEL)),
        'w_in': nrm(ks[5], (L, D_MODEL, IN_TOTAL), D_MODEL),
        'q_norm_g': gain(ks[6], (L, MLA_Q_RANK)),
        'w_uq': nrm(ks[7], (L, MLA_Q_RANK, MLA_HEADS * (MLA_NOPE + MLA_ROPE)), MLA_Q_RANK),
        'kv_norm_g': gain(ks[8], (L, MLA_KV_RANK)),
        'w_ukv': nrm(ks[9], (L, MLA_KV_RANK, MLA_HEADS * (MLA_NOPE + MLA_V)), MLA_KV_RANK),
        'w_proj_a': nrm(ks[10], (L, MLA_HEADS * MLA_V, D_MODEL), MLA_HEADS * MLA_V),
        'w_proj_b': nrm(ks[11], (L, DIL_HEADS * HEAD_DIM, D_MODEL), DIL_HEADS * HEAD_DIM),
        'w_out': nrm(ks[12], (L, D_MODEL, D_MODEL), D_MODEL),
        'norm2_g': gain(ks[13], (L, D_MODEL)),
        'w_gate': nrm(ks[14], (L, D_MODEL, D_FF), D_MODEL),
        'w_up': nrm(ks[15], (L, D_MODEL, D_FF), D_MODEL),
        'w_down': nrm(ks[16], (L, D_FF, D_MODEL), D_FF),
        'final_g': gain(ks[17], (D_MODEL,)),
    }


def reference(x, c, positions, w_ada, b_ada, norm1_g, w_in, q_norm_g, w_uq, kv_norm_g,
              w_ukv, w_proj_a, w_proj_b, w_out, norm2_g, w_gate, w_up, w_down, final_g):
    B, S, D = x.shape
    cos_f, sin_f = rope_tables(positions, HEAD_DIM)
    cos_r, sin_r = rope_tables(positions, MLA_ROPE)
    c_act = jax.nn.silu(c)

    for l in range(DEPTH):
        mod = c_act @ w_ada[l] + b_ada[l]
        sh1, sc1, g1, sh2, sc2, g2 = jnp.split(mod, N_MOD, axis=-1)

        h = modulate(rmsnorm(x, norm1_g[l]), sh1, sc1)
        z = h @ w_in[l]
        zq, zkv, zkr, zdil, zg = jnp.split(z, IN_SPLITS, axis=-1)

        q = (rmsnorm(zq, q_norm_g[l]) @ w_uq[l]).reshape(B, S, MLA_HEADS, MLA_NOPE + MLA_ROPE)
        q_nope = q[..., :MLA_NOPE]
        q_rope = apply_rope(q[..., MLA_NOPE:], cos_r, sin_r)
        kv = (rmsnorm(zkv, kv_norm_g[l]) @ w_ukv[l]).reshape(B, S, MLA_HEADS, MLA_NOPE + MLA_V)
        k_nope, v_a = kv[..., :MLA_NOPE], kv[..., MLA_NOPE:]
        k_rope = apply_rope(zkr[:, :, None, :], cos_r, sin_r)[:, :, 0, :]
        y_a = mla_attention(q_nope, q_rope, k_nope, k_rope, v_a)

        zd = zdil.reshape(B, S, 3, DIL_GROUPS, DIL_HEADS, HEAD_DIM)
        q_d = apply_rope(zd[:, :, 0], cos_f, sin_f)
        k_d = apply_rope(zd[:, :, 1], cos_f, sin_f)
        y_b = dilated_attention(q_d, k_d, zd[:, :, 2])

        gate_a, gate_b = jnp.split(jax.nn.sigmoid(zg), N_BRANCHES, axis=-1)
        mixed = gate_a * (y_a @ w_proj_a[l]) + gate_b * (y_b @ w_proj_b[l])
        x = x + g1[:, None, :] * (mixed @ w_out[l])

        h2 = modulate(rmsnorm(x, norm2_g[l]), sh2, sc2)
        ff = (jax.nn.silu(h2 @ w_gate[l]) * (h2 @ w_up[l])) @ w_down[l]
        x = x + g2[:, None, :] * ff

    return rmsnorm(x, final_g)
```

```cpp
#include <hip/hip_runtime.h>
#define MK_N_LAUNCHES 14
#include <cstdio>
#include <cstdint>
namespace pg8 {
#define PG8_LAS __attribute__((address_space(3)))
typedef unsigned short bf16_t;
typedef short bf16x8 __attribute__((ext_vector_type(8)));
typedef float f32x4 __attribute__((ext_vector_type(4)));
typedef unsigned u32x4 __attribute__((ext_vector_type(4)));
constexpr int BM = 256, BK = 64, HALF = 128, HTB = HALF * BK * 2  , STAGE_BYTES = 8 * HTB, NXCD = 8, WGM = 8;

__host__ __device__ __forceinline__ int lds_byte(int r, int c) { const int st = (r >> 4) * 2 + (c >> 5), rr = r & 15, cc = c & 31, ob = rr * 64 + cc * 2; return st * 1024 + (ob ^ (((ob >> 9) & 1) << 5)); }
__host__ __device__ __forceinline__ void stage_rc(int b, int& R, int& C) { const int st = b / 1024, sb = b % 1024, swz = sb ^ (((sb >> 9) & 1) << 5); R = (st >> 1) * 16 + swz / 64; C = (st & 1) * 32 + (swz % 64) / 2; }
__host__ __device__ __forceinline__ int perm32(int rho) { const int n = rho >> 4, i = rho & 15; return 8 * (i >> 2) + 4 * n + (i & 3); }

struct Unit { int pm, pn; };
struct Gemm { const bf16_t* A; const bf16_t* Bt; int M, N, K; };

struct StaticOrder {
    int nM, nN, nwg, G, c;
    __host__ __device__ void init(int M, int N, int G_, int c_) { nM = M / BM; nN = N / BM; nwg = nM * nN; G = G_; c = c_; }
    __host__ __device__ bool next(int i, Unit& u) const {
        const long L = (long)i * G + c; if (L >= nwg) return false;
        int wgid = (int)L; { const int q = nwg / NXCD, r = nwg % NXCD, xcd = wgid % NXCD, off = wgid / NXCD; wgid = (xcd < r ? xcd * (q + 1) : r * (q + 1) + (xcd - r) * q) + off; }
        const int nig = WGM * nN, gid = wgid / nig, fm = gid * WGM, gsz = (nM - fm) < WGM ? (nM - fm) : WGM;
        u.pm = fm + ((wgid % nig) % gsz); u.pn = (wgid % nig) / gsz; return true;
    }
    __device__ __forceinline__ void a_ready(const Unit&) const {}
    __device__ __forceinline__ void done(const Unit&) const {}
};

__device__ __forceinline__ unsigned cvt_pk_bf16(float lo, float hi) { unsigned r; asm volatile("v_cvt_pk_bf16_f32 %0, %1, %2" : "=v"(r) : "v"(lo), "v"(hi)); return r; }
__device__ __forceinline__ float bf_lo(unsigned w) { return __uint_as_float(w << 16); }
__device__ __forceinline__ float bf_hi(unsigned w) { return __uint_as_float(w & 0xffff0000u); }
__device__ __forceinline__ float sigmoid_f(float x) { return __builtin_amdgcn_rcpf(1.0f + __builtin_amdgcn_exp2f(-1.4426950408889634f * x)); }
__device__ __forceinline__ f32x4 sigmoid4(f32x4 v) { return (f32x4){sigmoid_f(v[0]), sigmoid_f(v[1]), sigmoid_f(v[2]), sigmoid_f(v[3])}; }
__device__ __forceinline__ void st8(bf16_t* p, f32x4 v0, f32x4 v1) { u32x4 w; w.x = cvt_pk_bf16(v0[0], v0[1]); w.y = cvt_pk_bf16(v0[2], v0[3]); w.z = cvt_pk_bf16(v1[0], v1[1]); w.w = cvt_pk_bf16(v1[2], v1[3]); *(u32x4*)p = w; }
__device__ __forceinline__ f32x4 bf4_lo(u32x4 g) { return (f32x4){bf_lo(g.x), bf_hi(g.x), bf_lo(g.y), bf_hi(g.y)}; }
__device__ __forceinline__ f32x4 bf4_hi(u32x4 g) { return (f32x4){bf_lo(g.z), bf_hi(g.z), bf_lo(g.w), bf_hi(g.w)}; }

struct EpiZ {
    static constexpr bool PERM = true, AFTER_DRAIN = false;
    bf16_t *ZQ, *ZKV, *QD, *KD, *VD, *GA, *GB, *ZKR; const float *cosF, *sinF;
    __device__ __forceinline__ void operator()(const f32x4 (&acc)[2][2][4][2], const Unit& u, int wr, int wc, int fr, int fq) const {
        const int pn = u.pn, row0 = u.pm * BM + wr * 64 + fr, j0 = wc * 32 + 8 * fq;
        if (pn >= 6 && pn < 30) {
            const int t = (pn - 6) / 12, tt = (pn - 6) % 12, i0 = (wc & 1) * 32 + 8 * fq;
            bf16_t* base = (t ? KD : QD) + (2 * tt + (wc >> 1)) * 128 + i0;
#pragma unroll
            for (int ai = 0; ai < 2; ++ai)
#pragma unroll
                for (int m = 0; m < 4; ++m) { const int row = row0 + ai * HALF + m * 16;
                    const float* cp = cosF + (size_t)row * 64 + i0; const float* sp = sinF + (size_t)row * 64 + i0;
                    const f32x4 c0 = *(const f32x4*)cp, c1 = *(const f32x4*)(cp + 4), s0 = *(const f32x4*)sp, s1 = *(const f32x4*)(sp + 4);
                    const f32x4 x10 = acc[ai][0][m][0], x11 = acc[ai][0][m][1], x20 = acc[ai][1][m][0], x21 = acc[ai][1][m][1];
                    bf16_t* rp = base + (size_t)row * 3072;
                    st8(rp, x10 * c0 - x20 * s0, x11 * c1 - x21 * s1); st8(rp + 64, x20 * c0 + x10 * s0, x21 * c1 + x11 * s1); }
        } else {
            bf16_t* base; int ld; bool sig = false;
            if (pn < 4) { base = ZQ + pn * 256; ld = 1024; }
            else if (pn < 6) { base = ZKV + (pn - 4) * 256; ld = 512; }
            else if (pn < 42) { base = VD + (pn - 30) * 256; ld = 3072; }
            else if (pn < 74) { const int gi = pn - 42; base = (gi < 16 ? GA : GB) + (gi & 15) * 256; ld = 4096; sig = true; }
            else { base = ZKR; ld = 256; }
            base += j0;
#pragma unroll
            for (int ai = 0; ai < 2; ++ai)
#pragma unroll
                for (int m = 0; m < 4; ++m) { bf16_t* rp = base + (size_t)(row0 + ai * HALF + m * 16) * ld;
#pragma unroll
                    for (int bj = 0; bj < 2; ++bj) { f32x4 v0 = acc[ai][bj][m][0], v1 = acc[ai][bj][m][1];
                        if (sig) { v0 = sigmoid4(v0); v1 = sigmoid4(v1); }
                        st8(rp + bj * HALF, v0, v1); } }
        }
    }
};
struct EpiQ {
    static constexpr bool PERM = true, AFTER_DRAIN = false;
    bf16_t* Q; const float *cosR, *sinR;
    __device__ __forceinline__ void operator()(const f32x4 (&acc)[2][2][4][2], const Unit& u, int wr, int wc, int fr, int fq) const {
        const int pn = u.pn, row0 = u.pm * BM + wr * 64 + fr;
        if (pn >= 8) {
            const int head = 4 * (pn - 8) + wc, i0 = 8 * fq;
            bf16_t* base = Q + head * 192 + 128 + i0;
#pragma unroll
            for (int ai = 0; ai < 2; ++ai)
#pragma unroll
                for (int m = 0; m < 4; ++m) { const int row = row0 + ai * HALF + m * 16;
                    const float* cp = cosR + (size_t)row * 32 + i0; const float* sp = sinR + (size_t)row * 32 + i0;
                    const f32x4 c0 = *(const f32x4*)cp, c1 = *(const f32x4*)(cp + 4), s0 = *(const f32x4*)sp, s1 = *(const f32x4*)(sp + 4);
                    const f32x4 x10 = acc[ai][0][m][0], x11 = acc[ai][0][m][1], x20 = acc[ai][1][m][0], x21 = acc[ai][1][m][1];
                    bf16_t* rp = base + (size_t)row * 3072;
                    st8(rp, x10 * c0 - x20 * s0, x11 * c1 - x21 * s1); st8(rp + 32, x20 * c0 + x10 * s0, x21 * c1 + x11 * s1); }
        } else {
            bf16_t* base = Q + (2 * pn) * 192 + wc * 32 + 8 * fq;
#pragma unroll
            for (int ai = 0; ai < 2; ++ai)
#pragma unroll
                for (int m = 0; m < 4; ++m) { bf16_t* rp = base + (size_t)(row0 + ai * HALF + m * 16) * 3072;
#pragma unroll
                    for (int bj = 0; bj < 2; ++bj) st8(rp + bj * 192, acc[ai][bj][m][0], acc[ai][bj][m][1]); }
        }
    }
};
struct EpiRaw {
    static constexpr bool PERM = true, AFTER_DRAIN = false;
    bf16_t* O; int ldc;
    __device__ __forceinline__ void operator()(const f32x4 (&acc)[2][2][4][2], const Unit& u, int wr, int wc, int fr, int fq) const {
        const int row0 = u.pm * BM + wr * 64 + fr; bf16_t* base = O + u.pn * BM + wc * 32 + 8 * fq;
#pragma unroll
        for (int ai = 0; ai < 2; ++ai)
#pragma unroll
            for (int m = 0; m < 4; ++m) { bf16_t* rp = base + (size_t)(row0 + ai * HALF + m * 16) * ldc;
#pragma unroll
                for (int bj = 0; bj < 2; ++bj) st8(rp + bj * HALF, acc[ai][bj][m][0], acc[ai][bj][m][1]); }
    }
};
template <bool FIRST> struct EpiGate {
    static constexpr bool PERM = true, AFTER_DRAIN = false;
    const bf16_t* G; const bf16_t* T; bf16_t* O;
    __device__ __forceinline__ void operator()(const f32x4 (&acc)[2][2][4][2], const Unit& u, int wr, int wc, int fr, int fq) const {
        const int row0 = u.pm * BM + wr * 64 + fr; const size_t c0 = (size_t)u.pn * BM + wc * 32 + 8 * fq;
#pragma unroll
        for (int ai = 0; ai < 2; ++ai)
#pragma unroll
            for (int m = 0; m < 4; ++m) { const size_t ro = (size_t)(row0 + ai * HALF + m * 16) * 4096 + c0;
#pragma unroll
                for (int bj = 0; bj < 2; ++bj) { const size_t p = ro + bj * HALF; const u32x4 g = *(const u32x4*)(G + p);
                    f32x4 v0 = acc[ai][bj][m][0] * bf4_lo(g), v1 = acc[ai][bj][m][1] * bf4_hi(g);
                    if (!FIRST) { const u32x4 t = *(const u32x4*)(T + p); v0 += bf4_lo(t); v1 += bf4_hi(t); }
                    st8(O + p, v0, v1); } }
    }
};
struct EpiRes {
    static constexpr bool PERM = false, AFTER_DRAIN = false;
    const float* base; float* out; const float* gvec;
    __device__ __forceinline__ void operator()(const f32x4 (&acc)[2][2][4][2], const Unit& u, int wr, int wc, int fr, int fq) const {
        const int row0 = u.pm * BM + wr * 64 + fr, col0 = u.pn * BM + wc * 32 + 4 * fq; const float* gb = gvec + (size_t)(u.pm >> 4) * 4096 + col0;
        f32x4 gv[2][2];
#pragma unroll
        for (int bj = 0; bj < 2; ++bj)
#pragma unroll
            for (int n = 0; n < 2; ++n) gv[bj][n] = *(const f32x4*)(gb + bj * HALF + n * 16);
#pragma unroll
        for (int ai = 0; ai < 2; ++ai)
#pragma unroll
            for (int m = 0; m < 4; ++m) { const size_t ro = (size_t)(row0 + ai * HALF + m * 16) * 4096 + col0;
#pragma unroll
                for (int bj = 0; bj < 2; ++bj)
#pragma unroll
                    for (int n = 0; n < 2; ++n) { const size_t p = ro + bj * HALF + n * 16; const f32x4 xv = *(const f32x4*)(base + p); *(f32x4*)(out + p) = xv + gv[bj][n] * acc[ai][bj][m][n]; } }
    }
};
struct EpiGU {
    static constexpr bool PERM = true, AFTER_DRAIN = false;
    bf16_t* A;
    __device__ __forceinline__ void operator()(const f32x4 (&acc)[2][2][4][2], const Unit& u, int wr, int wc, int fr, int fq) const {
        const int row0 = u.pm * BM + wr * 64 + fr; bf16_t* base = A + u.pn * HALF + wc * 32 + 8 * fq;
#pragma unroll
        for (int ai = 0; ai < 2; ++ai)
#pragma unroll
            for (int m = 0; m < 4; ++m) { const f32x4 g0 = acc[ai][0][m][0], g1 = acc[ai][0][m][1], u0 = acc[ai][1][m][0], u1 = acc[ai][1][m][1];
                st8(base + (size_t)(row0 + ai * HALF + m * 16) * 11008, g0 * sigmoid4(g0) * u0, g1 * sigmoid4(g1) * u1); }
    }
};

template <class Epi, class Sched, bool ALIGN_EPI = false, bool SP2 = false>
__device__ __forceinline__ void gemm_phase(PG8_LAS unsigned char* lds, const Gemm g, const Sched& S, const Epi& E) {
    const int tid = threadIdx.x, wid = __builtin_amdgcn_readfirstlane(tid >> 6), lane = tid & 63, wr = wid >> 2, wc = wid & 3, fr = lane & 15, fq = lane >> 4;
    const int K = g.K, nt = K / BK;
    unsigned voffA[2], voffB[2];
#pragma unroll
    for (int i = 0; i < 2; ++i) { int R, C; stage_rc(tid * 16 + i * 8192, R, C); const int Rb = Epi::PERM ? ((R & ~31) + perm32(R & 31)) : R;
        voffA[i] = (unsigned)(R * K + C) * 2u; voffB[i] = (unsigned)(Rb * K + C) * 2u; }
    const size_t kstep = (size_t)(BK * 2);
    const size_t hstep = (size_t)HALF * K * 2;
    const size_t tstep = 2 * hstep;
    const unsigned ldsw = (unsigned)wid * 1024u;
    const int aoff = lds_byte(wr * 64 + fr, fq * 8), boff = lds_byte(wc * 32 + fr, fq * 8);
#define PG8_SA(b, h) (((b) * 2 + (h)) * HTB)
#define PG8_SB(b, h) ((4 + (b) * 2 + (h)) * HTB)
#define PG8_STAGE(bufoff, gbase, voff) do { _Pragma("unroll") for (int _i = 0; _i < 2; ++_i) \
        __builtin_amdgcn_global_load_lds((const unsigned*)((const char*)(gbase) + (voff)[_i]), (PG8_LAS unsigned*)(lds + (bufoff) + ldsw + _i * 8192), 16, 0, 0); } while (0)
#define PG8_LDA(dst, b, h) do { _Pragma("unroll") for (int m = 0; m < 4; ++m) _Pragma("unroll") for (int k = 0; k < 2; ++k) dst[m][k] = *(const PG8_LAS bf16x8*)(lds + PG8_SA(b, h) + aoff + m * 2048 + k * 1024); } while (0)
#define PG8_LDB(dst, b, h) do { _Pragma("unroll") for (int n = 0; n < 2; ++n) _Pragma("unroll") for (int k = 0; k < 2; ++k) dst[n][k] = *(const PG8_LAS bf16x8*)(lds + PG8_SB(b, h) + boff + n * 2048 + k * 1024); } while (0)
#define PG8_MMA(ai, bj, At, Bt) do { __builtin_amdgcn_s_setprio(1); _Pragma("unroll") for (int m = 0; m < 4; ++m) _Pragma("unroll") for (int n = 0; n < 2; ++n) _Pragma("unroll") for (int k = 0; k < 2; ++k) \
        acc[ai][bj][m][n] = __builtin_amdgcn_mfma_f32_16x16x32_bf16(Bt[n][k], At[m][k], acc[ai][bj][m][n], 0, 0, 0); __builtin_amdgcn_s_setprio(0); } while (0)
#define PG8_WAIT_V(n) asm volatile("s_waitcnt vmcnt(" #n ")" ::: "memory")
#define PG8_WAIT_L(n) asm volatile("s_waitcnt lgkmcnt(" #n ")" ::: "memory")
#define PG8_BAR __builtin_amdgcn_s_barrier()
#define PG8_SCHED __builtin_amdgcn_sched_barrier(0)
    Unit cur, nxt; int ui = 0;
    if (!S.next(0, cur)) return;
    f32x4 acc[2][2][4][2];
#pragma unroll
    for (int a = 0; a < 2; ++a)
#pragma unroll
        for (int b = 0; b < 2; ++b)
#pragma unroll
            for (int m = 0; m < 4; ++m)
#pragma unroll
                for (int n = 0; n < 2; ++n) acc[a][b][m][n] = (f32x4){0.f, 0.f, 0.f, 0.f};
    bf16x8 At[4][2], B0[2][2], B1[2][2];
    const char* cA = (const char*)g.A + (size_t)cur.pm * tstep; const char* cB = (const char*)g.Bt + (size_t)cur.pn * tstep;
    S.a_ready(cur);
    if constexpr (SP2) {
        PG8_STAGE(PG8_SB(0, 0), cB, voffB); PG8_STAGE(PG8_SB(0, 1), cB + hstep, voffB); PG8_STAGE(PG8_SA(0, 0), cA, voffA); PG8_STAGE(PG8_SA(0, 1), cA + hstep, voffA);
        if (wr == 1) PG8_BAR;
        PG8_WAIT_V(2); PG8_BAR;
        PG8_STAGE(PG8_SB(1, 0), cB + kstep, voffB); PG8_STAGE(PG8_SA(1, 0), cA + kstep, voffA); PG8_STAGE(PG8_SB(1, 1), cB + hstep + kstep, voffB);
        PG8_WAIT_V(6); PG8_BAR;
    } else {
        PG8_STAGE(PG8_SB(0, 0), cB, voffB); PG8_STAGE(PG8_SA(0, 0), cA, voffA); PG8_STAGE(PG8_SB(0, 1), cB + hstep, voffB); PG8_STAGE(PG8_SA(0, 1), cA + hstep, voffA);
        if (wr == 1) PG8_BAR;
        PG8_WAIT_V(4); PG8_BAR;
        PG8_STAGE(PG8_SB(1, 0), cB + kstep, voffB); PG8_STAGE(PG8_SA(1, 0), cA + kstep, voffA); PG8_STAGE(PG8_SB(1, 1), cB + hstep + kstep, voffB);
        PG8_WAIT_V(6); PG8_BAR;
    }
    for (;;) {
        const bool has_next = S.next(ui + 1, nxt);
        const char* nA = has_next ? (const char*)g.A + (size_t)nxt.pm * tstep : cA; const char* nB = has_next ? (const char*)g.Bt + (size_t)nxt.pn * tstep : cB;
        for (int t = 0; t < nt; t += 2) {
            const bool last = (t == nt - 2);
            const char* a1 = cA + (size_t)(t + 1) * kstep;
            const char* a2 = last ? nA : cA + (size_t)(t + 2) * kstep; const char* b2 = last ? nB : cB + (size_t)(t + 2) * kstep;
            const char* a3 = a2 + kstep; const char* b3 = b2 + kstep;
            if (last && has_next) S.a_ready(nxt);
            if constexpr (SP2) {
            PG8_LDB(B0, 0, 0); PG8_LDB(B1, 0, 1); PG8_SCHED; PG8_LDA(At, 0, 0); PG8_STAGE(PG8_SA(1, 1), a1 + hstep, voffA);
            PG8_WAIT_V(8); PG8_WAIT_L(0); PG8_BAR; PG8_MMA(0, 0, At, B0); PG8_MMA(0, 1, At, B1); PG8_BAR; PG8_SCHED;
            PG8_LDA(At, 0, 1); PG8_STAGE(PG8_SB(0, 0), b2, voffB); PG8_STAGE(PG8_SB(0, 1), b2 + hstep, voffB); PG8_STAGE(PG8_SA(0, 0), a2, voffA);
            PG8_WAIT_V(8); PG8_WAIT_L(0); PG8_BAR; PG8_MMA(1, 0, At, B0); PG8_MMA(1, 1, At, B1); PG8_BAR; PG8_SCHED;
            PG8_LDB(B0, 1, 0); PG8_LDB(B1, 1, 1); PG8_SCHED; PG8_LDA(At, 1, 0); PG8_STAGE(PG8_SA(0, 1), a2 + hstep, voffA);
            PG8_WAIT_V(8); PG8_WAIT_L(0); PG8_BAR; PG8_MMA(0, 0, At, B0); PG8_MMA(0, 1, At, B1); PG8_BAR; PG8_SCHED;
            PG8_LDA(At, 1, 1); PG8_STAGE(PG8_SB(1, 0), b3, voffB); PG8_STAGE(PG8_SB(1, 1), b3 + hstep, voffB); PG8_STAGE(PG8_SA(1, 0), a3, voffA);
            PG8_WAIT_V(8); PG8_WAIT_L(0); PG8_BAR; PG8_MMA(1, 0, At, B0); PG8_MMA(1, 1, At, B1); PG8_BAR; PG8_SCHED;
            } else {
            PG8_LDB(B0, 0, 0); PG8_SCHED; PG8_LDA(At, 0, 0); PG8_STAGE(PG8_SA(1, 1), a1 + hstep, voffA);
            PG8_WAIT_L(8); PG8_BAR; PG8_WAIT_L(0); PG8_MMA(0, 0, At, B0); PG8_BAR; PG8_SCHED;
            PG8_LDB(B1, 0, 1); PG8_STAGE(PG8_SB(0, 0), b2, voffB);
            PG8_BAR; PG8_WAIT_L(0); PG8_MMA(0, 1, At, B1); PG8_BAR;
            PG8_LDA(At, 0, 1); PG8_STAGE(PG8_SA(0, 0), a2, voffA);
            PG8_BAR; PG8_WAIT_L(0); PG8_MMA(1, 0, At, B0); PG8_BAR; PG8_SCHED;
            PG8_STAGE(PG8_SB(0, 1), b2 + hstep, voffB);
            PG8_WAIT_V(6); PG8_BAR; PG8_MMA(1, 1, At, B1); PG8_BAR;
            PG8_LDB(B0, 1, 0); PG8_SCHED; PG8_LDA(At, 1, 0); PG8_STAGE(PG8_SA(0, 1), a2 + hstep, voffA);
            PG8_WAIT_L(8); PG8_BAR; PG8_WAIT_L(0); PG8_MMA(0, 0, At, B0); PG8_BAR; PG8_SCHED;
            PG8_LDB(B1, 1, 1); PG8_STAGE(PG8_SB(1, 0), b3, voffB);
            PG8_BAR; PG8_WAIT_L(0); PG8_MMA(0, 1, At, B1); PG8_BAR;
            PG8_LDA(At, 1, 1); PG8_STAGE(PG8_SA(1, 0), a3, voffA);
            PG8_BAR; PG8_WAIT_L(0); PG8_MMA(1, 0, At, B0); PG8_BAR; PG8_SCHED;
            PG8_STAGE(PG8_SB(1, 1), b3 + hstep, voffB);
            PG8_WAIT_V(6); PG8_BAR; PG8_MMA(1, 1, At, B1); PG8_BAR;
            }
        }
        if constexpr (ALIGN_EPI) { if (wr == 0) PG8_BAR; }
        if constexpr (!Epi::AFTER_DRAIN) { E(acc, cur, wr, wc, fr, fq); S.done(cur); }
        if (!has_next) break;
#pragma unroll
        for (int a = 0; a < 2; ++a)
#pragma unroll
            for (int b = 0; b < 2; ++b)
#pragma unroll
                for (int m = 0; m < 4; ++m)
#pragma unroll
                    for (int n = 0; n < 2; ++n) acc[a][b][m][n] = (f32x4){0.f, 0.f, 0.f, 0.f};
        cur = nxt; cA = nA; cB = nB; ++ui;
        if constexpr (ALIGN_EPI) { if (wr == 1) PG8_BAR; }
    }
    PG8_WAIT_V(0);
    if constexpr (!ALIGN_EPI) { if (wr == 0) PG8_BAR; }
    PG8_BAR;
    if constexpr (Epi::AFTER_DRAIN) { E.fused(acc, cur, wr, wc, fr, fq, lds, wid, lane); S.done(cur); }
#undef PG8_SA
#undef PG8_SB
#undef PG8_STAGE
#undef PG8_LDA
#undef PG8_LDB
#undef PG8_MMA
#undef PG8_WAIT_V
#undef PG8_WAIT_L
#undef PG8_BAR
#undef PG8_SCHED
}
}
namespace att {
typedef unsigned short bf16;
using bf16x8 = __attribute__((ext_vector_type(8))) short;
using s16x4  = __attribute__((ext_vector_type(4))) short;
using f32x16 = __attribute__((ext_vector_type(16))) float;
using u32x4  = __attribute__((ext_vector_type(4))) unsigned;
constexpr int SEQ = 4096, MTOK = 16384;
constexpr int NW = 8, QBLK = 32, KVBLK = 64;
constexpr float SCALE_MLA = 0.07216878364870323f;
constexpr float SCALE_DIL = 0.08838834764831845f;
constexpr float THR = 8.f;
constexpr int L_V = 0, L_KN = 32768, L_KR = 65536, L_WS = 81920, ATT_LDS_BYTES = 83968;
#define KSWZ(row, colB) ((row) * 256 + ((colB) ^ (((row) & 7) << 4)))
#define KRSWZ(row, c) ((row) * 128 + ((((c) ^ ((row) >> 1)) & 7) << 4))
#define SBAR() __builtin_amdgcn_sched_barrier(0)
__device__ __forceinline__ int crow(int r, int hi) { return (r & 3) + 8 * (r >> 2) + 4 * hi; }
__device__ __forceinline__ unsigned cvtpk(float lo, float hi) { unsigned r; asm volatile("v_cvt_pk_bf16_f32 %0, %1, %2" : "=v"(r) : "v"(lo), "v"(hi)); return r; }
__device__ __forceinline__ bf16x8 ld8(const bf16* p) { return *reinterpret_cast<const bf16x8*>(p); }

template <bool MLA> __device__ __forceinline__ void partialSM(f32x16& p0, f32x16& p1, float& m_reg, float& mn, float& alpha) {
  constexpr float SCALE = MLA ? SCALE_MLA : SCALE_DIL;
  constexpr float C = SCALE * 1.4426950408889634f;
  float pmax = p0[0];
#pragma unroll
  for (int r = 1; r < 16; ++r) pmax = fmaxf(pmax, p0[r]);
#pragma unroll
  for (int r = 0; r < 16; ++r) pmax = fmaxf(pmax, p1[r]);
  { auto rr = __builtin_amdgcn_permlane32_swap(__float_as_uint(pmax), __float_as_uint(pmax), false, false);
    pmax = fmaxf(__uint_as_float(rr[0]), __uint_as_float(rr[1])); }
  if (__builtin_expect(__all(pmax - m_reg <= THR / SCALE), 1)) { mn = m_reg; alpha = 1.f; }
  else { mn = fmaxf(m_reg, pmax); alpha = __builtin_amdgcn_exp2f((m_reg - mn) * C); m_reg = mn; }
  float mnC = -mn * C;
#pragma unroll
  for (int r = 0; r < 16; ++r) p0[r] = fmaf(p0[r], C, mnC);
#pragma unroll
  for (int r = 0; r < 16; ++r) p1[r] = fmaf(p1[r], C, mnC);
#pragma unroll
  for (int r = 0; r < 16; ++r) p0[r] = __builtin_amdgcn_exp2f(p0[r]);
}
__device__ __forceinline__ void finishSM(f32x16& p0, f32x16& p1, float alpha, float& l_reg, bf16x8& pa0, bf16x8& pa1, bf16x8& pa2, bf16x8& pa3) {
#pragma unroll
  for (int r = 0; r < 16; ++r) p1[r] = __builtin_amdgcn_exp2f(p1[r]);
  float ps = 0;
#pragma unroll
  for (int r = 0; r < 16; ++r) ps += p0[r];
#pragma unroll
  for (int r = 0; r < 16; ++r) ps += p1[r];
  { auto rr = __builtin_amdgcn_permlane32_swap(__float_as_uint(ps), __float_as_uint(ps), false, false);
    ps = __uint_as_float(rr[0]) + __uint_as_float(rr[1]); }
  l_reg = l_reg * alpha + ps;
#define PK4(P, BASE, OUT) do { unsigned a0 = cvtpk(P[BASE + 0], P[BASE + 1]), a1 = cvtpk(P[BASE + 2], P[BASE + 3]);   \
    unsigned b0 = cvtpk(P[BASE + 4], P[BASE + 5]), b1 = cvtpk(P[BASE + 6], P[BASE + 7]);                              \
    auto r0 = __builtin_amdgcn_permlane32_swap(a0, b0, false, false); auto r1 = __builtin_amdgcn_permlane32_swap(a1, b1, false, false); \
    u32x4 w = {r0[0], r1[0], r0[1], r1[1]}; OUT = *reinterpret_cast<bf16x8*>(&w); } while (0)
  PK4(p0, 0, pa0); PK4(p0, 8, pa1); PK4(p1, 0, pa2); PK4(p1, 8, pa3);
#undef PK4
}
template <int NR> __device__ __forceinline__ void qkt(f32x16& p0, f32x16& p1, const char* Kn, const char* Kr, const bf16x8* qr, int r32, int hi) {
  p0 = f32x16{}; p1 = f32x16{};
#pragma unroll
  for (int d0 = 0; d0 < 8; ++d0) { int cb = (d0 * 16 + hi * 8) * 2;
    bf16x8 b0 = *reinterpret_cast<const bf16x8*>(Kn + KSWZ(r32, cb));
    bf16x8 b1 = *reinterpret_cast<const bf16x8*>(Kn + KSWZ(32 + r32, cb));
    p0 = __builtin_amdgcn_mfma_f32_32x32x16_bf16(b0, qr[d0], p0, 0, 0, 0);
    p1 = __builtin_amdgcn_mfma_f32_32x32x16_bf16(b1, qr[d0], p1, 0, 0, 0); }
#pragma unroll
  for (int d0 = 0; d0 < NR; ++d0) { int c = d0 * 2 + hi;
    bf16x8 b0 = *reinterpret_cast<const bf16x8*>(Kr + KRSWZ(r32, c));
    bf16x8 b1 = *reinterpret_cast<const bf16x8*>(Kr + KRSWZ(32 + r32, c));
    p0 = __builtin_amdgcn_mfma_f32_32x32x16_bf16(b0, qr[8 + d0], p0, 0, 0, 0);
    p1 = __builtin_amdgcn_mfma_f32_32x32x16_bf16(b1, qr[8 + d0], p1, 0, 0, 0); }
}
__device__ __forceinline__ int v_st(int k, int c) { const int kk = (k & ~0xC) | ((k & 4) << 1) | ((k & 8) >> 1); return ((kk >> 3) * 4 + (c >> 5)) * 512 + ((kk & 7) * 32 + (c & 31)) * 2; }
__device__ __forceinline__ int v_rd_base(int lane) { return ((lane & 3) << 3) | (((lane >> 2) & 3) << 6) | (((lane >> 4) & 1) << 5) | (((lane >> 5) & 1) << 8); }
constexpr int v_rd_off(int d0, int ks, int half) { return d0 * 512 + ks * 4096 + half * 2048; }
template <int OFF> __device__ __forceinline__ s16x4 tr_read(int vb) {
  s16x4 r; asm volatile("ds_read_b64_tr_b16 %0, %1 offset:%2" : "=&v"(r) : "v"(vb), "i"(OFF) : "memory"); return r;
}
template <int D0> __device__ __forceinline__ void pv_one(f32x16& od, int vb, bf16x8 pa0, bf16x8 pa1, bf16x8 pa2, bf16x8 pa3) {
  const s16x4 l0 = tr_read<v_rd_off(D0, 0, 0)>(vb), h0 = tr_read<v_rd_off(D0, 0, 1)>(vb), l1 = tr_read<v_rd_off(D0, 1, 0)>(vb), h1 = tr_read<v_rd_off(D0, 1, 1)>(vb);
  const s16x4 l2 = tr_read<v_rd_off(D0, 2, 0)>(vb), h2 = tr_read<v_rd_off(D0, 2, 1)>(vb), l3 = tr_read<v_rd_off(D0, 3, 0)>(vb), h3 = tr_read<v_rd_off(D0, 3, 1)>(vb);
  asm volatile("s_waitcnt lgkmcnt(0)" ::: "memory"); SBAR();
#define PK(L, H) (bf16x8){L[0], L[1], L[2], L[3], H[0], H[1], H[2], H[3]}
  od = __builtin_amdgcn_mfma_f32_32x32x16_bf16(pa0, PK(l0, h0), od, 0, 0, 0);
  od = __builtin_amdgcn_mfma_f32_32x32x16_bf16(pa1, PK(l1, h1), od, 0, 0, 0);
  od = __builtin_amdgcn_mfma_f32_32x32x16_bf16(pa2, PK(l2, h2), od, 0, 0, 0);
  od = __builtin_amdgcn_mfma_f32_32x32x16_bf16(pa3, PK(l3, h3), od, 0, 0, 0);
#undef PK
}
__device__ __forceinline__ void pv_d0(f32x16* o, int vb, bf16x8 pa0, bf16x8 pa1, bf16x8 pa2, bf16x8 pa3) {
  pv_one<0>(o[0], vb, pa0, pa1, pa2, pa3); pv_one<1>(o[1], vb, pa0, pa1, pa2, pa3); pv_one<2>(o[2], vb, pa0, pa1, pa2, pa3); pv_one<3>(o[3], vb, pa0, pa1, pa2, pa3);
}
__device__ __forceinline__ void store_o_bf16(const f32x16* o, float l_reg, float* wsf, char* stg, bf16* Ow, long rstride, int lane, int r32, int hi) {
  if (hi == 0) wsf[r32] = l_reg; asm volatile("s_waitcnt lgkmcnt(0)" ::: "memory");
  float rli[16];
#pragma unroll
  for (int r = 0; r < 16; ++r) rli[r] = __builtin_amdgcn_rcpf(wsf[crow(r, hi)]);
  unsigned short* st = (unsigned short*)stg;
#pragma unroll
  for (int r = 0; r < 16; ++r) { const int orow = crow(r, hi);
#pragma unroll
    for (int d0 = 0; d0 < 4; ++d0) { const float v = o[d0][r] * rli[r]; st[orow * 128 + d0 * 32 + r32] = (unsigned short)(cvtpk(v, v) & 0xffffu); } }
  asm volatile("s_waitcnt lgkmcnt(0)" ::: "memory");
#pragma unroll
  for (int i = 0; i < 8; ++i) { const int row = i * 4 + (lane >> 4), ch = lane & 15; const u32x4 v = *(const u32x4*)(stg + row * 256 + ch * 16); *(u32x4*)(Ow + (long)row * rstride + ch * 8) = v; }
}

__device__ __forceinline__ void mla_unit(const bf16* __restrict__ Qb, const bf16* __restrict__ Kh, const bf16* __restrict__ Vh, const bf16* __restrict__ Krh, bf16* __restrict__ Ob, char* lds) {
  constexpr int LDQ = 3072, LDK = 4096, LDR = 64, LDO = 2048, SHM_V = 16384, SHM_K = 16384, SHM_R = 8192;
  const int tid = threadIdx.x, wid = __builtin_amdgcn_readfirstlane(tid >> 6), lane = tid & 63, r32 = lane & 31, hi = lane >> 5;
  char* V_lds = lds + L_V; char* K_lds = lds + L_KN; char* R_lds = lds + L_KR;
  float* ws = (float*)(lds + L_WS) + wid * 64; float* al_l = ws + 32;
  float m_reg = -1e30f, l_reg = 0; f32x16 o[4] = {}; bf16x8 qr[12];
  { const bf16* Qw = Qb + (long)(wid * QBLK + r32) * LDQ + hi * 8;
#pragma unroll
    for (int d0 = 0; d0 < 12; ++d0) qr[d0] = ld8(Qw + d0 * 16); }
  bf16x8 s_vs0, s_vs1, s_ks0, s_ks1, s_kr;
#define SLOAD(k0) do { int t_ = tid; asm volatile("" : "+v"(t_)); const int sr = t_ >> 4, sc = (t_ & 15) * 8; const unsigned go = (unsigned)(((k0) + sr) * LDK + sc), gr = (unsigned)(((k0) + (t_ >> 3)) * LDR + (t_ & 7) * 8); \
    s_vs0 = ld8(Vh + go); s_vs1 = ld8(Vh + go + 32 * LDK); s_ks0 = ld8(Kh + go); s_ks1 = ld8(Kh + go + 32 * LDK); s_kr = ld8(Krh + gr); } while (0)
#define SWRITE(b) do { int t_ = tid; asm volatile("" : "+v"(t_)); const int sr = t_ >> 4, sc = (t_ & 15) * 8, vst0 = v_st(sr, sc), kc = sc * 2, rr_ = t_ >> 3, rc_ = t_ & 7; \
    *(bf16x8*)(V_lds + (b) * SHM_V + vst0) = s_vs0; *(bf16x8*)(V_lds + (b) * SHM_V + vst0 + 8192) = s_vs1;  \
    *(bf16x8*)(K_lds + (b) * SHM_K + KSWZ(sr, kc)) = s_ks0; *(bf16x8*)(K_lds + (b) * SHM_K + KSWZ(sr, kc) + 8192) = s_ks1;                          \
    *(bf16x8*)(R_lds + (b) * SHM_R + KRSWZ(rr_, rc_)) = s_kr; } while (0)
#define RESC(a) do { if (__any((a) < 1.f)) { if (hi == 0) al_l[r32] = (a); asm volatile("s_waitcnt lgkmcnt(0)" ::: "memory"); \
    _Pragma("unroll") for (int d = 0; d < 4; ++d) _Pragma("unroll") for (int r = 0; r < 16; ++r) o[d][r] *= al_l[crow(r, hi)]; } } while (0)
  f32x16 p0, p1; float mn, al; bf16x8 pa0, pa1, pa2, pa3; constexpr int NT = SEQ / KVBLK;
#define TILE(bufc, bufn, jn) do { \
    if ((jn) < NT) SLOAD((jn) * KVBLK); SBAR(); \
    { int l_ = lane; asm volatile("" : "+v"(l_)); qkt<4>(p0, p1, K_lds + (bufc) * SHM_K, R_lds + (bufc) * SHM_R, qr, l_ & 31, l_ >> 5); } \
    partialSM<true>(p0, p1, m_reg, mn, al); RESC(al); \
    finishSM(p0, p1, al, l_reg, pa0, pa1, pa2, pa3); SBAR(); \
    { int l_ = lane; asm volatile("" : "+v"(l_)); pv_d0(o, (int)(uintptr_t)V_lds + (bufc) * SHM_V + v_rd_base(l_), pa0, pa1, pa2, pa3); } \
    if ((jn) < NT) { asm volatile("s_waitcnt vmcnt(0)" ::: "memory"); SWRITE(bufn); } \
    __syncthreads(); } while (0)
  SLOAD(0); asm volatile("s_waitcnt vmcnt(0)" ::: "memory"); SWRITE(0); __syncthreads();
#pragma clang loop unroll(disable)
  for (int j = 0; j < NT; j += 2) { TILE(0, 1, j + 1); TILE(1, 0, j + 2); }
  store_o_bf16(o, l_reg, ws, lds + wid * 8192, Ob + (long)(wid * QBLK) * LDO, LDO, lane, r32, hi);
  __syncthreads();
#undef SLOAD
#undef SWRITE
#undef TILE
}

__device__ __forceinline__ void dil_unit(int b, int g, int h, int rho, int blk, const bf16* __restrict__ QD, const bf16* __restrict__ KD, const bf16* __restrict__ VD, bf16* __restrict__ PD, float* __restrict__ LSE, char* lds) {
  constexpr float C = SCALE_DIL * 1.4426950408889634f;
  const int d = (g == 0) ? 1 : (g == 1 ? 4 : 16), L = SEQ / d, t0 = blk * 256;
  const int tid = threadIdx.x, wid = __builtin_amdgcn_readfirstlane(tid >> 6), lane = tid & 63, r32 = lane & 31, hi = lane >> 5;
  char* V_lds = lds + L_V; char* K_lds = lds + L_KN;
  float* ws = (float*)(lds + L_WS) + wid * 64; float* al_l = ws + 32;
  const long tokbase = (long)b * SEQ; const int hoff = g * 1024 + h * 128;
  float m_reg = -1e30f, l_reg = 0; f32x16 o[4] = {}; bf16x8 qr[8];
  const int tauq = t0 + wid * QBLK + r32;
  const bf16* Qw = QD + (tokbase + rho + (long)d * tauq) * 3072 + hoff + hi * 8;
#pragma unroll
  for (int d0 = 0; d0 < 8; ++d0) qr[d0] = ld8(Qw + d0 * 16);
  const int sr = tid >> 4, sc = (tid & 15) * 8, vst0 = v_st(sr, sc), vst1 = v_st(32 + sr, sc);
  const int vb0 = (int)(uintptr_t)V_lds + v_rd_base(lane);
  for (int kt = 0; kt < 6; ++kt) {
    const int kbase = t0 - 64 + 64 * kt;
    if (kbase + 63 < 0 || kbase >= L) continue;
    __syncthreads();
    { int ta = kbase + sr, tb = ta + 32; ta = ta < 0 ? 0 : (ta >= L ? L - 1 : ta); tb = tb < 0 ? 0 : (tb >= L ? L - 1 : tb);
      const long oa = (tokbase + rho + (long)d * ta) * 3072 + hoff + sc, ob = (tokbase + rho + (long)d * tb) * 3072 + hoff + sc;
      const bf16x8 ka = ld8(KD + oa), kb = ld8(KD + ob), va = ld8(VD + oa), vb = ld8(VD + ob); const int kc = sc * 2;
      *(bf16x8*)(V_lds + vst0) = va; *(bf16x8*)(V_lds + vst1) = vb; *(bf16x8*)(K_lds + KSWZ(sr, kc)) = ka; *(bf16x8*)(K_lds + KSWZ(32 + sr, kc)) = kb; }
    __syncthreads();
    if (kt >= (wid >> 1) && kt <= (wid >> 1) + 2) {
      f32x16 p0, p1; float mn, al; bf16x8 pa0, pa1, pa2, pa3;
      qkt<0>(p0, p1, K_lds, K_lds, qr, r32, hi);
      const int dl0 = kbase - tauq;
#pragma unroll
      for (int r = 0; r < 16; ++r) { const int kk = crow(r, hi); const int dl = dl0 + kk, tp = kbase + kk;
        if (!(dl >= -64 && dl <= 64 && tp >= 0 && tp < L)) p0[r] = -1e30f;
        if (!(dl + 32 >= -64 && dl + 32 <= 64 && tp + 32 >= 0 && tp + 32 < L)) p1[r] = -1e30f; }
      partialSM<false>(p0, p1, m_reg, mn, al);
      RESC(al);
      finishSM(p0, p1, al, l_reg, pa0, pa1, pa2, pa3); SBAR();
      pv_d0(o, vb0, pa0, pa1, pa2, pa3);
    }
  }
  __syncthreads();
  if (hi == 0) LSE[((long)g * MTOK + tokbase + rho + (long)d * tauq) * 8 + h] = m_reg * C + __builtin_amdgcn_logf(l_reg);
  store_o_bf16(o, l_reg, ws, lds + wid * 8192, PD + ((long)g * MTOK + tokbase + rho + (long)d * (t0 + wid * QBLK)) * 1024 + h * 128, (long)d * 1024, lane, r32, hi);
  __syncthreads();
#undef RESC
}
#undef SBAR
}

#define GAS __attribute__((address_space(1)))
#define LAS __attribute__((address_space(3)))
typedef unsigned short bf16;
typedef unsigned v4u __attribute__((ext_vector_type(4)));
typedef float f32x4 __attribute__((ext_vector_type(4)));
typedef short bf16x8 __attribute__((ext_vector_type(8)));
typedef GAS unsigned gu32;
typedef GAS unsigned long long gu64;
#define RLX_AGENT __ATOMIC_RELAXED, __HIP_MEMORY_SCOPE_AGENT
#define LDS_WAIT() asm volatile("s_waitcnt lgkmcnt(0)" ::: "memory")
#define VM_WAIT() asm volatile("s_waitcnt vmcnt(0)" ::: "memory")
__device__ __forceinline__ unsigned long long rt() { return __builtin_amdgcn_s_memrealtime(); }
__device__ __forceinline__ unsigned f2bf(float f) { unsigned u = __builtin_bit_cast(unsigned, f); return (u + 0x7fffu + ((u >> 16) & 1u)) >> 16; }
__device__ __forceinline__ unsigned pk2(float lo, float hi) { return f2bf(lo) | (f2bf(hi) << 16); }

#define XB_TMO      128
#define XB_XCNT(j)  (256  + 64 * (j))
#define XB_XSUB(j)  (1280 + 64 * (j))
#define XB_XGEN(j)  (2304 + 64 * (j))
#define XB_TOP      3328
#define XB_TOPGEN   3392
#define XCD_BAR_WORDS 3456
#define XB_SPIN_CAP (1u << 18)

__device__ __forceinline__ unsigned xb_ld(unsigned* p)              { return __hip_atomic_load(p, __ATOMIC_RELAXED, __HIP_MEMORY_SCOPE_AGENT); }
__device__ __forceinline__ unsigned xb_add(unsigned* p, unsigned v) { return __hip_atomic_fetch_add(p, v, __ATOMIC_RELAXED, __HIP_MEMORY_SCOPE_AGENT); }
__device__ __forceinline__ unsigned xb_xcc_id() { return (unsigned)__builtin_amdgcn_s_getreg((3 << 11) | 20) & 0xFu; }
#define XB_SPIN(cond, bar) do { unsigned _sp = 0; while (cond) { __builtin_amdgcn_s_sleep(1); \
    if ((++_sp & 255u) == 0u) { if (xb_ld(&(bar)[XB_TMO])) break; if (_sp > XB_SPIN_CAP) { atomicAdd(&(bar)[XB_TMO], 1u); break; } } } } while (0)

struct XcdBarrier {
    unsigned* bar; unsigned x;
    volatile LAS unsigned* st;
};

__device__ __forceinline__ XcdBarrier xcd_barrier_post(unsigned* bar, volatile LAS unsigned* st) {
    XcdBarrier b; b.bar = bar; b.x = xb_xcc_id(); b.st = st;
    if (threadIdx.x == 0) (void)xb_add(&bar[XB_XCNT(b.x)], 1u);
    return b;
}
__device__ __forceinline__ void xcd_barrier_complete(unsigned* bar, unsigned x, unsigned& nloc, unsigned& nx) {
    const unsigned G = gridDim.x * gridDim.y * gridDim.z;
    unsigned sum, cnt, mine, sp = 0u;
    for (;;) {
        sum = 0u; cnt = 0u; mine = 0u;
#pragma unroll
        for (unsigned j = 0; j < 16; ++j) { const unsigned c = xb_ld(&bar[XB_XCNT(j)]); sum += c; cnt += (c > 0u) ? 1u : 0u; mine = (j == x) ? c : mine; }
        if (sum == G) break;
        __builtin_amdgcn_s_sleep(1);
        if ((++sp & 255u) == 0u) { if (xb_ld(&bar[XB_TMO])) break; if (sp > XB_SPIN_CAP) { atomicAdd(&bar[XB_TMO], 1u); break; } }
    }
    nloc = mine > 0u ? mine : 1u; nx = cnt > 0u ? cnt : 1u;
}

__device__ __forceinline__ void xcd_barrier(const XcdBarrier& b) {
    asm volatile("s_waitcnt vmcnt(0)" ::: "memory");
    __syncthreads();
    if (threadIdx.x == 0) {
        unsigned* bar = b.bar;
        __builtin_amdgcn_s_waitcnt(0);
        unsigned nloc = b.st[0], nx = b.st[1];
        if (nloc == 0u) { xcd_barrier_complete(bar, b.x, nloc, nx); b.st[0] = nloc; b.st[1] = nx; }
        const unsigned old = xb_add(&bar[XB_XSUB(b.x)], 1u);
        const unsigned gen = old / nloc;
        if (old + 1u == (gen + 1u) * nloc) {
            __builtin_amdgcn_fence(__ATOMIC_RELEASE, "agent");
            asm volatile("s_waitcnt vmcnt(0)" ::: "memory");
            const unsigned og = xb_add(&bar[XB_TOP], 1u);
            const unsigned tg = og / nx;
            if (og + 1u == (tg + 1u) * nx) xb_add(&bar[XB_TOPGEN], 1u);
            else XB_SPIN(xb_ld(&bar[XB_TOPGEN]) == tg, bar);
            __builtin_amdgcn_fence(__ATOMIC_ACQUIRE, "agent");
            xb_add(&bar[XB_XGEN(b.x)], 1u);
            asm volatile("s_waitcnt vmcnt(0)" ::: "memory");
        } else {
            XB_SPIN(xb_ld(&bar[XB_XGEN(b.x)]) == gen, bar);
            __builtin_amdgcn_fence(__ATOMIC_ACQUIRE, "agent");
            asm volatile("s_waitcnt vmcnt(0)" ::: "memory");
        }
    }
    __syncthreads();
}

constexpr int NWAVES = 8;
constexpr int BATCH = 4, SEQ = 4096, DM = 4096, M = BATCH * SEQ;
constexpr int QRANK = 1024, KVRANK = 512, DFF = 11008, IN_TOTAL = 19008, N_IN = 19200  , N_MOD = 6 * DM;
constexpr float NORM_EPS = 1e-6f;
#ifndef MK_N_LAUNCHES
#define MK_N_LAUNCHES 1
#endif
constexpr int PER_PHASE = 14;
constexpr int N_LAUNCHES = MK_N_LAUNCHES;
static_assert(N_LAUNCHES == 1 || N_LAUNCHES == PER_PHASE, "MK_N_LAUNCHES is 1 or 14");

constexpr size_t MiB = 1u << 20;
constexpr size_t WS_CTL = 0, CTL_ZERO_BYTES = 1 * MiB;
constexpr size_t WS_MOD = 1 * MiB;
constexpr size_t WS_VEC = WS_MOD + 4 * N_MOD * 4;
constexpr size_t WS_COSF = 2 * MiB, WS_SINF = 6 * MiB;
constexpr size_t WS_COSR = 10 * MiB, WS_SINR = 12 * MiB;
constexpr size_t WS_KROPE = 14 * MiB;
constexpr size_t WS_LSE = 16 * MiB;
constexpr size_t WS_MODP = 18 * MiB;
constexpr int KSPLIT = 64;
constexpr size_t WS_WIN = 48 * MiB, WS_WUQ = 198 * MiB, WS_WUKV = 204 * MiB, WS_WPA = 208 * MiB, WS_WPB = 224 * MiB, WS_WOUT = 232 * MiB, WS_WGU = 264 * MiB, WS_WDN = 436 * MiB;
constexpr size_t WS_A = 522 * MiB;
constexpr size_t WS_QD = 650 * MiB, WS_KD = 746 * MiB, WS_VD = 842 * MiB;
constexpr size_t WS_GA = 938 * MiB, WS_GB = 1066 * MiB;
constexpr size_t WS_ZQ = 1194 * MiB, WS_ZKV = 1226 * MiB, WS_ZKR = 1242 * MiB, WS_QN = 1250 * MiB, WS_KVN = 1282 * MiB;
constexpr size_t WS_PD = 1194 * MiB;
constexpr size_t WS_KV = 1298 * MiB;
constexpr size_t WS_YA = 1426 * MiB, WS_YB = 1490 * MiB;
constexpr size_t WS_END = 1522 * MiB;
static_assert(WS_WIN + (size_t)N_IN * DM * 2 <= WS_WUQ && WS_WGU + (size_t)2 * DFF * DM * 2 <= WS_WDN && WS_WDN + (size_t)DM * DFF * 2 <= WS_A, "weights map");
static_assert(WS_QD + (size_t)M * DFF * 2 <= WS_ZQ && WS_PD + (size_t)3 * M * 1024 * 2 <= WS_KV && WS_KV + (size_t)M * 4096 * 2 <= WS_YA && WS_YB + (size_t)M * 1024 * 2 <= WS_END, "activation map");
static_assert(WS_MODP + (size_t)KSPLIT * 4 * N_MOD * 4 <= WS_WIN && WS_VEC + 6 * 4 * DM * 4 <= WS_COSF, "misc map");
constexpr int CW_BAR = 4096;

constexpr int RING_OFF = 0, RING_BYTES = 131072;
constexpr int LDSCTL_OFF = RING_BYTES, MISC_OFF = LDSCTL_OFF + 320;
constexpr int LDS_BYTES = 147456;
static_assert(MISC_OFF + 128 <= LDS_BYTES && att::ATT_LDS_BYTES <= RING_BYTES, "LDS map");

__device__ const float INVF[64] = {
1.000000000e+00f, 8.659643531e-01f, 7.498942018e-01f, 6.493816376e-01f, 5.623413324e-01f, 4.869675338e-01f, 4.216965139e-01f, 3.651741147e-01f, 3.162277639e-01f, 2.738419771e-01f, 2.371373773e-01f, 2.053525001e-01f, 1.778279394e-01f, 1.539926529e-01f, 1.333521456e-01f, 1.154781953e-01f,
1.000000015e-01f, 8.659642935e-02f, 7.498942316e-02f, 6.493816525e-02f, 5.623413250e-02f, 4.869675264e-02f, 4.216964915e-02f, 3.651741147e-02f, 3.162277490e-02f, 2.738419548e-02f, 2.371373773e-02f, 2.053525113e-02f, 1.778279431e-02f, 1.539926510e-02f, 1.333521400e-02f, 1.154781971e-02f,
9.999999776e-03f, 8.659643121e-03f, 7.498942316e-03f, 6.493816152e-03f, 5.623413250e-03f, 4.869675264e-03f, 4.216964822e-03f, 3.651741194e-03f, 3.162277630e-03f, 2.738419687e-03f, 2.371373819e-03f, 2.053525066e-03f, 1.778279431e-03f, 1.539926510e-03f, 1.333521446e-03f, 1.154782018e-03f,
1.000000047e-03f, 8.659643354e-04f, 7.498941850e-04f, 6.493816036e-04f, 5.623413017e-04f, 4.869675322e-04f, 4.216965172e-04f, 3.651741135e-04f, 3.162277571e-04f, 2.738419571e-04f, 2.371373703e-04f, 2.053525095e-04f, 1.778279402e-04f, 1.539926598e-04f, 1.333521504e-04f, 1.154782003e-04f };

struct Frame {
    LAS unsigned char* lds;
    volatile LAS unsigned* MISC;
    gu32* ctl;
    int tid, lane, wave;
    int vcu, G;
};
__device__ __forceinline__ float wave_sum(float v) {
#pragma unroll
    for (int o = 1; o < 64; o <<= 1) v += __shfl_xor(v, o);
    return v;
}
__device__ __forceinline__ void sincos_d(double a, float& s, float& c) {
    const double n = __builtin_rint(a * 0.63661977236758134308);
    const double r = (a - n * 1.57079632673412561417e+00) - n * 6.07710050650619224932e-11;
    const double z = r * r;
    const double sp = r + r * z * (-1.66666666666666324348e-01 + z * (8.33333333332248946124e-03 + z * (-1.98412698298579493134e-04 + z * (2.75573137070700676789e-06 + z * (-2.50507602534068634195e-08 + z * 1.58969099521155010221e-10)))));
    const double cp = 1.0 - 0.5 * z + z * z * (4.16666666666666019037e-02 + z * (-1.38888888888741095749e-03 + z * (2.48015872894767294178e-05 + z * (-2.75573143513906633035e-07 + z * (2.08757232129817482790e-09 + z * -1.13596475577881948265e-11)))));
    const int q = ((int)n) & 3;
    const double ss = (q & 1) ? cp : sp, cc = (q & 1) ? sp : cp;
    s = (float)((q & 2) ? -ss : ss); c = (float)(((q + 1) & 2) ? -cc : cc);
}
__device__ __forceinline__ int map_row(int mode, int n) {
    if (mode == 1) {
        if (n < 1536) return n;
        if (n < 1600) { const int r = n - 1536; return 74 * 256 + (r >> 5) * 128 + (r & 31); }
        if (n < 10816) { const int r = n - 1600, t = r / 3072, rr = r - t * 3072;
            if (t < 2) { const int hd = rr >> 7, dd = rr & 127; return (6 + t * 12 + (hd >> 1)) * 256 + (dd >> 6) * 128 + (hd & 1) * 64 + (dd & 63); }
            return 30 * 256 + rr; }
        return 42 * 256 + (n - 10816);
    }
    if (mode == 2) { const int h = n / 192, dd = n - h * 192; if (dd < 128) return h * 128 + dd; const int r = dd - 128; return (8 + (h >> 2)) * 256 + (r >> 5) * 128 + (h & 3) * 32 + (r & 31); }
    if (mode == 3) return (n >> 7) * 256 + (n & 127);
    if (mode == 4) return (n >> 7) * 256 + 128 + (n & 127);
    return n;
}
__device__ __forceinline__ void p0_transpose_item(const float* W, int K, int N, bf16* WT, int mode, LAS float* scr, int item, int lane) {
    const int nblk = N / 32, kb = item / nblk, nb = item % nblk, k0 = 64 * kb, n0 = 32 * nb;
#pragma unroll 8
    for (int i = 0; i < 32; ++i) { const int kk = 2 * i + (lane >> 5); scr[kk * 33 + (lane & 31)] = W[(size_t)(k0 + kk) * N + n0 + (lane & 31)]; }
    LDS_WAIT(); asm volatile("" ::: "memory");
    const int c = lane & 7;
#pragma unroll
    for (int j = 0; j < 4; ++j) { const int n = (lane >> 3) + 8 * j; const LAS float* s = scr + (8 * c) * 33 + n;
        v4u o; o.x = pk2(s[0 * 33], s[1 * 33]); o.y = pk2(s[2 * 33], s[3 * 33]); o.z = pk2(s[4 * 33], s[5 * 33]); o.w = pk2(s[6 * 33], s[7 * 33]);
        *(GAS v4u*)(WT + (size_t)map_row(mode, n0 + n) * K + k0 + 8 * c) = o; }
    LDS_WAIT(); asm volatile("" ::: "memory");
}
__device__ __forceinline__ void normmod_row(const float* xrow, const float* gm, const float* sh, bf16* orow, int lane) {
    const GAS f32x4* xr = (const GAS f32x4*)xrow + lane;
    f32x4 v[16]; float s = 0.f;
#pragma unroll
    for (int j = 0; j < 16; ++j) { v[j] = xr[64 * j]; s += (v[j].x * v[j].x + v[j].y * v[j].y) + (v[j].z * v[j].z + v[j].w * v[j].w); }
    const float rstd = 1.f / sqrtf(wave_sum(s) * (1.f / DM) + NORM_EPS);
    GAS unsigned long long* o8 = (GAS unsigned long long*)orow + lane;
    const GAS f32x4* g4 = (const GAS f32x4*)gm + lane; const GAS f32x4* s4 = (const GAS f32x4*)sh + lane;
#pragma unroll
    for (int j = 0; j < 16; ++j) { const f32x4 g = g4[64 * j], b = s4[64 * j]; const f32x4 y = v[j] * rstd * g + b;
        o8[64 * j] = (unsigned long long)pk2(y.x, y.y) | ((unsigned long long)pk2(y.z, y.w) << 32); }
}

struct Args { const float* in[19]; float* out; unsigned char* ws; int ph_lo, ph_hi, li, pad; };
__global__ void __launch_bounds__(NWAVES * 64, 2) mk_fwd(Args args) {
    extern __shared__ __attribute__((aligned(16))) unsigned char lds[];
    Frame F;
    F.lds = (LAS unsigned char*)lds;
    F.MISC = (volatile LAS unsigned*)(F.lds + MISC_OFF);
    F.tid = threadIdx.x; F.lane = F.tid & 63; F.wave = __builtin_amdgcn_readfirstlane(F.tid >> 6);
    F.G = gridDim.x; { const int bx = blockIdx.x; F.vcu = (F.G % 8 == 0) ? (bx % 8) * (F.G / 8) + bx / 8 : bx; }
    unsigned char* ws = args.ws;
    F.ctl = (gu32*)(ws + WS_CTL);
    const float* x = args.in[0]; const float* cvec = args.in[1]; const int* positions = (const int*)args.in[2];
    const float* w_ada = args.in[3]; const float* b_ada = args.in[4]; const float* norm1_g = args.in[5]; const float* w_in = args.in[6];
    const float* q_norm_g = args.in[7]; const float* w_uq = args.in[8]; const float* kv_norm_g = args.in[9]; const float* w_ukv = args.in[10];
    const float* w_proj_a = args.in[11]; const float* w_proj_b = args.in[12]; const float* w_out = args.in[13]; const float* norm2_g = args.in[14];
    const float* w_gate = args.in[15]; const float* w_up = args.in[16]; const float* w_down = args.in[17]; const float* final_g = args.in[18];
    float* out = args.out;
    float* MOD = (float*)(ws + WS_MOD); float* VEC = (float*)(ws + WS_VEC); float* MODP = (float*)(ws + WS_MODP);
    float* COSF = (float*)(ws + WS_COSF); float* SINF = (float*)(ws + WS_SINF); float* COSR = (float*)(ws + WS_COSR); float* SINR = (float*)(ws + WS_SINR);
    bf16* KROPE = (bf16*)(ws + WS_KROPE); float* LSE = (float*)(ws + WS_LSE);
    bf16 *WIN = (bf16*)(ws + WS_WIN), *WUQ = (bf16*)(ws + WS_WUQ), *WUKV = (bf16*)(ws + WS_WUKV), *WPA = (bf16*)(ws + WS_WPA), *WPB = (bf16*)(ws + WS_WPB), *WOUT = (bf16*)(ws + WS_WOUT), *WGU = (bf16*)(ws + WS_WGU), *WDN = (bf16*)(ws + WS_WDN);
    bf16 *HB = (bf16*)(ws + WS_A), *QB = (bf16*)(ws + WS_A), *TMP = (bf16*)(ws + WS_A), *H2 = (bf16*)(ws + WS_A);
    bf16 *QD = (bf16*)(ws + WS_QD), *KD = (bf16*)(ws + WS_KD), *VD = (bf16*)(ws + WS_VD), *MIXED = (bf16*)(ws + WS_QD), *AFF = (bf16*)(ws + WS_QD);
    bf16 *GA = (bf16*)(ws + WS_GA), *GB = (bf16*)(ws + WS_GB);
    bf16 *ZQ = (bf16*)(ws + WS_ZQ), *ZKV = (bf16*)(ws + WS_ZKV), *ZKR = (bf16*)(ws + WS_ZKR), *QN = (bf16*)(ws + WS_QN), *KVN = (bf16*)(ws + WS_KVN), *PD = (bf16*)(ws + WS_PD);
    bf16 *KV = (bf16*)(ws + WS_KV), *YA = (bf16*)(ws + WS_YA), *YB = (bf16*)(ws + WS_YB);

    for (int u = F.tid; u < (LDS_BYTES - LDSCTL_OFF) / 4; u += NWAVES * 64) ((LAS unsigned*)(F.lds + LDSCTL_OFF))[u] = 0u;
    __syncthreads();
    XcdBarrier bar; bar.bar = (unsigned*)(F.ctl + CW_BAR); bar.x = 0; bar.st = nullptr;
    if (N_LAUNCHES == 1) bar = xcd_barrier_post((unsigned*)(F.ctl + CW_BAR), F.MISC + 8);
#define GRID_BAR() do { if (N_LAUNCHES == 1) xcd_barrier(bar); } while (0)
    const int lo = args.ph_lo, hi = args.ph_hi;
#ifndef PHASE_MASK
#define PHASE_MASK 0x3fff
#endif
#define IN(k) (((PHASE_MASK >> (k)) & 1) && lo <= (k) && (k) < hi)
#define BOTH(k) (IN(k) && IN((k) + 1))
    const int gw = F.vcu * NWAVES + F.wave, NGW = F.G * NWAVES;
    const int gt = (int)blockIdx.x * (NWAVES * 64) + F.tid, NGT = F.G * NWAVES * 64;

    if (IN(0)) {
        { LAS float* scv = (LAS float*)(F.lds + RING_OFF);
          for (int it = blockIdx.x; it < KSPLIT * 12; it += F.G) {
              const int kc = it / 12, cb = it % 12;
              __syncthreads();
              if (F.tid < 256) { const int k = F.tid >> 2, b = F.tid & 3; const float cv = cvec[b * DM + kc * 64 + k]; scv[k * 4 + b] = cv / (1.f + expf(-cv)); }
              __syncthreads();
              const int col = cb * 2048 + 4 * F.tid;
              f32x4 a0 = {0.f, 0.f, 0.f, 0.f}, a1 = a0, a2 = a0, a3 = a0;
              const float* wp = w_ada + (size_t)(kc * 64) * N_MOD + col;
#pragma unroll 8
              for (int k = 0; k < 64; ++k) { const f32x4 w = *(const GAS f32x4*)(wp + (size_t)k * N_MOD); const f32x4 s = *(const LAS f32x4*)(scv + k * 4);
                  a0 += s.x * w; a1 += s.y * w; a2 += s.z * w; a3 += s.w * w; }
              float* mp = MODP + (size_t)(kc * 4) * N_MOD + col;
              *(GAS f32x4*)(mp) = a0; *(GAS f32x4*)(mp + N_MOD) = a1; *(GAS f32x4*)(mp + 2 * N_MOD) = a2; *(GAS f32x4*)(mp + 3 * N_MOD) = a3;
          }
          __syncthreads(); }
        for (int e = gt; e < M * 64; e += NGT) { const int row = e >> 6, i = e & 63; const float ang = (float)positions[row] * INVF[i]; float s, c; sincos_d((double)ang, s, c); COSF[e] = c; SINF[e] = s; }
        for (int e = gt; e < M * 32; e += NGT) { const int row = e >> 5, i = e & 31; const float ang = (float)positions[row] * INVF[2 * i]; float s, c; sincos_d((double)ang, s, c); COSR[e] = c; SINR[e] = s; }
        for (int e = gt; e < 192 * (DM / 8); e += NGT) { const int rr = e / (DM / 8), c8 = e % (DM / 8); const int row = 74 * 256 + (rr / 96) * 128 + 32 + (rr % 96);
            *(GAS v4u*)(WIN + (size_t)row * DM + c8 * 8) = (v4u){0u, 0u, 0u, 0u}; }
        { LAS float* scr = (LAS float*)(F.lds + RING_OFF + F.wave * 16384);
          constexpr int I_IN = (DM / 64) * (IN_TOTAL / 32), I_UQ = (QRANK / 64) * (3072 / 32), I_UKV = (KVRANK / 64) * (4096 / 32), I_PA = (2048 / 64) * (DM / 32), I_PB = (1024 / 64) * (DM / 32),
                        I_OUT = (DM / 64) * (DM / 32), I_G = (DM / 64) * (DFF / 32), I_DN = (DFF / 64) * (DM / 32);
          constexpr int NITEMS = I_IN + I_UQ + I_UKV + I_PA + I_PB + I_OUT + 2 * I_G + I_DN;
          for (int it = gw; it < NITEMS; it += NGW) {
              int r = it;
              if (r < I_IN) { p0_transpose_item(w_in, DM, IN_TOTAL, WIN, 1, scr, r, F.lane); continue; } r -= I_IN;
              if (r < I_UQ) { p0_transpose_item(w_uq, QRANK, 3072, WUQ, 2, scr, r, F.lane); continue; } r -= I_UQ;
              if (r < I_UKV) { p0_transpose_item(w_ukv, KVRANK, 4096, WUKV, 0, scr, r, F.lane); continue; } r -= I_UKV;
              if (r < I_PA) { p0_transpose_item(w_proj_a, 2048, DM, WPA, 0, scr, r, F.lane); continue; } r -= I_PA;
              if (r < I_PB) { p0_transpose_item(w_proj_b, 1024, DM, WPB, 0, scr, r, F.lane); continue; } r -= I_PB;
              if (r < I_OUT) { p0_transpose_item(w_out, DM, DM, WOUT, 0, scr, r, F.lane); continue; } r -= I_OUT;
              if (r < I_G) { p0_transpose_item(w_gate, DM, DFF, WGU, 3, scr, r, F.lane); continue; } r -= I_G;
              if (r < I_G) { p0_transpose_item(w_up, DM, DFF, WGU, 4, scr, r, F.lane); continue; } r -= I_G;
              p0_transpose_item(w_down, DFF, DM, WDN, 0, scr, r, F.lane);
          } }
        if (BOTH(0)) GRID_BAR();
    }
    if (IN(1)) {
        for (int e = gt; e < BATCH * DM; e += NGT) { const int b = e >> 12, col = e & (DM - 1); float mv[6];
#pragma unroll
            for (int ch = 0; ch < 6; ++ch) { const int j = ch * DM + col; float s = b_ada[j];
                for (int kc = 0; kc < KSPLIT; ++kc) s += MODP[(size_t)(kc * 4 + b) * N_MOD + j];
                mv[ch] = s; MOD[(size_t)b * N_MOD + j] = s; }
            VEC[(0 * 4 + b) * DM + col] = norm1_g[col] * (1.f + mv[1]); VEC[(1 * 4 + b) * DM + col] = mv[0]; VEC[(2 * 4 + b) * DM + col] = mv[2];
            VEC[(3 * 4 + b) * DM + col] = norm2_g[col] * (1.f + mv[4]); VEC[(4 * 4 + b) * DM + col] = mv[3]; VEC[(5 * 4 + b) * DM + col] = mv[5]; }
        if (BOTH(1)) GRID_BAR();
    }
    if (IN(2)) {
        for (int m = gw; m < M; m += NGW) { const int b = m >> 12; normmod_row(x + (size_t)m * DM, VEC + (0 * 4 + b) * DM, VEC + (1 * 4 + b) * DM, HB + (size_t)m * DM, F.lane); }
        if (BOTH(2)) GRID_BAR();
    }
    if (IN(3)) {
        pg8::Gemm g{HB, WIN, M, N_IN, DM}; pg8::StaticOrder S; S.init(M, N_IN, F.G, (int)blockIdx.x);
        pg8::EpiZ E{ZQ, ZKV, QD, KD, VD, GA, GB, ZKR, COSF, SINF};
        pg8::gemm_phase<pg8::EpiZ, pg8::StaticOrder, true, true>(F.lds + RING_OFF, g, S, E);
        if (BOTH(3)) GRID_BAR();
    }
    if (IN(4)) {
        for (int m = gw; m < M; m += NGW) {
            { const GAS v4u* zp = (const GAS v4u*)(ZQ + (size_t)m * QRANK); v4u a = zp[F.lane], b2 = zp[64 + F.lane];
              float f[16]; f[0] = pg8::bf_lo(a.x); f[1] = pg8::bf_hi(a.x); f[2] = pg8::bf_lo(a.y); f[3] = pg8::bf_hi(a.y); f[4] = pg8::bf_lo(a.z); f[5] = pg8::bf_hi(a.z); f[6] = pg8::bf_lo(a.w); f[7] = pg8::bf_hi(a.w);
              f[8] = pg8::bf_lo(b2.x); f[9] = pg8::bf_hi(b2.x); f[10] = pg8::bf_lo(b2.y); f[11] = pg8::bf_hi(b2.y); f[12] = pg8::bf_lo(b2.z); f[13] = pg8::bf_hi(b2.z); f[14] = pg8::bf_lo(b2.w); f[15] = pg8::bf_hi(b2.w);
              float s = 0.f;
#pragma unroll
              for (int i = 0; i < 16; ++i) s += f[i] * f[i];
              const float rstd = 1.f / sqrtf(wave_sum(s) * (1.f / QRANK) + NORM_EPS);
              const float* g0 = q_norm_g + 8 * F.lane; const float* g1 = q_norm_g + 512 + 8 * F.lane;
              v4u o0, o1;
              o0.x = pk2(f[0] * rstd * g0[0], f[1] * rstd * g0[1]); o0.y = pk2(f[2] * rstd * g0[2], f[3] * rstd * g0[3]); o0.z = pk2(f[4] * rstd * g0[4], f[5] * rstd * g0[5]); o0.w = pk2(f[6] * rstd * g0[6], f[7] * rstd * g0[7]);
              o1.x = pk2(f[8] * rstd * g1[0], f[9] * rstd * g1[1]); o1.y = pk2(f[10] * rstd * g1[2], f[11] * rstd * g1[3]); o1.z = pk2(f[12] * rstd * g1[4], f[13] * rstd * g1[5]); o1.w = pk2(f[14] * rstd * g1[6], f[15] * rstd * g1[7]);
              GAS v4u* op = (GAS v4u*)(QN + (size_t)m * QRANK); op[F.lane] = o0; op[64 + F.lane] = o1; }
            { const GAS v4u* zp = (const GAS v4u*)(ZKV + (size_t)m * KVRANK); v4u a = zp[F.lane];
              float f[8]; f[0] = pg8::bf_lo(a.x); f[1] = pg8::bf_hi(a.x); f[2] = pg8::bf_lo(a.y); f[3] = pg8::bf_hi(a.y); f[4] = pg8::bf_lo(a.z); f[5] = pg8::bf_hi(a.z); f[6] = pg8::bf_lo(a.w); f[7] = pg8::bf_hi(a.w);
              float s = 0.f;
#pragma unroll
              for (int i = 0; i < 8; ++i) s += f[i] * f[i];
              const float rstd = 1.f / sqrtf(wave_sum(s) * (1.f / KVRANK) + NORM_EPS);
              const float* g0 = kv_norm_g + 8 * F.lane; v4u o0;
              o0.x = pk2(f[0] * rstd * g0[0], f[1] * rstd * g0[1]); o0.y = pk2(f[2] * rstd * g0[2], f[3] * rstd * g0[3]); o0.z = pk2(f[4] * rstd * g0[4], f[5] * rstd * g0[5]); o0.w = pk2(f[6] * rstd * g0[6], f[7] * rstd * g0[7]);
              ((GAS v4u*)(KVN + (size_t)m * KVRANK))[F.lane] = o0; }
            if (F.lane < 32) { const int i = F.lane; const float x1 = pg8::bf_lo((unsigned)ZKR[(size_t)m * 256 + i]), x2 = pg8::bf_lo((unsigned)ZKR[(size_t)m * 256 + 128 + i]);
              const float c = COSR[(size_t)m * 32 + i], s = SINR[(size_t)m * 32 + i];
              KROPE[(size_t)m * 64 + i] = (bf16)f2bf(x1 * c - x2 * s); KROPE[(size_t)m * 64 + 32 + i] = (bf16)f2bf(x2 * c + x1 * s); }
        }
        if (BOTH(4)) GRID_BAR();
    }
    if (IN(5)) {
        { pg8::Gemm g{QN, WUQ, M, 3072, QRANK}; pg8::StaticOrder S; S.init(M, 3072, F.G, (int)blockIdx.x);
          pg8::EpiQ E{QB, COSR, SINR};
          pg8::gemm_phase<pg8::EpiQ, pg8::StaticOrder, true, true>(F.lds + RING_OFF, g, S, E); }
        { pg8::Gemm g{KVN, WUKV, M, 4096, KVRANK}; pg8::StaticOrder S; S.init(M, 4096, F.G, (int)blockIdx.x);
          pg8::EpiRaw E{KV, 4096};
          pg8::gemm_phase<pg8::EpiRaw, pg8::StaticOrder, true, true>(F.lds + RING_OFF, g, S, E); }
        if (BOTH(5)) GRID_BAR();
    }
    if (IN(6)) {
        char* albs = (char*)lds + RING_OFF;
#ifndef NO_DIL
        for (int i = 0; i < 6; ++i) { const int U = (int)blockIdx.x + F.G * i; if (U >= 1536) break;
            const int bgh = U >> 4, sub = U & 15, b = bgh / 24, g = (bgh % 24) >> 3, h = bgh & 7;
            const int rho = (g == 0) ? 0 : (g == 1 ? (sub >> 2) : sub), blk = (g == 0) ? sub : (g == 1 ? (sub & 3) : 0);
            att::dil_unit(b, g, h, rho, blk, QD, KD, VD, PD, LSE, albs); }
#endif
#ifndef NO_MLA
        for (int i = 0; i < 4; ++i) { const int v = F.vcu; const int xcd = v >> 5, vl = v & 31; const int bh = xcd * 8 + i * 2 + (vl >> 4), qb = vl & 15;
            if (F.G != 256) break;
            const int b = bh >> 4, h = bh & 15; const long r0 = (long)b * SEQ;
            att::mla_unit(QB + (r0 + qb * 256) * 3072 + h * 192, KV + r0 * 4096 + h * 256, KV + r0 * 4096 + h * 256 + 128, KROPE + r0 * 64, YA + (r0 + qb * 256) * 2048 + h * 128, albs); }
#endif
        if (BOTH(6)) GRID_BAR();
    }
    if (IN(7)) {
        for (int e = gt; e < M * 128; e += NGT) { const int tok = e >> 7, c8 = e & 127, h = c8 >> 4;
            const float l0 = LSE[((size_t)0 * M + tok) * 8 + h], l1 = LSE[((size_t)1 * M + tok) * 8 + h], l2 = LSE[((size_t)2 * M + tok) * 8 + h];
            const float mx = fmaxf(l0, fmaxf(l1, l2)); float w0 = __builtin_amdgcn_exp2f(l0 - mx), w1 = __builtin_amdgcn_exp2f(l1 - mx), w2 = __builtin_amdgcn_exp2f(l2 - mx);
            const float inv = 1.f / (w0 + w1 + w2); w0 *= inv; w1 *= inv; w2 *= inv;
            const v4u p0 = *(const GAS v4u*)(PD + ((size_t)0 * M + tok) * 1024 + c8 * 8), p1 = *(const GAS v4u*)(PD + ((size_t)1 * M + tok) * 1024 + c8 * 8), p2 = *(const GAS v4u*)(PD + ((size_t)2 * M + tok) * 1024 + c8 * 8);
            v4u o;
            o.x = pk2(w0 * pg8::bf_lo(p0.x) + w1 * pg8::bf_lo(p1.x) + w2 * pg8::bf_lo(p2.x), w0 * pg8::bf_hi(p0.x) + w1 * pg8::bf_hi(p1.x) + w2 * pg8::bf_hi(p2.x));
            o.y = pk2(w0 * pg8::bf_lo(p0.y) + w1 * pg8::bf_lo(p1.y) + w2 * pg8::bf_lo(p2.y), w0 * pg8::bf_hi(p0.y) + w1 * pg8::bf_hi(p1.y) + w2 * pg8::bf_hi(p2.y));
            o.z = pk2(w0 * pg8::bf_lo(p0.z) + w1 * pg8::bf_lo(p1.z) + w2 * pg8::bf_lo(p2.z), w0 * pg8::bf_hi(p0.z) + w1 * pg8::bf_hi(p1.z) + w2 * pg8::bf_hi(p2.z));
            o.w = pk2(w0 * pg8::bf_lo(p0.w) + w1 * pg8::bf_lo(p1.w) + w2 * pg8::bf_lo(p2.w), w0 * pg8::bf_hi(p0.w) + w1 * pg8::bf_hi(p1.w) + w2 * pg8::bf_hi(p2.w));
            *(GAS v4u*)(YB + (size_t)tok * 1024 + c8 * 8) = o; }
        if (BOTH(7)) GRID_BAR();
    }
    if (IN(8)) {
        { pg8::Gemm g{YA, WPA, M, DM, 2048}; pg8::StaticOrder S; S.init(M, DM, F.G, (int)blockIdx.x);
          pg8::EpiGate<true> E{GA, nullptr, TMP};
          pg8::gemm_phase<pg8::EpiGate<true>, pg8::StaticOrder, true, true>(F.lds + RING_OFF, g, S, E); }
        { pg8::Gemm g{YB, WPB, M, DM, 1024}; pg8::StaticOrder S; S.init(M, DM, F.G, (int)blockIdx.x);
          pg8::EpiGate<false> E{GB, TMP, MIXED};
          pg8::gemm_phase<pg8::EpiGate<false>, pg8::StaticOrder, true, true>(F.lds + RING_OFF, g, S, E); }
        if (BOTH(8)) GRID_BAR();
    }
    if (IN(9)) {
        pg8::Gemm g{MIXED, WOUT, M, DM, DM}; pg8::StaticOrder S; S.init(M, DM, F.G, (int)blockIdx.x);
        pg8::EpiRes E{x, out, VEC + 2 * 4 * DM};
        pg8::gemm_phase<pg8::EpiRes, pg8::StaticOrder, true, true>(F.lds + RING_OFF, g, S, E);
        if (BOTH(9)) GRID_BAR();
    }
    if (IN(10)) {
        for (int m = gw; m < M; m += NGW) { const int b = m >> 12; normmod_row(out + (size_t)m * DM, VEC + (3 * 4 + b) * DM, VEC + (4 * 4 + b) * DM, H2 + (size_t)m * DM, F.lane); }
        if (BOTH(10)) GRID_BAR();
    }
    if (IN(11)) {
        pg8::Gemm g{H2, WGU, M, 2 * DFF, DM}; pg8::StaticOrder S; S.init(M, 2 * DFF, F.G, (int)blockIdx.x);
        pg8::EpiGU E{AFF};
        pg8::gemm_phase<pg8::EpiGU, pg8::StaticOrder, true, true>(F.lds + RING_OFF, g, S, E);
        if (BOTH(11)) GRID_BAR();
    }
    if (IN(12)) {
        pg8::Gemm g{AFF, WDN, M, DM, DFF}; pg8::StaticOrder S; S.init(M, DM, F.G, (int)blockIdx.x);
        pg8::EpiRes E{out, out, VEC + 5 * 4 * DM};
        pg8::gemm_phase<pg8::EpiRes, pg8::StaticOrder, true, true>(F.lds + RING_OFF, g, S, E);
        if (BOTH(12)) GRID_BAR();
    }
    if (IN(13)) {
        const bool bad = (N_LAUNCHES == 1) && (__hip_atomic_load((gu32*)((unsigned*)(F.ctl + CW_BAR) + XB_TMO), RLX_AGENT) != 0u);
        for (int m = gw; m < M; m += NGW) {
            GAS f32x4* xr = (GAS f32x4*)(out + (size_t)m * DM) + F.lane; f32x4 v[16]; float s = 0.f;
#pragma unroll
            for (int j = 0; j < 16; ++j) { v[j] = xr[64 * j]; s += (v[j].x * v[j].x + v[j].y * v[j].y) + (v[j].z * v[j].z + v[j].w * v[j].w); }
            float rstd = 1.f / sqrtf(wave_sum(s) * (1.f / DM) + NORM_EPS); if (bad) rstd = __builtin_nanf("");
            const GAS f32x4* g4 = (const GAS f32x4*)final_g + F.lane;
#pragma unroll
            for (int j = 0; j < 16; ++j) xr[64 * j] = v[j] * rstd * g4[64 * j];
        }
    }
#undef IN
#undef BOTH
#undef GRID_BAR
}

extern "C" void kernel_launch(void* const* d_in, const int* in_sizes, int n_in, void* d_out, int out_size, void* d_ws, size_t ws_size, hipStream_t stream) {
    static int grid = 0;
    if (grid == 0) {
        if (n_in != 19 || in_sizes[0] != M * DM || out_size != M * DM || ws_size < WS_END) { fprintf(stderr, "kernel_launch: shape mismatch: n_in %d in0 %d out %d ws %zu (need %zu); nothing launched\n", n_in, n_in > 0 ? in_sizes[0] : -1, out_size, ws_size, (size_t)WS_END); grid = -1; return; }
        int dev = 0, cus = 0, per_cu = 0;
        if (hipGetDevice(&dev) != hipSuccess || hipDeviceGetAttribute(&cus, hipDeviceAttributeMultiprocessorCount, dev) != hipSuccess) { fprintf(stderr, "kernel_launch: device query failed\n"); grid = -1; return; }
        if (hipFuncSetAttribute((const void*)mk_fwd, hipFuncAttributeMaxDynamicSharedMemorySize, LDS_BYTES) != hipSuccess) { fprintf(stderr, "kernel_launch: hipFuncSetAttribute failed\n"); grid = -1; return; }
        if (hipOccupancyMaxActiveBlocksPerMultiprocessor(&per_cu, (const void*)mk_fwd, NWAVES * 64, LDS_BYTES) != hipSuccess || per_cu < 1) fprintf(stderr, "kernel_launch: note: occupancy query reports %d workgroups per CU\n", per_cu);
        (void)hipGetLastError();
        grid = cus;
        if (grid != 256) fprintf(stderr, "kernel_launch: %d CUs; this kernel is laid out for 256\n", grid);
    }
    if (grid < 0) return;
    if (hipMemsetAsync((char*)d_ws + WS_CTL, 0, CTL_ZERO_BYTES, stream) != hipSuccess) { fprintf(stderr, "kernel_launch: hipMemsetAsync failed\n"); return; }
    Args a{};
    for (int i = 0; i < 19; ++i) a.in[i] = (const float*)d_in[i];
    a.out = (float*)d_out; a.ws = (unsigned char*)d_ws;
    for (int li = 0; li < N_LAUNCHES; ++li) {
        a.ph_lo = (N_LAUNCHES == PER_PHASE) ? li : 0; a.ph_hi = (N_LAUNCHES == PER_PHASE) ? li + 1 : PER_PHASE; a.li = li;
        hipLaunchKernelGGL(mk_fwd, dim3(grid), dim3(NWAVES * 64), LDS_BYTES, stream, a);
        const hipError_t le = hipPeekAtLastError();
        if (le != hipSuccess) { fprintf(stderr, "kernel_launch: launch %d failed: %s\n", li, hipGetErrorName(le)); break; }
    }
}
```

```cpp
#include <hip/hip_runtime.h>
#include <cstdio>
#include <cstdint>
namespace pg8 {
#define PG8_LAS __attribute__((address_space(3)))
typedef unsigned short bf16_t;
typedef short bf16x8 __attribute__((ext_vector_type(8)));
typedef float f32x4 __attribute__((ext_vector_type(4)));
typedef unsigned u32x4 __attribute__((ext_vector_type(4)));
typedef int i32x4_t __attribute__((ext_vector_type(4)));
typedef int i32x8_t __attribute__((ext_vector_type(8)));
constexpr int BM = 256, BK = 64, HALF = 128, HTB = HALF * BK * 2  , STAGE_BYTES = 8 * HTB, NXCD = 8, WGM = 8;

__host__ __device__ __forceinline__ int lds_byte(int r, int c) { const int st = (r >> 4) * 2 + (c >> 5), rr = r & 15, cc = c & 31, ob = rr * 64 + cc * 2; return st * 1024 + (ob ^ (((ob >> 9) & 1) << 5)); }
__host__ __device__ __forceinline__ void stage_rc(int b, int& R, int& C) { const int st = b / 1024, sb = b % 1024, swz = sb ^ (((sb >> 9) & 1) << 5); R = (st >> 1) * 16 + swz / 64; C = (st & 1) * 32 + (swz % 64) / 2; }
__host__ __device__ __forceinline__ int perm32(int rho) { const int n = rho >> 4, i = rho & 15; return 8 * (i >> 2) + 4 * n + (i & 3); }

struct Unit { int pm, pn; };
struct Gemm { const bf16_t* A; const bf16_t* Bt; int M, N, K; const float* sa = nullptr; const float* sw = nullptr; };

struct StaticOrder {
    int nM, nN, nwg, G, c;
    __host__ __device__ void init(int M, int N, int G_, int c_) { nM = M / BM; nN = N / BM; nwg = nM * nN; G = G_; c = c_; }
    __host__ __device__ bool next(int i, Unit& u) const {
        const long L = (long)i * G + c; if (L >= nwg) return false;
        int wgid = (int)L; { const int q = nwg / NXCD, r = nwg % NXCD, xcd = wgid % NXCD, off = wgid / NXCD; wgid = (xcd < r ? xcd * (q + 1) : r * (q + 1) + (xcd - r) * q) + off; }
        const int nig = WGM * nN, gid = wgid / nig, fm = gid * WGM, gsz = (nM - fm) < WGM ? (nM - fm) : WGM;
        u.pm = fm + ((wgid % nig) % gsz); u.pn = (wgid % nig) / gsz; return true;
    }
    __device__ __forceinline__ void a_ready(const Unit&) const {}
    __device__ __forceinline__ void done(const Unit&) const {}
};

__device__ __forceinline__ unsigned cvt_pk_bf16(float lo, float hi) { unsigned r; asm volatile("v_cvt_pk_bf16_f32 %0, %1, %2" : "=v"(r) : "v"(lo), "v"(hi)); return r; }
__device__ __forceinline__ float bf_lo(unsigned w) { return __uint_as_float(w << 16); }
__device__ __forceinline__ float bf_hi(unsigned w) { return __uint_as_float(w & 0xffff0000u); }
__device__ __forceinline__ float sigmoid_f(float x) { return __builtin_amdgcn_rcpf(1.0f + __builtin_amdgcn_exp2f(-1.4426950408889634f * x)); }
__device__ __forceinline__ f32x4 sigmoid4(f32x4 v) { return (f32x4){sigmoid_f(v[0]), sigmoid_f(v[1]), sigmoid_f(v[2]), sigmoid_f(v[3])}; }
__device__ __forceinline__ void st8(bf16_t* p, f32x4 v0, f32x4 v1) { u32x4 w; w.x = cvt_pk_bf16(v0[0], v0[1]); w.y = cvt_pk_bf16(v0[2], v0[3]); w.z = cvt_pk_bf16(v1[0], v1[1]); w.w = cvt_pk_bf16(v1[2], v1[3]); *(u32x4*)p = w; }
__device__ __forceinline__ void st8f(unsigned char* p, f32x4 v0, f32x4 v1) { int w0 = __builtin_amdgcn_cvt_pk_fp8_f32(v0[0], v0[1], 0, false); w0 = __builtin_amdgcn_cvt_pk_fp8_f32(v0[2], v0[3], w0, true); int w1 = __builtin_amdgcn_cvt_pk_fp8_f32(v1[0], v1[1], 0, false); w1 = __builtin_amdgcn_cvt_pk_fp8_f32(v1[2], v1[3], w1, true);
    *(unsigned long long*)p = (unsigned long long)(unsigned)w0 | ((unsigned long long)(unsigned)w1 << 32); }
__device__ __forceinline__ unsigned pk4_u8(f32x4 v) { unsigned w = __builtin_amdgcn_cvt_pk_u8_f32(v[0] * 255.f, 0, 0u); w = __builtin_amdgcn_cvt_pk_u8_f32(v[1] * 255.f, 1, w); w = __builtin_amdgcn_cvt_pk_u8_f32(v[2] * 255.f, 2, w); return __builtin_amdgcn_cvt_pk_u8_f32(v[3] * 255.f, 3, w); }
__device__ __forceinline__ f32x4 u8x4_f(unsigned w) { return (f32x4){(float)(w & 0xffu), (float)((w >> 8) & 0xffu), (float)((w >> 16) & 0xffu), (float)(w >> 24)}; }
__device__ __forceinline__ f32x4 bf4_lo(u32x4 g) { return (f32x4){bf_lo(g.x), bf_hi(g.x), bf_lo(g.y), bf_hi(g.y)}; }
__device__ __forceinline__ f32x4 bf4_hi(u32x4 g) { return (f32x4){bf_lo(g.z), bf_hi(g.z), bf_lo(g.w), bf_hi(g.w)}; }

constexpr int P3_NBF = 0;
struct EpiZ {
    static constexpr bool PERM = true, AFTER_DRAIN = false; static constexpr int MID_T = -1;
    bf16_t *ZQ, *ZKV, *QD, *KD, *VD, *GA, *GB, *ZKR; const float *cosF, *sinF; int remap;
    __device__ __forceinline__ void operator()(const f32x4 (&acc)[2][2][4][2], const Unit& u, int wr, int wc, int fr, int fq) const {
        const int pn = remap == 0 ? u.pn : (remap == 1 ? 6 + u.pn : (u.pn < 6 ? u.pn : P3_NBF + u.pn)), row0 = u.pm * BM + wr * 64 + fr, j0 = wc * 32 + 8 * fq;
        if (pn >= 6 && pn < 30) {
            const int t = (pn - 6) / 12, tt = (pn - 6) % 12, i0 = (wc & 1) * 32 + 8 * fq;
            bf16_t* base = (t ? KD : QD) + ((size_t)((u.pm >> 4) * 24 + 2 * tt + (wc >> 1)) * 4096) * 128 + i0;
#pragma unroll
            for (int ai = 0; ai < 2; ++ai) { f32x4 cs[4][4];
#pragma unroll
                for (int m = 0; m < 4; ++m) { const int row = row0 + ai * HALF + m * 16; const float* cp = cosF + (size_t)row * 64 + i0; const float* sp = sinF + (size_t)row * 64 + i0;
                    cs[m][0] = *(const f32x4*)cp; cs[m][1] = *(const f32x4*)(cp + 4); cs[m][2] = *(const f32x4*)sp; cs[m][3] = *(const f32x4*)(sp + 4); }
#pragma unroll
                for (int m = 0; m < 4; ++m) { const int row = row0 + ai * HALF + m * 16; const f32x4 c0 = cs[m][0], c1 = cs[m][1], s0 = cs[m][2], s1 = cs[m][3];
                    const f32x4 x10 = acc[ai][0][m][0], x11 = acc[ai][0][m][1], x20 = acc[ai][1][m][0], x21 = acc[ai][1][m][1];
                    bf16_t* rp = base + (size_t)(row & 4095) * 128;
                    st8(rp, x10 * c0 - x20 * s0, x11 * c1 - x21 * s1); st8(rp + 64, x20 * c0 + x10 * s0, x21 * c1 + x11 * s1); } }
        } else if (pn >= 30 && pn < 42) {
            bf16_t* base = VD + ((size_t)((u.pm >> 4) * 24 + 2 * (pn - 30)) * 4096) * 128 + j0;
#pragma unroll
            for (int ai = 0; ai < 2; ++ai)
#pragma unroll
                for (int m = 0; m < 4; ++m) { bf16_t* rp = base + (size_t)((row0 + ai * HALF + m * 16) & 4095) * 128;
#pragma unroll
                    for (int bj = 0; bj < 2; ++bj) st8(rp + (size_t)bj * 4096 * 128, acc[ai][bj][m][0], acc[ai][bj][m][1]); }
        } else {
            bf16_t* base; int ld; bool sig = false;
            if (pn < 4) { base = ZQ + pn * 256; ld = 1024; }
            else if (pn < 6) { base = ZKV + (pn - 4) * 256; ld = 512; }
            else if (pn < 74) { const int gi = pn - 42; base = (gi < 16 ? GA : GB) + ((gi & 15) * 256) / 2; ld = 4096 / 2; sig = true; }
            else { base = ZKR; ld = 256; }
            base += sig ? j0 / 2 : j0;
#pragma unroll
            for (int ai = 0; ai < 2; ++ai)
#pragma unroll
                for (int m = 0; m < 4; ++m) { bf16_t* rp = base + (size_t)(row0 + ai * HALF + m * 16) * ld;
#pragma unroll
                    for (int bj = 0; bj < 2; ++bj) { f32x4 v0 = acc[ai][bj][m][0], v1 = acc[ai][bj][m][1];
                        if (sig) { *(unsigned long long*)(rp + (bj * HALF) / 2) = (unsigned long long)pk4_u8(sigmoid4(v0)) | ((unsigned long long)pk4_u8(sigmoid4(v1)) << 32); }
                        else st8(rp + bj * HALF, v0, v1); } }
        }
    }
};
struct EpiQ {
    static constexpr bool PERM = true, AFTER_DRAIN = false; static constexpr int MID_T = -1;
    unsigned char* Q; const float *cosR, *sinR;
    __device__ __forceinline__ void operator()(const f32x4 (&acc)[2][2][4][2], const Unit& u, int wr, int wc, int fr, int fq) const {
        const int pn = u.pn, row0 = u.pm * BM + wr * 64 + fr;
        if (pn >= 8) {
            const int head = 4 * (pn - 8) + wc, i0 = 8 * fq;
            unsigned char* base = Q + ((size_t)((u.pm >> 4) * 16 + head) * 4096) * 192 + 128 + i0;
#pragma unroll
            for (int ai = 0; ai < 2; ++ai) { f32x4 cs[4][4];
#pragma unroll
                for (int m = 0; m < 4; ++m) { const int row = row0 + ai * HALF + m * 16; const float* cp = cosR + (size_t)row * 32 + i0; const float* sp = sinR + (size_t)row * 32 + i0;
                    cs[m][0] = *(const f32x4*)cp; cs[m][1] = *(const f32x4*)(cp + 4); cs[m][2] = *(const f32x4*)sp; cs[m][3] = *(const f32x4*)(sp + 4); }
#pragma unroll
                for (int m = 0; m < 4; ++m) { const int row = row0 + ai * HALF + m * 16; const f32x4 c0 = cs[m][0], c1 = cs[m][1], s0 = cs[m][2], s1 = cs[m][3];
                    const f32x4 x10 = acc[ai][0][m][0], x11 = acc[ai][0][m][1], x20 = acc[ai][1][m][0], x21 = acc[ai][1][m][1];
                    unsigned char* rp = base + (size_t)(row & 4095) * 192;
                    st8f(rp, x10 * c0 - x20 * s0, x11 * c1 - x21 * s1); st8f(rp + 32, x20 * c0 + x10 * s0, x21 * c1 + x11 * s1); } }
        } else {
            unsigned char* base = Q + ((size_t)((u.pm >> 4) * 16 + 2 * pn) * 4096) * 192 + wc * 32 + 8 * fq;
#pragma unroll
            for (int ai = 0; ai < 2; ++ai)
#pragma unroll
                for (int m = 0; m < 4; ++m) { unsigned char* rp = base + (size_t)((row0 + ai * HALF + m * 16) & 4095) * 192;
#pragma unroll
                    for (int bj = 0; bj < 2; ++bj) st8f(rp + (size_t)bj * 4096 * 192, acc[ai][bj][m][0], acc[ai][bj][m][1]); }
        }
    }
};
struct EpiKV {
    static constexpr bool PERM = true, AFTER_DRAIN = false; static constexpr int MID_T = -1;
    unsigned char* K8; unsigned char* V8T;
    __device__ __forceinline__ void operator()(const f32x4 (&acc)[2][2][4][2], const Unit& u, int wr, int wc, int fr, int fq) const {
        const int row0 = u.pm * BM + wr * 64 + fr, j0 = wc * 32 + 8 * fq; const size_t bh = (size_t)((u.pm >> 4) * 16 + u.pn);
#pragma unroll
        for (int ai = 0; ai < 2; ++ai)
#pragma unroll
            for (int m = 0; m < 4; ++m) { const int s_ = (row0 + ai * HALF + m * 16) & 4095, t = s_ & 63;
                st8f(K8 + (bh * 4096 + s_) * 128 + j0, acc[ai][0][m][0], acc[ai][0][m][1]);
                const int vp = 32 * ((t >> 2) & 1) + (t & 3) + 4 * ((t >> 3) & 3) + 16 * (t >> 5);
                unsigned char* vb = V8T + ((bh * 64 + (s_ >> 6)) * 128 + j0) * 64 + vp;
                const f32x4 v0 = acc[ai][1][m][0], v1 = acc[ai][1][m][1];
                const unsigned w0 = (unsigned)__builtin_amdgcn_cvt_pk_fp8_f32(v0[0], v0[1], 0, false), w1 = (unsigned)__builtin_amdgcn_cvt_pk_fp8_f32(v0[2], v0[3], 0, false), w2 = (unsigned)__builtin_amdgcn_cvt_pk_fp8_f32(v1[0], v1[1], 0, false), w3 = (unsigned)__builtin_amdgcn_cvt_pk_fp8_f32(v1[2], v1[3], 0, false);
                vb[0] = (unsigned char)w0; vb[64] = (unsigned char)(w0 >> 8); vb[128] = (unsigned char)w1; vb[192] = (unsigned char)(w1 >> 8); vb[256] = (unsigned char)w2; vb[320] = (unsigned char)(w2 >> 8); vb[384] = (unsigned char)w3; vb[448] = (unsigned char)(w3 >> 8); }
    }
};
struct EpiMix {
    static constexpr bool PERM = true, AFTER_DRAIN = false; static constexpr int MID_T = 32;
    const unsigned char* GA; const unsigned char* GB; bf16_t* O;
    __device__ __forceinline__ void mid(f32x4 (&acc)[2][2][4][2], const Unit& u, int wr, int wc, int fr_in, int fq_in) const {
        int fr = fr_in, fq = fq_in; asm volatile("" : "+v"(fr), "+v"(fq));
        const int row0 = u.pm * BM + wr * 64 + fr; const size_t c0 = (size_t)u.pn * BM + wc * 32 + 8 * fq;
#pragma unroll
        for (int ai = 0; ai < 2; ++ai)
#pragma unroll
            for (int m = 0; m < 4; ++m) { const size_t ro = (size_t)(row0 + ai * HALF + m * 16) * 4096 + c0;
#pragma unroll
                for (int bj = 0; bj < 2; ++bj) { const size_t p = ro + bj * HALF; const unsigned long long ga = *(const unsigned long long*)(GA + p), gb = *(const unsigned long long*)(GB + p);
                    const f32x4 a0 = u8x4_f((unsigned)ga), a1 = u8x4_f((unsigned)(ga >> 32)); f32x4 b0 = u8x4_f((unsigned)gb), b1 = u8x4_f((unsigned)(gb >> 32));
#pragma unroll
                    for (int i = 0; i < 4; ++i) { b0[i] = fmaxf(b0[i], 1.f); b1[i] = fmaxf(b1[i], 1.f); }
                    acc[ai][bj][m][0] *= (f32x4){a0[0] * __builtin_amdgcn_rcpf(b0[0]), a0[1] * __builtin_amdgcn_rcpf(b0[1]), a0[2] * __builtin_amdgcn_rcpf(b0[2]), a0[3] * __builtin_amdgcn_rcpf(b0[3])};
                    acc[ai][bj][m][1] *= (f32x4){a1[0] * __builtin_amdgcn_rcpf(b1[0]), a1[1] * __builtin_amdgcn_rcpf(b1[1]), a1[2] * __builtin_amdgcn_rcpf(b1[2]), a1[3] * __builtin_amdgcn_rcpf(b1[3])}; }
            }
    }
    __device__ __forceinline__ void operator()(const f32x4 (&acc)[2][2][4][2], const Unit& u, int wr, int wc, int fr, int fq) const {
        const int row0 = u.pm * BM + wr * 64 + fr; const size_t c0 = (size_t)u.pn * BM + wc * 32 + 8 * fq;
        unsigned long long gbv[2][4][2];
#pragma unroll
        for (int ai = 0; ai < 2; ++ai)
#pragma unroll
            for (int m = 0; m < 4; ++m)
#pragma unroll
                for (int bj = 0; bj < 2; ++bj) gbv[ai][m][bj] = *(const unsigned long long*)(GB + (size_t)(row0 + ai * HALF + m * 16) * 4096 + c0 + bj * HALF);
#pragma unroll
        for (int ai = 0; ai < 2; ++ai)
#pragma unroll
            for (int m = 0; m < 4; ++m)
#pragma unroll
                for (int bj = 0; bj < 2; ++bj) { const size_t p = (size_t)(row0 + ai * HALF + m * 16) * 4096 + c0 + bj * HALF; const unsigned long long gb = gbv[ai][m][bj];
                    f32x4 b0 = u8x4_f((unsigned)gb), b1 = u8x4_f((unsigned)(gb >> 32));
#pragma unroll
                    for (int i = 0; i < 4; ++i) { b0[i] = fmaxf(b0[i], 1.f) * (1.f / 255.f); b1[i] = fmaxf(b1[i], 1.f) * (1.f / 255.f); }
                    st8(O + p, acc[ai][bj][m][0] * b0, acc[ai][bj][m][1] * b1); }
    }
};
template <bool BASE_F32> struct EpiRes {
    static constexpr bool PERM = true, AFTER_DRAIN = false; static constexpr int MID_T = -1;
    const void* base; bf16_t* out; const float* gvec;
    __device__ __forceinline__ void operator()(const f32x4 (&acc)[2][2][4][2], const Unit& u, int wr, int wc, int fr, int fq) const {
        const int row0 = u.pm * BM + wr * 64 + fr, col0 = u.pn * BM + wc * 32 + 8 * fq; const float* gb = gvec + (size_t)(u.pm >> 4) * 4096 + col0;
        f32x4 gv[2][2];
#pragma unroll
        for (int bj = 0; bj < 2; ++bj)
#pragma unroll
            for (int n = 0; n < 2; ++n) gv[bj][n] = *(const f32x4*)(gb + bj * HALF + n * 4);
        if constexpr (BASE_F32) {
#pragma unroll
            for (int ai = 0; ai < 2; ++ai) { f32x4 pre[4][2][2];
#pragma unroll
                for (int m = 0; m < 4; ++m)
#pragma unroll
                    for (int bj = 0; bj < 2; ++bj) { const size_t p = (size_t)(row0 + ai * HALF + m * 16) * 4096 + col0 + bj * HALF; pre[m][bj][0] = *(const f32x4*)((const float*)base + p); pre[m][bj][1] = *(const f32x4*)((const float*)base + p + 4); }
#pragma unroll
                for (int m = 0; m < 4; ++m)
#pragma unroll
                    for (int bj = 0; bj < 2; ++bj) { const size_t p = (size_t)(row0 + ai * HALF + m * 16) * 4096 + col0 + bj * HALF; st8(out + p, pre[m][bj][0] + gv[bj][0] * acc[ai][bj][m][0], pre[m][bj][1] + gv[bj][1] * acc[ai][bj][m][1]); } }
        } else {
            u32x4 pre[2][4][2];
#pragma unroll
            for (int ai = 0; ai < 2; ++ai)
#pragma unroll
                for (int m = 0; m < 4; ++m)
#pragma unroll
                    for (int bj = 0; bj < 2; ++bj) pre[ai][m][bj] = *(const u32x4*)((const bf16_t*)base + (size_t)(row0 + ai * HALF + m * 16) * 4096 + col0 + bj * HALF);
#pragma unroll
            for (int ai = 0; ai < 2; ++ai)
#pragma unroll
                for (int m = 0; m < 4; ++m)
#pragma unroll
                    for (int bj = 0; bj < 2; ++bj) { const size_t p = (size_t)(row0 + ai * HALF + m * 16) * 4096 + col0 + bj * HALF; st8(out + p, bf4_lo(pre[ai][m][bj]) + gv[bj][0] * acc[ai][bj][m][0], bf4_hi(pre[ai][m][bj]) + gv[bj][1] * acc[ai][bj][m][1]); }
        }
    }
};
struct EpiGU {
    static constexpr bool PERM = true, AFTER_DRAIN = false; static constexpr int MID_T = -1;
    bf16_t* A;
    __device__ __forceinline__ void operator()(const f32x4 (&acc)[2][2][4][2], const Unit& u, int wr, int wc, int fr, int fq) const {
        const int row0 = u.pm * BM + wr * 64 + fr; bf16_t* base = A + u.pn * HALF + wc * 32 + 8 * fq;
#pragma unroll
        for (int ai = 0; ai < 2; ++ai)
#pragma unroll
            for (int m = 0; m < 4; ++m) { const f32x4 g0 = acc[ai][0][m][0], g1 = acc[ai][0][m][1], u0 = acc[ai][1][m][0], u1 = acc[ai][1][m][1];
                st8(base + (size_t)(row0 + ai * HALF + m * 16) * 11008, g0 * sigmoid4(g0) * u0, g1 * sigmoid4(g1) * u1); }
    }
};

template <class Epi, class Sched, bool ALIGN_EPI = false, bool SP2 = false, bool F8 = false, int SCALE_W = 127, bool I8 = false>
__device__ __forceinline__ void gemm_phase(PG8_LAS unsigned char* lds, const Gemm g, const Sched& S, const Epi& E) {
    int tid_ = threadIdx.x; asm volatile("" : "+v"(tid_));
    const int tid = tid_, wid = __builtin_amdgcn_readfirstlane(tid >> 6), lane = tid & 63, wr = wid >> 2, wc = wid & 3, fr = lane & 15, fq = lane >> 4;
    const int K = g.K, nt = F8 ? K / 128 : K / BK;
    unsigned voffA[2], voffB[2];
#pragma unroll
    for (int i = 0; i < 2; ++i) { int R, C; stage_rc(tid * 16 + i * 8192, R, C); const int Rb = Epi::PERM ? ((R & ~31) + perm32(R & 31)) : R;
        voffA[i] = F8 ? (unsigned)(R * K + 2 * C) : (unsigned)(R * K + C) * 2u; voffB[i] = F8 ? (unsigned)(Rb * K + 2 * C) : (unsigned)(Rb * K + C) * 2u; }
    const size_t kstep = (size_t)(BK * 2);
    const size_t hstep = (size_t)HALF * K * (F8 ? 1 : 2);
    const size_t tstep = 2 * hstep;
    const unsigned ldsw = (unsigned)wid * 1024u;
    const int fcol = F8 ? (fq >> 1) * 32 + (fq & 1) * 16 : fq * 8;
    const int aoff = lds_byte(wr * 64 + fr, fcol), boff = lds_byte(wc * 32 + fr, fcol);
    int scale_w = SCALE_W * 0x01010101, scale_a = 0x7f7f7f7f; asm volatile("" : "+v"(scale_w), "+v"(scale_a));
#define PG8_SA(b, h) (((b) * 2 + (h)) * HTB)
#define PG8_SB(b, h) ((4 + (b) * 2 + (h)) * HTB)
#define PG8_STAGE(bufoff, gbase, voff) do { _Pragma("unroll") for (int _i = 0; _i < 2; ++_i) \
        __builtin_amdgcn_global_load_lds((const unsigned*)((const char*)(gbase) + (voff)[_i]), (PG8_LAS unsigned*)(lds + (bufoff) + ldsw + _i * 8192), 16, 0, 0); } while (0)
#define PG8_RD16(off) (*(const PG8_LAS i32x4_t*)(lds + (off)))
#define PG8_LDA(dst, b, h) do { if constexpr (F8) { _Pragma("unroll") for (int m = 0; m < 4; ++m) dst##8[m] = PG8_CAT8(PG8_RD16(PG8_SA(b, h) + aoff + m * 2048), PG8_RD16(PG8_SA(b, h) + aoff + m * 2048 + 16)); } \
    else { _Pragma("unroll") for (int m = 0; m < 4; ++m) _Pragma("unroll") for (int k = 0; k < 2; ++k) dst[m][k] = *(const PG8_LAS bf16x8*)(lds + PG8_SA(b, h) + aoff + m * 2048 + k * 1024); } } while (0)
#define PG8_LDB(dst, b, h) do { if constexpr (F8) { _Pragma("unroll") for (int n = 0; n < 2; ++n) dst##8[n] = PG8_CAT8(PG8_RD16(PG8_SB(b, h) + boff + n * 2048), PG8_RD16(PG8_SB(b, h) + boff + n * 2048 + 16)); } \
    else { _Pragma("unroll") for (int n = 0; n < 2; ++n) _Pragma("unroll") for (int k = 0; k < 2; ++k) dst[n][k] = *(const PG8_LAS bf16x8*)(lds + PG8_SB(b, h) + boff + n * 2048 + k * 1024); } } while (0)
#define PG8_CAT8(lo, hi) __builtin_shufflevector(lo, hi, 0, 1, 2, 3, 4, 5, 6, 7)
#define PG8_LO4(x) __builtin_shufflevector(x, x, 0, 1, 2, 3)
#define PG8_HI4(x) __builtin_shufflevector(x, x, 4, 5, 6, 7)
#define PG8_MMA(ai, bj, At, Bt) do { __builtin_amdgcn_s_setprio(1); if constexpr (I8) { _Pragma("unroll") for (int m = 0; m < 4; ++m) _Pragma("unroll") for (int n = 0; n < 2; ++n) { \
        i32x4_t c_ = __builtin_bit_cast(i32x4_t, acc[ai][bj][m][n]); c_ = __builtin_amdgcn_mfma_i32_16x16x64_i8(PG8_LO4(Bt##8[n]), PG8_LO4(At##8[m]), c_, 0, 0, 0); \
        c_ = __builtin_amdgcn_mfma_i32_16x16x64_i8(PG8_HI4(Bt##8[n]), PG8_HI4(At##8[m]), c_, 0, 0, 0); acc[ai][bj][m][n] = __builtin_bit_cast(f32x4, c_); } } \
      else if constexpr (F8) { _Pragma("unroll") for (int m = 0; m < 4; ++m) _Pragma("unroll") for (int n = 0; n < 2; ++n) \
        asm volatile("v_mfma_scale_f32_16x16x128_f8f6f4 %0, %1, %2, %0, %3, %4 op_sel_hi:[0,0,0]" : "+v"(acc[ai][bj][m][n]) : "v"(Bt##8[n]), "v"(At##8[m]), "v"(scale_w), "v"(scale_a)); } \
      else { _Pragma("unroll") for (int m = 0; m < 4; ++m) _Pragma("unroll") for (int n = 0; n < 2; ++n) _Pragma("unroll") for (int k = 0; k < 2; ++k) \
        acc[ai][bj][m][n] = __builtin_amdgcn_mfma_f32_16x16x32_bf16(Bt[n][k], At[m][k], acc[ai][bj][m][n], 0, 0, 0); } __builtin_amdgcn_s_setprio(0); } while (0)
#define PG8_WAIT_V(n) asm volatile("s_waitcnt vmcnt(" #n ")" ::: "memory")
#define PG8_WAIT_L(n) asm volatile("s_waitcnt lgkmcnt(" #n ")" ::: "memory")
#define PG8_BAR __builtin_amdgcn_s_barrier()
#define PG8_SCHED __builtin_amdgcn_sched_barrier(0)
    Unit cur, nxt; int ui = 0;
    if (!S.next(0, cur)) return;
    f32x4 acc[2][2][4][2];
#pragma unroll
    for (int a = 0; a < 2; ++a)
#pragma unroll
        for (int b = 0; b < 2; ++b)
#pragma unroll
            for (int m = 0; m < 4; ++m)
#pragma unroll
                for (int n = 0; n < 2; ++n) acc[a][b][m][n] = (f32x4){0.f, 0.f, 0.f, 0.f};
    bf16x8 At[4][2], B0[2][2], B1[2][2]; i32x8_t At8[4], B08[2], B18[2];
    const char* cA = (const char*)g.A + (size_t)cur.pm * tstep; const char* cB = (const char*)g.Bt + (size_t)cur.pn * tstep;
    S.a_ready(cur);
    if constexpr (SP2) {
        PG8_STAGE(PG8_SB(0, 0), cB, voffB); PG8_STAGE(PG8_SB(0, 1), cB + hstep, voffB); PG8_STAGE(PG8_SA(0, 0), cA, voffA); PG8_STAGE(PG8_SA(0, 1), cA + hstep, voffA);
        if (wr == 1) PG8_BAR;
        PG8_WAIT_V(2); PG8_BAR;
        PG8_STAGE(PG8_SB(1, 0), cB + kstep, voffB); PG8_STAGE(PG8_SA(1, 0), cA + kstep, voffA); PG8_STAGE(PG8_SB(1, 1), cB + hstep + kstep, voffB);
        PG8_WAIT_V(6); PG8_BAR;
    } else {
        PG8_STAGE(PG8_SB(0, 0), cB, voffB); PG8_STAGE(PG8_SA(0, 0), cA, voffA); PG8_STAGE(PG8_SB(0, 1), cB + hstep, voffB); PG8_STAGE(PG8_SA(0, 1), cA + hstep, voffA);
        if (wr == 1) PG8_BAR;
        PG8_WAIT_V(4); PG8_BAR;
        PG8_STAGE(PG8_SB(1, 0), cB + kstep, voffB); PG8_STAGE(PG8_SA(1, 0), cA + kstep, voffA); PG8_STAGE(PG8_SB(1, 1), cB + hstep + kstep, voffB);
        PG8_WAIT_V(6); PG8_BAR;
    }
    for (;;) {
        const bool has_next = S.next(ui + 1, nxt);
        const char* nA = has_next ? (const char*)g.A + (size_t)nxt.pm * tstep : cA; const char* nB = has_next ? (const char*)g.Bt + (size_t)nxt.pn * tstep : cB;
        for (int t = 0; t < nt; t += 2) {
            if constexpr (Epi::MID_T >= 0) { if (t == Epi::MID_T) E.mid(acc, cur, wr, wc, fr, fq); }
            const bool last = (t == nt - 2);
            const char* a1 = cA + (size_t)(t + 1) * kstep;
            const char* a2 = last ? nA : cA + (size_t)(t + 2) * kstep; const char* b2 = last ? nB : cB + (size_t)(t + 2) * kstep;
            const char* a3 = a2 + kstep; const char* b3 = b2 + kstep;
            if (last && has_next) S.a_ready(nxt);
            if constexpr (SP2) {
            PG8_LDB(B0, 0, 0); PG8_LDB(B1, 0, 1); PG8_SCHED; PG8_LDA(At, 0, 0); PG8_STAGE(PG8_SA(1, 1), a1 + hstep, voffA);
            PG8_WAIT_V(8); PG8_WAIT_L(0); PG8_BAR; PG8_MMA(0, 0, At, B0); PG8_MMA(0, 1, At, B1); PG8_BAR; PG8_SCHED;
            PG8_LDA(At, 0, 1); PG8_STAGE(PG8_SB(0, 0), b2, voffB); PG8_STAGE(PG8_SB(0, 1), b2 + hstep, voffB); PG8_STAGE(PG8_SA(0, 0), a2, voffA);
            PG8_WAIT_V(8); PG8_WAIT_L(0); PG8_BAR; PG8_MMA(1, 0, At, B0); PG8_MMA(1, 1, At, B1); PG8_BAR; PG8_SCHED;
            PG8_LDB(B0, 1, 0); PG8_LDB(B1, 1, 1); PG8_SCHED; PG8_LDA(At, 1, 0); PG8_STAGE(PG8_SA(0, 1), a2 + hstep, voffA);
            PG8_WAIT_V(8); PG8_WAIT_L(0); PG8_BAR; PG8_MMA(0, 0, At, B0); PG8_MMA(0, 1, At, B1); PG8_BAR; PG8_SCHED;
            PG8_LDA(At, 1, 1); PG8_STAGE(PG8_SB(1, 0), b3, voffB); PG8_STAGE(PG8_SB(1, 1), b3 + hstep, voffB); PG8_STAGE(PG8_SA(1, 0), a3, voffA);
            PG8_WAIT_V(8); PG8_WAIT_L(0); PG8_BAR; PG8_MMA(1, 0, At, B0); PG8_MMA(1, 1, At, B1); PG8_BAR; PG8_SCHED;
            } else {
            PG8_LDB(B0, 0, 0); PG8_SCHED; PG8_LDA(At, 0, 0); PG8_STAGE(PG8_SA(1, 1), a1 + hstep, voffA);
            PG8_WAIT_L(8); PG8_BAR; PG8_WAIT_L(0); PG8_MMA(0, 0, At, B0); PG8_BAR; PG8_SCHED;
            PG8_LDB(B1, 0, 1); PG8_STAGE(PG8_SB(0, 0), b2, voffB);
            PG8_BAR; PG8_WAIT_L(0); PG8_MMA(0, 1, At, B1); PG8_BAR;
            PG8_LDA(At, 0, 1); PG8_STAGE(PG8_SA(0, 0), a2, voffA);
            PG8_BAR; PG8_WAIT_L(0); PG8_MMA(1, 0, At, B0); PG8_BAR; PG8_SCHED;
            PG8_STAGE(PG8_SB(0, 1), b2 + hstep, voffB);
            PG8_WAIT_V(6); PG8_BAR; PG8_MMA(1, 1, At, B1); PG8_BAR;
            PG8_LDB(B0, 1, 0); PG8_SCHED; PG8_LDA(At, 1, 0); PG8_STAGE(PG8_SA(0, 1), a2 + hstep, voffA);
            PG8_WAIT_L(8); PG8_BAR; PG8_WAIT_L(0); PG8_MMA(0, 0, At, B0); PG8_BAR; PG8_SCHED;
            PG8_LDB(B1, 1, 1); PG8_STAGE(PG8_SB(1, 0), b3, voffB);
            PG8_BAR; PG8_WAIT_L(0); PG8_MMA(0, 1, At, B1); PG8_BAR;
            PG8_LDA(At, 1, 1); PG8_STAGE(PG8_SA(1, 0), a3, voffA);
            PG8_BAR; PG8_WAIT_L(0); PG8_MMA(1, 0, At, B0); PG8_BAR; PG8_SCHED;
            PG8_STAGE(PG8_SB(1, 1), b3 + hstep, voffB);
            PG8_WAIT_V(6); PG8_BAR; PG8_MMA(1, 1, At, B1); PG8_BAR;
            }
        }
        if constexpr (F8) asm volatile("s_nop 15\n\ts_nop 15" ::: "memory");
        if constexpr (I8) {
            const int r0_ = cur.pm * BM + wr * 64 + fr, c0_ = cur.pn * BM + wc * 32 + 8 * fq;
#pragma unroll
            for (int a = 0; a < 2; ++a)
#pragma unroll
                for (int m = 0; m < 4; ++m) { const float sa_ = g.sa[r0_ + a * HALF + m * 16] * (1.f / 127.f);
#pragma unroll
                    for (int b = 0; b < 2; ++b)
#pragma unroll
                        for (int n = 0; n < 2; ++n) { const f32x4 sw_ = *(const f32x4*)(g.sw + c0_ + b * HALF + n * 4); const i32x4_t c_ = __builtin_bit_cast(i32x4_t, acc[a][b][m][n]);
                            acc[a][b][m][n] = (f32x4){(float)c_.x * sa_ * sw_.x, (float)c_.y * sa_ * sw_.y, (float)c_.z * sa_ * sw_.z, (float)c_.w * sa_ * sw_.w}; } } }
        if constexpr (ALIGN_EPI) { if (wr == 0) PG8_BAR; }
        if constexpr (!Epi::AFTER_DRAIN) { int fr_ = fr, fq_ = fq; asm volatile("" : "+v"(fr_), "+v"(fq_));
            E(acc, cur, wr, wc, fr_, fq_); S.done(cur); }
        if (!has_next) break;
#pragma unroll
        for (int a = 0; a < 2; ++a)
#pragma unroll
            for (int b = 0; b < 2; ++b)
#pragma unroll
                for (int m = 0; m < 4; ++m)
#pragma unroll
                    for (int n = 0; n < 2; ++n) acc[a][b][m][n] = (f32x4){0.f, 0.f, 0.f, 0.f};
        cur = nxt; cA = nA; cB = nB; ++ui;
        if constexpr (ALIGN_EPI) { if (wr == 1) PG8_BAR; }
    }
    PG8_WAIT_V(0);
    if constexpr (!ALIGN_EPI) { if (wr == 0) PG8_BAR; }
    PG8_BAR;
    if constexpr (Epi::AFTER_DRAIN) { E.fused(acc, cur, wr, wc, fr, fq, lds, wid, lane); S.done(cur); }
#undef PG8_SA
#undef PG8_SB
#undef PG8_STAGE
#undef PG8_LDA
#undef PG8_LDB
#undef PG8_MMA
#undef PG8_CAT8
#undef PG8_LO4
#undef PG8_HI4
#undef PG8_RD16
#undef PG8_WAIT_V
#undef PG8_WAIT_L
#undef PG8_BAR
#undef PG8_SCHED
}
}
namespace att {
typedef unsigned short bf16;
using bf16x8 = __attribute__((ext_vector_type(8))) short;
using s16x4  = __attribute__((ext_vector_type(4))) short;
using f32x16 = __attribute__((ext_vector_type(16))) float;
using u32x4  = __attribute__((ext_vector_type(4))) unsigned;
constexpr int SEQ = 4096, MTOK = 16384;
constexpr int NW = 8, QBLK = 32, KVBLK = 64;
constexpr float SCALE_MLA = 0.07216878364870323f;
constexpr float SCALE_DIL = 0.08838834764831845f;
constexpr float THR = 8.f;
constexpr float THR_MLA = 5.f;
constexpr int L_V = 0, L_KN = 32768, L_KR = 65536, L_WS = 81920, ATT_LDS_BYTES = 83968;
#define KSWZ(row, colB) ((row) * 256 + ((colB) ^ (((row) & 7) << 4)))
#define KRSWZ(row, c) ((row) * 128 + ((((c) ^ ((row) >> 1)) & 7) << 4))
#define SBAR() __builtin_amdgcn_sched_barrier(0)
__device__ __forceinline__ int crow(int r, int hi) { return (r & 3) + 8 * (r >> 2) + 4 * hi; }
__device__ __forceinline__ unsigned cvtpk(float lo, float hi) { unsigned r; asm volatile("v_cvt_pk_bf16_f32 %0, %1, %2" : "=v"(r) : "v"(lo), "v"(hi)); return r; }
__device__ __forceinline__ bf16x8 ld8(const bf16* p) { return *reinterpret_cast<const bf16x8*>(p); }

template <bool MLA> __device__ __forceinline__ void partialSM(f32x16& p0, f32x16& p1, float& m_reg, float& mn, float& alpha) {
  constexpr float SCALE = MLA ? SCALE_MLA : SCALE_DIL;
  constexpr float C = SCALE * 1.4426950408889634f;
  float pmax = p0[0];
#pragma unroll
  for (int r = 1; r < 16; ++r) pmax = fmaxf(pmax, p0[r]);
#pragma unroll
  for (int r = 0; r < 16; ++r) pmax = fmaxf(pmax, p1[r]);
  { auto rr = __builtin_amdgcn_permlane32_swap(__float_as_uint(pmax), __float_as_uint(pmax), false, false);
    pmax = fmaxf(__uint_as_float(rr[0]), __uint_as_float(rr[1])); }
  constexpr float THR_ = MLA ? THR_MLA : THR;
  if (__builtin_expect(__all(pmax - m_reg <= THR_ / SCALE), 1)) { mn = m_reg; alpha = 1.f; }
  else { mn = fmaxf(m_reg, pmax); alpha = __builtin_amdgcn_exp2f((m_reg - mn) * C); m_reg = mn; }
  float mnC = -mn * C;
#pragma unroll
  for (int r = 0; r < 16; ++r) p0[r] = fmaf(p0[r], C, mnC);
#pragma unroll
  for (int r = 0; r < 16; ++r) p1[r] = fmaf(p1[r], C, mnC);
#pragma unroll
  for (int r = 0; r < 16; ++r) p0[r] = __builtin_amdgcn_exp2f(p0[r]);
}
__device__ __forceinline__ void finishSM(f32x16& p0, f32x16& p1, float alpha, float& l_reg, bf16x8& pa0, bf16x8& pa1, bf16x8& pa2, bf16x8& pa3) {
#pragma unroll
  for (int r = 0; r < 16; ++r) p1[r] = __builtin_amdgcn_exp2f(p1[r]);
  float ps = 0;
#pragma unroll
  for (int r = 0; r < 16; ++r) ps += p0[r];
#pragma unroll
  for (int r = 0; r < 16; ++r) ps += p1[r];
  { auto rr = __builtin_amdgcn_permlane32_swap(__float_as_uint(ps), __float_as_uint(ps), false, false);
    ps = __uint_as_float(rr[0]) + __uint_as_float(rr[1]); }
  l_reg = l_reg * alpha + ps;
#define PK4(P, BASE, OUT) do { unsigned a0 = cvtpk(P[BASE + 0], P[BASE + 1]), a1 = cvtpk(P[BASE + 2], P[BASE + 3]);   \
    unsigned b0 = cvtpk(P[BASE + 4], P[BASE + 5]), b1 = cvtpk(P[BASE + 6], P[BASE + 7]);                              \
    auto r0 = __builtin_amdgcn_permlane32_swap(a0, b0, false, false); auto r1 = __builtin_amdgcn_permlane32_swap(a1, b1, false, false); \
    u32x4 w = {r0[0], r1[0], r0[1], r1[1]}; OUT = *reinterpret_cast<bf16x8*>(&w); } while (0)
  PK4(p0, 0, pa0); PK4(p0, 8, pa1); PK4(p1, 0, pa2); PK4(p1, 8, pa3);
#undef PK4
}
typedef int i32x8p __attribute__((ext_vector_type(8)));
__device__ __forceinline__ void finishSM_f8(f32x16& p0, f32x16& p1, float alpha, float& l_reg, i32x8p& pa) {
#pragma unroll
  for (int r = 0; r < 16; ++r) p1[r] = __builtin_amdgcn_exp2f(p1[r]);
  float ps = 0;
#pragma unroll
  for (int r = 0; r < 16; ++r) ps += p0[r];
#pragma unroll
  for (int r = 0; r < 16; ++r) ps += p1[r];
  { auto rr = __builtin_amdgcn_permlane32_swap(__float_as_uint(ps), __float_as_uint(ps), false, false);
    ps = __uint_as_float(rr[0]) + __uint_as_float(rr[1]); }
  l_reg = l_reg * alpha + ps;
#pragma unroll
  for (int k = 0; k < 4; ++k) { int w = __builtin_amdgcn_cvt_pk_fp8_f32(p0[4 * k], p0[4 * k + 1], 0, false); w = __builtin_amdgcn_cvt_pk_fp8_f32(p0[4 * k + 2], p0[4 * k + 3], w, true); pa[k] = w;
    int v = __builtin_amdgcn_cvt_pk_fp8_f32(p1[4 * k], p1[4 * k + 1], 0, false); v = __builtin_amdgcn_cvt_pk_fp8_f32(p1[4 * k + 2], p1[4 * k + 3], v, true); pa[4 + k] = v; }
}
__host__ __device__ __forceinline__ int vpos(int t) { return 32 * ((t >> 2) & 1) + (t & 3) + 4 * ((t >> 3) & 3) + 16 * (t >> 5); }
template <int NR> __device__ __forceinline__ void qkt(f32x16& p0, f32x16& p1, const char* Kn, const char* Kr, const bf16x8* qr, int r32, int hi) {
  p0 = f32x16{}; p1 = f32x16{};
#pragma unroll
  for (int d0 = 0; d0 < 8; ++d0) { int cb = (d0 * 16 + hi * 8) * 2;
    bf16x8 b0 = *reinterpret_cast<const bf16x8*>(Kn + KSWZ(r32, cb));
    bf16x8 b1 = *reinterpret_cast<const bf16x8*>(Kn + KSWZ(32 + r32, cb));
    p0 = __builtin_amdgcn_mfma_f32_32x32x16_bf16(b0, qr[d0], p0, 0, 0, 0);
    p1 = __builtin_amdgcn_mfma_f32_32x32x16_bf16(b1, qr[d0], p1, 0, 0, 0); }
#pragma unroll
  for (int d0 = 0; d0 < NR; ++d0) { int c = d0 * 2 + hi;
    bf16x8 b0 = *reinterpret_cast<const bf16x8*>(Kr + KRSWZ(r32, c));
    bf16x8 b1 = *reinterpret_cast<const bf16x8*>(Kr + KRSWZ(32 + r32, c));
    p0 = __builtin_amdgcn_mfma_f32_32x32x16_bf16(b0, qr[8 + d0], p0, 0, 0, 0);
    p1 = __builtin_amdgcn_mfma_f32_32x32x16_bf16(b1, qr[8 + d0], p1, 0, 0, 0); }
}
__device__ __forceinline__ int v_st(int k, int c) { const int kk = (k & ~0xC) | ((k & 4) << 1) | ((k & 8) >> 1); return ((kk >> 3) * 4 + (c >> 5)) * 512 + ((kk & 7) * 32 + (c & 31)) * 2; }
__device__ __forceinline__ int v_rd_base(int lane) { return ((lane & 3) << 3) | (((lane >> 2) & 3) << 6) | (((lane >> 4) & 1) << 5) | (((lane >> 5) & 1) << 8); }
constexpr int v_rd_off(int d0, int ks, int half) { return d0 * 512 + ks * 4096 + half * 2048; }
template <int OFF> __device__ __forceinline__ s16x4 tr_read(int vb) {
  s16x4 r; asm volatile("ds_read_b64_tr_b16 %0, %1 offset:%2" : "=&v"(r) : "v"(vb), "i"(OFF) : "memory"); return r;
}
template <int D0> __device__ __forceinline__ void pv_one(f32x16& od, int vb, bf16x8 pa0, bf16x8 pa1, bf16x8 pa2, bf16x8 pa3) {
  const s16x4 l0 = tr_read<v_rd_off(D0, 0, 0)>(vb), h0 = tr_read<v_rd_off(D0, 0, 1)>(vb), l1 = tr_read<v_rd_off(D0, 1, 0)>(vb), h1 = tr_read<v_rd_off(D0, 1, 1)>(vb);
  const s16x4 l2 = tr_read<v_rd_off(D0, 2, 0)>(vb), h2 = tr_read<v_rd_off(D0, 2, 1)>(vb), l3 = tr_read<v_rd_off(D0, 3, 0)>(vb), h3 = tr_read<v_rd_off(D0, 3, 1)>(vb);
  asm volatile("s_waitcnt lgkmcnt(0)" ::: "memory"); SBAR();
#define PK(L, H) (bf16x8){L[0], L[1], L[2], L[3], H[0], H[1], H[2], H[3]}
  od = __builtin_amdgcn_mfma_f32_32x32x16_bf16(pa0, PK(l0, h0), od, 0, 0, 0);
  od = __builtin_amdgcn_mfma_f32_32x32x16_bf16(pa1, PK(l1, h1), od, 0, 0, 0);
  od = __builtin_amdgcn_mfma_f32_32x32x16_bf16(pa2, PK(l2, h2), od, 0, 0, 0);
  od = __builtin_amdgcn_mfma_f32_32x32x16_bf16(pa3, PK(l3, h3), od, 0, 0, 0);
#undef PK
}
__device__ __forceinline__ void pv_d0(f32x16* o, int vb, bf16x8 pa0, bf16x8 pa1, bf16x8 pa2, bf16x8 pa3) {
  pv_one<0>(o[0], vb, pa0, pa1, pa2, pa3); pv_one<1>(o[1], vb, pa0, pa1, pa2, pa3); pv_one<2>(o[2], vb, pa0, pa1, pa2, pa3); pv_one<3>(o[3], vb, pa0, pa1, pa2, pa3);
}
__device__ __forceinline__ void store_o_bf16(const f32x16* o, float l_reg, float* wsf, char* stg, bf16* Ow, long rstride, int lane_in, int, int) {
  int lane = lane_in; asm volatile("" : "+v"(lane)); const int r32 = lane & 31, hi = lane >> 5;
  if (hi == 0) wsf[r32] = l_reg; asm volatile("s_waitcnt lgkmcnt(0)" ::: "memory");
  float rli[16];
#pragma unroll
  for (int r = 0; r < 16; ++r) rli[r] = __builtin_amdgcn_rcpf(wsf[crow(r, hi)]);
  unsigned short* st = (unsigned short*)stg;
#pragma unroll
  for (int r = 0; r < 16; ++r) { const int orow = crow(r, hi);
#pragma unroll
    for (int d0 = 0; d0 < 4; ++d0) { const float v = o[d0][r] * rli[r]; st[orow * 128 + d0 * 32 + r32] = (unsigned short)(cvtpk(v, v) & 0xffffu); } }
  asm volatile("s_waitcnt lgkmcnt(0)" ::: "memory");
#pragma unroll
  for (int i = 0; i < 8; ++i) { const int row = i * 4 + (lane >> 4), ch = lane & 15; const u32x4 v = *(const u32x4*)(stg + row * 256 + ch * 16); *(u32x4*)(Ow + (long)row * rstride + ch * 8) = v; }
}

typedef __attribute__((address_space(3))) char* lds_ptr;
typedef short v4i16_t __attribute__((ext_vector_type(4)));
__device__ __forceinline__ bf16x8 ldsf(lds_ptr p, int off) { return *(const __attribute__((address_space(3))) bf16x8*)(p + off); }
__device__ __forceinline__ s16x4 vtr(lds_ptr p, int off) { return __builtin_bit_cast(s16x4, __builtin_amdgcn_ds_read_tr16_b64_v4i16((__attribute__((address_space(3))) v4i16_t*)(p + off))); }
template <int S> __device__ __forceinline__ void kld(bf16x8& lo, bf16x8& hi_, lds_ptr Kn, lds_ptr Kr, int rown, int tn, int rowr, int tr) {
  if constexpr (S < 8) { const int off = rown + (((S & 3) * 32) ^ tn) + (S >> 2) * 128; lo = ldsf(Kn, off); hi_ = ldsf(Kn, off + 8192); }
  else { const int off = rowr + (((S - 8) * 32) ^ tr); lo = ldsf(Kr, off); hi_ = ldsf(Kr, off + 4096); }
}
template <int NS> __device__ __forceinline__ void qkt_ring(f32x16& p0, f32x16& p1, lds_ptr Kn, lds_ptr Kr, const bf16x8* qr, int r32, int hi) {
  const int rown = r32 * 256, tn = (hi * 16) ^ ((r32 & 7) << 4), rowr = r32 * 128, tr = (hi ^ ((r32 >> 1) & 7)) << 4;
  bf16x8 a0, a1, b0, b1, c0, c1;
  p0 = f32x16{}; p1 = f32x16{};
  kld<0>(a0, a1, Kn, Kr, rown, tn, rowr, tr); kld<1>(b0, b1, Kn, Kr, rown, tn, rowr, tr);
#define QSTEP(S, C0, C1, N0, N1) do { if constexpr ((S) < NS) { if constexpr ((S) + 2 < NS) kld<((S) + 2 < NS ? (S) + 2 : 0)>(N0, N1, Kn, Kr, rown, tn, rowr, tr); SBAR(); \
    p0 = __builtin_amdgcn_mfma_f32_32x32x16_bf16(C0, qr[(S) < NS ? (S) : 0], p0, 0, 0, 0); p1 = __builtin_amdgcn_mfma_f32_32x32x16_bf16(C1, qr[(S) < NS ? (S) : 0], p1, 0, 0, 0); SBAR(); } } while (0)
  QSTEP(0, a0, a1, c0, c1); QSTEP(1, b0, b1, a0, a1); QSTEP(2, c0, c1, b0, b1); QSTEP(3, a0, a1, c0, c1); QSTEP(4, b0, b1, a0, a1); QSTEP(5, c0, c1, b0, b1);
  QSTEP(6, a0, a1, c0, c1); QSTEP(7, b0, b1, a0, a1); QSTEP(8, c0, c1, b0, b1); QSTEP(9, a0, a1, c0, c1); QSTEP(10, b0, b1, a0, a1); QSTEP(11, c0, c1, b0, b1);
#undef QSTEP
}
#define VOFF(i, half) v_rd_off((i) >> 2, (i) & 3, half)
__device__ __forceinline__ void pv_ring_pre(lds_ptr vp, s16x4& la, s16x4& ha, s16x4& lb, s16x4& hb) { la = vtr(vp, VOFF(0, 0)); ha = vtr(vp, VOFF(0, 1)); lb = vtr(vp, VOFF(1, 0)); hb = vtr(vp, VOFF(1, 1)); }
__device__ __forceinline__ void pv_ring(f32x16* o, lds_ptr vp, s16x4 la, s16x4 ha, s16x4 lb, s16x4 hb, bf16x8 pa0, bf16x8 pa1, bf16x8 pa2, bf16x8 pa3) {
  s16x4 lc, hc;
#define PKV(L, H) (bf16x8){L[0], L[1], L[2], L[3], H[0], H[1], H[2], H[3]}
#define PSTEP(I, PA, CL, CH, NL, NH) do { if constexpr ((I) + 2 < 16) { NL = vtr(vp, VOFF(((I) + 2) & 15, 0)); NH = vtr(vp, VOFF(((I) + 2) & 15, 1)); } SBAR(); \
    o[(I) >> 2] = __builtin_amdgcn_mfma_f32_32x32x16_bf16(PA, PKV(CL, CH), o[(I) >> 2], 0, 0, 0); SBAR(); } while (0)
  PSTEP(0, pa0, la, ha, lc, hc);  PSTEP(1, pa1, lb, hb, la, ha);  PSTEP(2, pa2, lc, hc, lb, hb);  PSTEP(3, pa3, la, ha, lc, hc);
  PSTEP(4, pa0, lb, hb, la, ha);  PSTEP(5, pa1, lc, hc, lb, hb);  PSTEP(6, pa2, la, ha, lc, hc);  PSTEP(7, pa3, lb, hb, la, ha);
  PSTEP(8, pa0, lc, hc, lb, hb);  PSTEP(9, pa1, la, ha, lc, hc);  PSTEP(10, pa2, lb, hb, la, ha); PSTEP(11, pa3, lc, hc, lb, hb);
  PSTEP(12, pa0, la, ha, lc, hc); PSTEP(13, pa1, lb, hb, la, ha); PSTEP(14, pa2, lc, hc, lb, hb); PSTEP(15, pa3, la, ha, lc, hc);
#undef PSTEP
#undef PKV
}
constexpr int M_V = 0, M_KN = 24576, M_KR = 49152, M_WS = 65536, MLA_LDS_BYTES = 67584;
typedef int i32x4_t __attribute__((ext_vector_type(4)));
typedef int i32x8_t __attribute__((ext_vector_type(8)));
__device__ __forceinline__ void glds16(const void* gsrc, unsigned lds_dst) { unsigned keep;
  asm volatile("s_mov_b32 %0, m0\n\ts_mov_b32 m0, %2\n\ts_nop 0\n\tglobal_load_lds_dwordx4 %1, off\n\ts_mov_b32 m0, %0" : "=&s"(keep) : "v"(gsrc), "s"(lds_dst) : "memory"); }
#define WAIT_BAR(N) asm volatile("s_waitcnt vmcnt(" #N ") lgkmcnt(0)\n\ts_barrier" ::: "memory")
__device__ __forceinline__ i32x4_t ldsq(lds_ptr p, int off) { return *(const __attribute__((address_space(3))) i32x4_t*)(p + off); }
#define CAT8(lo, hi) __builtin_shufflevector(lo, hi, 0, 1, 2, 3, 4, 5, 6, 7)
__device__ __forceinline__ void qkt_f8(f32x16& p0, f32x16& p1, lds_ptr Kn, lds_ptr Kr, const i32x8_t* q8, int r32, int hi, int sc) {
  const int swn = (r32 >> 1) & 7, swr = (r32 >> 2) & 3, rown = r32 * 128, rowr = r32 * 64;
  i32x8_t kf[6];
#pragma unroll
  for (int kb = 0; kb < 2; ++kb) {
#pragma unroll
    for (int c = 0; c < 2; ++c) { const int ci = c * 4 + 2 * hi; kf[kb * 3 + c] = CAT8(ldsq(Kn, kb * 4096 + rown + ((ci ^ swn) << 4)), ldsq(Kn, kb * 4096 + rown + (((ci + 1) ^ swn) << 4))); }
    { const int ci = 2 * hi; kf[kb * 3 + 2] = CAT8(ldsq(Kr, kb * 2048 + rowr + ((ci ^ swr) << 4)), ldsq(Kr, kb * 2048 + rowr + (((ci + 1) ^ swr) << 4))); }
  }
#define MF0(P, A, B) asm volatile("v_mfma_scale_f32_32x32x64_f8f6f4 %0, %1, %2, 0, %3, %3 op_sel_hi:[0,0,0]" : "=&v"(P) : "v"(A), "v"(B), "v"(sc))
#define MF1(P, A, B) asm volatile("v_mfma_scale_f32_32x32x64_f8f6f4 %0, %1, %2, %0, %3, %3 op_sel_hi:[0,0,0]" : "+v"(P) : "v"(A), "v"(B), "v"(sc))
  MF0(p0, kf[0], q8[0]); MF0(p1, kf[3], q8[0]); MF1(p0, kf[1], q8[1]); MF1(p1, kf[4], q8[1]); MF1(p0, kf[2], q8[2]); MF1(p1, kf[5], q8[2]);
  asm volatile("s_nop 15\n\ts_nop 7" : "+v"(p0), "+v"(p1));
#undef MF0
#undef MF1
}
__device__ __forceinline__ void pv_f8(f32x16* o, lds_ptr Vt, i32x8_t pa, int r32, int hi, int sc) {
  i32x8_t vf[4];
#pragma unroll
  for (int d0 = 0; d0 < 4; ++d0) { const int d = 32 * d0 + r32, sw = (d >> 2) & 3, ci = 2 * hi; vf[d0] = CAT8(ldsq(Vt, d * 64 + ((ci ^ sw) << 4)), ldsq(Vt, d * 64 + (((ci + 1) ^ sw) << 4))); }
#pragma unroll
  for (int d0 = 0; d0 < 4; ++d0) asm volatile("v_mfma_scale_f32_32x32x64_f8f6f4 %0, %1, %2, %0, %3, %3 op_sel_hi:[0,0,0]" : "+v"(o[d0]) : "v"(pa), "v"(vf[d0]), "v"(sc));
}
__device__ __forceinline__ void mla_unit(const unsigned char* __restrict__ Q8b, const unsigned char* __restrict__ K8h, const unsigned char* __restrict__ Vth, const unsigned char* __restrict__ KR8h, bf16* __restrict__ Ob, char* lds) {
  constexpr int LDQ = 192, LDK = 128, LDR = 64, LDO = 3072, SHM_V = 8192, SHM_K = 8192, SHM_R = 4096;
  const int tid = threadIdx.x, wid = __builtin_amdgcn_readfirstlane(tid >> 6), lane = tid & 63, r32 = lane & 31, hi = lane >> 5;
  const lds_ptr l3 = (lds_ptr)lds; const unsigned lds0 = (unsigned)(uintptr_t)lds;
  float* ws = (float*)(lds + M_WS) + wid * 64; float* al_l = ws + 32;
  float m_reg = -1e30f, l_reg = 0; f32x16 o[4] = {}; i32x8_t q8[3];
  int sc = 0x7f7f7f7f; asm volatile("" : "+v"(sc));
  const unsigned char *pk, *pr, *pv;
  { const int rk = 8 * wid + (lane >> 3); pk = K8h + (long)rk * LDK + (((lane & 7) ^ ((rk >> 1) & 7)) << 4);
    const int rr = 8 * wid + ((lane & 31) >> 2); pr = KR8h + (long)rr * LDR + (((lane & 3) ^ ((rr >> 2) & 3)) << 4);
    const int dv_ = 16 * wid + (lane >> 2); pv = Vth + (long)dv_ * 64 + (((lane & 3) ^ ((dv_ >> 2) & 3)) << 4); }
#define DMA_K(slot) do { const unsigned dk = (unsigned)__builtin_amdgcn_readfirstlane((int)(lds0 + M_KN + (slot) * SHM_K + wid * 1024)), dr = (unsigned)__builtin_amdgcn_readfirstlane((int)(lds0 + M_KR + (slot) * SHM_R + wid * 512)); \
    glds16(pk, dk); if (lane < 32) glds16(pr, dr); pk += KVBLK * LDK; pr += KVBLK * LDR; } while (0)
#define DMA_V(slot) do { const unsigned dv = (unsigned)__builtin_amdgcn_readfirstlane((int)(lds0 + M_V + (slot) * SHM_V + wid * 1024)); glds16(pv, dv); pv += 8192; } while (0)
  DMA_V(0); DMA_K(0); DMA_K(1);
  { const unsigned char* Qw = Q8b + (long)(wid * QBLK + r32) * LDQ + 32 * hi;
#pragma unroll
    for (int c = 0; c < 3; ++c) q8[c] = CAT8(*(const i32x4_t*)(Qw + c * 64), *(const i32x4_t*)(Qw + c * 64 + 16)); }
#define RESC(a) do { if (__any((a) < 1.f)) { if (hi == 0) al_l[r32] = (a); asm volatile("s_waitcnt lgkmcnt(0)" ::: "memory"); \
    _Pragma("unroll") for (int d = 0; d < 4; ++d) _Pragma("unroll") for (int r = 0; r < 16; ++r) o[d][r] *= al_l[crow(r, hi)]; } } while (0)
  f32x16 p0, p1; float mn, al; i32x8_t pa8 = {}; constexpr int NT = SEQ / KVBLK;
  WAIT_BAR(2);
  const bool late = wid >= 4;
  int s_cur = 0, s_nx1 = 1, s_nx2 = 2, s_prev = 2;
#pragma clang loop unroll(disable)
  for (int j = 0; j < NT; ++j) {
    const bool more2 = (j + 2 < NT);
    if (j + 1 < NT) DMA_V(s_nx1);
    if (more2) DMA_K(s_nx2);
    SBAR();
    if (late) { if (j > 0) pv_f8(o, l3 + M_V + s_prev * SHM_V, pa8, r32, hi, sc); }
    SBAR();
    qkt_f8(p0, p1, l3 + M_KN + s_cur * SHM_K, l3 + M_KR + s_cur * SHM_R, q8, r32, hi, sc);
    partialSM<true>(p0, p1, m_reg, mn, al); RESC(al);
    finishSM_f8(p0, p1, al, l_reg, pa8); SBAR();
    if (!late) pv_f8(o, l3 + M_V + s_cur * SHM_V, pa8, r32, hi, sc);
    SBAR();
    if (more2) WAIT_BAR(2); else WAIT_BAR(0);
    s_prev = s_cur; s_cur = s_nx1; s_nx1 = s_nx2; s_nx2 = (s_nx2 == 2) ? 0 : s_nx2 + 1;
  }
  if (late) pv_f8(o, l3 + M_V + s_prev * SHM_V, pa8, r32, hi, sc);
  asm volatile("s_nop 15\n\ts_nop 7" : "+v"(o[0]), "+v"(o[1]), "+v"(o[2]), "+v"(o[3]));
  WAIT_BAR(0);
  store_o_bf16(o, l_reg, ws, lds + wid * 8192, Ob + (long)(wid * QBLK) * LDO, LDO, lane, r32, hi);
  __syncthreads();
#undef DMA_K
#undef DMA_V
}
#undef CAT8
#undef WAIT_BAR

__device__ __forceinline__ void dil_unit(int b, int g, int h, int rho, int blk, const bf16* __restrict__ QD, const bf16* __restrict__ KD, const bf16* __restrict__ VD, bf16* __restrict__ PD, float* __restrict__ LSE, char* lds) {
  constexpr float C = SCALE_DIL * 1.4426950408889634f;
  const int d = (g == 0) ? 1 : (g == 1 ? 4 : 16), L = SEQ / d, t0 = blk * 256;
  const int tid = threadIdx.x, wid = __builtin_amdgcn_readfirstlane(tid >> 6), lane = tid & 63, r32 = lane & 31, hi = lane >> 5;
  const lds_ptr l3 = (lds_ptr)lds; char* V_lds = lds + L_V; char* K_lds = lds + L_KN;
  float* ws = (float*)(lds + L_WS) + wid * 64; float* al_l = ws + 32;
  const long tokbase = (long)b * SEQ; const long hbase = ((long)(b * 24 + g * 8 + h) * SEQ) * 128;
  float m_reg = -1e30f, l_reg = 0; f32x16 o[4] = {}; bf16x8 qr[8];
  const int tauq = t0 + wid * QBLK + r32;
  { const bf16* Qw = QD + hbase + (rho + (long)d * tauq) * 128 + hi * 8;
#pragma unroll
    for (int d0 = 0; d0 < 8; ++d0) qr[d0] = ld8(Qw + d0 * 16); }
  const int kt0 = (t0 == 0) ? 1 : 0, kt1 = ((L - t0) >> 6) < 5 ? ((L - t0) >> 6) : 5;
  bf16x8 s_ka, s_kb, s_va, s_vb;
#define DLOAD(kt_) do { int t_ = tid; asm volatile("" : "+v"(t_)); const int sr = t_ >> 4, sc = (t_ & 15) * 8, kb_ = t0 - 64 + 64 * (kt_); int ta = kb_ + sr, tb = ta + 32; \
    ta = ta < 0 ? 0 : (ta >= L ? L - 1 : ta); tb = tb < 0 ? 0 : (tb >= L ? L - 1 : tb); \
    const long oa = hbase + (rho + (long)d * ta) * 128 + sc, ob = hbase + (rho + (long)d * tb) * 128 + sc; s_ka = ld8(KD + oa); s_kb = ld8(KD + ob); s_va = ld8(VD + oa); s_vb = ld8(VD + ob); } while (0)
#define DWRITE(buf) do { int t_ = tid; asm volatile("" : "+v"(t_)); const int sr = t_ >> 4, sc = (t_ & 15) * 8, vst0 = v_st(sr, sc), kc = sc * 2; \
    *(bf16x8*)(V_lds + (buf) * 16384 + vst0) = s_va; *(bf16x8*)(V_lds + (buf) * 16384 + vst0 + 8192) = s_vb; *(bf16x8*)(K_lds + (buf) * 16384 + KSWZ(sr, kc)) = s_ka; *(bf16x8*)(K_lds + (buf) * 16384 + KSWZ(sr, kc) + 8192) = s_kb; } while (0)
  DLOAD(kt0); DWRITE(0); __syncthreads();
  int buf = 0;
  for (int kt = kt0; kt <= kt1; ++kt) {
    const bool more = kt < kt1;
    if (more) DLOAD(kt + 1);
    SBAR();
    if (kt >= (wid >> 1) && kt <= (wid >> 1) + 2) {
      f32x16 p0, p1; float mn, al; bf16x8 pa0, pa1, pa2, pa3; const int kbase = t0 - 64 + 64 * kt;
      qkt_ring<8>(p0, p1, l3 + L_KN + buf * 16384, l3 + L_KN, qr, r32, hi);
      s16x4 vla, vha, vlb, vhb; const lds_ptr vp_ = l3 + L_V + buf * 16384 + v_rd_base(lane); pv_ring_pre(vp_, vla, vha, vlb, vhb);
      const int dl0 = kbase - tauq;
#pragma unroll
      for (int r = 0; r < 16; ++r) { const int kk = crow(r, hi); const int dl = dl0 + kk, tp = kbase + kk;
        if (!(dl >= -64 && dl <= 64 && tp >= 0 && tp < L)) p0[r] = -1e30f;
        if (!(dl + 32 >= -64 && dl + 32 <= 64 && tp + 32 >= 0 && tp + 32 < L)) p1[r] = -1e30f; }
      partialSM<false>(p0, p1, m_reg, mn, al);
      RESC(al);
      finishSM(p0, p1, al, l_reg, pa0, pa1, pa2, pa3); SBAR();
      pv_ring(o, vp_, vla, vha, vlb, vhb, pa0, pa1, pa2, pa3);
    }
    if (more) DWRITE(buf ^ 1);
    __syncthreads();
    buf ^= 1;
  }
  if (hi == 0) LSE[((long)g * MTOK + tokbase + rho + (long)d * tauq) * 8 + h] = m_reg * C + __builtin_amdgcn_logf(l_reg);
  store_o_bf16(o, l_reg, ws, lds + wid * 8192, PD + ((long)g * MTOK + tokbase + rho + (long)d * (t0 + wid * QBLK)) * 1024 + h * 128, (long)d * 1024, lane, r32, hi);
  __syncthreads();
#undef DLOAD
#undef DWRITE
#undef RESC
}
#undef SBAR
}

#define GAS __attribute__((address_space(1)))
#define LAS __attribute__((address_space(3)))
typedef unsigned short bf16;
typedef unsigned v4u __attribute__((ext_vector_type(4)));
typedef float f32x4 __attribute__((ext_vector_type(4)));
typedef short bf16x8 __attribute__((ext_vector_type(8)));
typedef GAS unsigned gu32;
typedef GAS unsigned long long gu64;
#define RLX_AGENT __ATOMIC_RELAXED, __HIP_MEMORY_SCOPE_AGENT
#define LDS_WAIT() asm volatile("s_waitcnt lgkmcnt(0)" ::: "memory")
#define VM_WAIT() asm volatile("s_waitcnt vmcnt(0)" ::: "memory")
__device__ __forceinline__ unsigned long long rt() { return __builtin_amdgcn_s_memrealtime(); }
__device__ __forceinline__ unsigned f2bf(float f) { unsigned u = __builtin_bit_cast(unsigned, f); return (u + 0x7fffu + ((u >> 16) & 1u)) >> 16; }
__device__ __forceinline__ unsigned pk2(float lo, float hi) { return f2bf(lo) | (f2bf(hi) << 16); }

#define XB_TMO      128
#define XB_XCNT(j)  (256  + 64 * (j))
#define XB_XSUB(j)  (1280 + 64 * (j))
#define XB_XGEN(j)  (2304 + 64 * (j))
#define XB_TOP      3328
#define XB_TOPGEN   3392
#define XCD_BAR_WORDS 3456
#define XB_SPIN_CAP (1u << 18)

__device__ __forceinline__ unsigned xb_ld(unsigned* p)              { return __hip_atomic_load(p, __ATOMIC_RELAXED, __HIP_MEMORY_SCOPE_AGENT); }
__device__ __forceinline__ unsigned xb_add(unsigned* p, unsigned v) { return __hip_atomic_fetch_add(p, v, __ATOMIC_RELAXED, __HIP_MEMORY_SCOPE_AGENT); }
__device__ __forceinline__ unsigned xb_xcc_id() { return (unsigned)__builtin_amdgcn_s_getreg((3 << 11) | 20) & 0xFu; }
#define XB_SPIN(cond, bar) do { unsigned _sp = 0; while (cond) { __builtin_amdgcn_s_sleep(1); \
    if ((++_sp & 255u) == 0u) { if (xb_ld(&(bar)[XB_TMO])) break; if (_sp > XB_SPIN_CAP) { atomicAdd(&(bar)[XB_TMO], 1u); break; } } } } while (0)

struct XcdBarrier {
    unsigned* bar; unsigned x;
    volatile LAS unsigned* st;
};

__device__ __forceinline__ XcdBarrier xcd_barrier_post(unsigned* bar, volatile LAS unsigned* st) {
    XcdBarrier b; b.bar = bar; b.x = xb_xcc_id(); b.st = st;
    if (threadIdx.x == 0) (void)xb_add(&bar[XB_XCNT(b.x)], 1u);
    return b;
}
__device__ __forceinline__ void xcd_barrier_complete(unsigned* bar, unsigned x, unsigned& nloc, unsigned& nx) {
    const unsigned G = gridDim.x * gridDim.y * gridDim.z;
    unsigned sum, cnt, mine, sp = 0u;
    for (;;) {
        sum = 0u; cnt = 0u; mine = 0u;
#pragma unroll
        for (unsigned j = 0; j < 16; ++j) { const unsigned c = xb_ld(&bar[XB_XCNT(j)]); sum += c; cnt += (c > 0u) ? 1u : 0u; mine = (j == x) ? c : mine; }
        if (sum == G) break;
        __builtin_amdgcn_s_sleep(1);
        if ((++sp & 255u) == 0u) { if (xb_ld(&bar[XB_TMO])) break; if (sp > XB_SPIN_CAP) { atomicAdd(&bar[XB_TMO], 1u); break; } }
    }
    nloc = mine > 0u ? mine : 1u; nx = cnt > 0u ? cnt : 1u;
}

__device__ __forceinline__ void xcd_barrier(const XcdBarrier& b) {
    asm volatile("s_waitcnt vmcnt(0)" ::: "memory");
    __syncthreads();
    if (threadIdx.x == 0) {
        unsigned* bar = b.bar;
        __builtin_amdgcn_s_waitcnt(0);
        unsigned nloc = b.st[0], nx = b.st[1];
        if (nloc == 0u) { xcd_barrier_complete(bar, b.x, nloc, nx); b.st[0] = nloc; b.st[1] = nx; }
        const unsigned old = xb_add(&bar[XB_XSUB(b.x)], 1u);
        const unsigned gen = old / nloc;
        if (old + 1u == (gen + 1u) * nloc) {
            __builtin_amdgcn_fence(__ATOMIC_RELEASE, "agent");
            asm volatile("s_waitcnt vmcnt(0)" ::: "memory");
            const unsigned og = xb_add(&bar[XB_TOP], 1u);
            const unsigned tg = og / nx;
            if (og + 1u == (tg + 1u) * nx) xb_add(&bar[XB_TOPGEN], 1u);
            else XB_SPIN(xb_ld(&bar[XB_TOPGEN]) == tg, bar);
            __builtin_amdgcn_fence(__ATOMIC_ACQUIRE, "agent");
            xb_add(&bar[XB_XGEN(b.x)], 1u);
            asm volatile("s_waitcnt vmcnt(0)" ::: "memory");
        } else {
            XB_SPIN(xb_ld(&bar[XB_XGEN(b.x)]) == gen, bar);
            __builtin_amdgcn_fence(__ATOMIC_ACQUIRE, "agent");
            asm volatile("s_waitcnt vmcnt(0)" ::: "memory");
        }
    }
    __syncthreads();
}

constexpr int NWAVES = 8;
constexpr int BATCH = 4, SEQ = 4096, DM = 4096, M = BATCH * SEQ;
constexpr int QRANK = 1024, KVRANK = 512, DFF = 11008, IN_TOTAL = 19008, N_IN = 19200  , N_MOD = 6 * DM;
constexpr float NORM_EPS = 1e-6f;
#ifndef PG_ALIGN
#define PG_ALIGN true
#endif
#ifndef PG_SP2
#define PG_SP2 true
#endif
#ifdef SELFCHECK
#define HB_OR_NULL(p) (p)
#else
#define HB_OR_NULL(p) (pg8::P3_NBF > 0 ? (p) : nullptr)
#endif
#ifndef CHK_MASK
#define CHK_MASK 0xffffffff
#endif
#ifndef MK_N_LAUNCHES
#define MK_N_LAUNCHES 1
#endif
constexpr int PER_PHASE = 14;
constexpr int N_LAUNCHES = MK_N_LAUNCHES;
static_assert(N_LAUNCHES == 1 || N_LAUNCHES == PER_PHASE, "MK_N_LAUNCHES is 1 or 14");

constexpr size_t MiB = 1u << 20;
constexpr size_t WS_CTL = 0, CTL_ZERO_BYTES = 1 * MiB;
constexpr size_t WS_MOD = 1 * MiB;
constexpr size_t WS_VEC = WS_MOD + 4 * N_MOD * 4;
constexpr size_t WS_COSF = 2 * MiB, WS_SINF = 6 * MiB;
constexpr size_t WS_COSR = 10 * MiB, WS_SINR = 12 * MiB;
constexpr size_t WS_KROPE = 14 * MiB;
constexpr size_t WS_LSE = 16 * MiB;
constexpr size_t WS_MODP = 18 * MiB;
constexpr int KSPLIT = 64;
constexpr size_t WS_WIN = 48 * MiB, WS_WUQ = 198 * MiB, WS_WUKV = 204 * MiB, WS_WPA = 208 * MiB, WS_WPB = 224 * MiB, WS_WOUT = 232 * MiB, WS_WGU = 264 * MiB, WS_WDN = 436 * MiB;
constexpr size_t WS_A = 522 * MiB;
constexpr size_t WS_QD = 650 * MiB, WS_KD = 746 * MiB, WS_VD = 842 * MiB;
constexpr size_t WS_GA = 938 * MiB, WS_GB = 1066 * MiB;
constexpr size_t WS_ZQ = 1194 * MiB, WS_ZKV = 1226 * MiB, WS_ZKR = 1242 * MiB, WS_QN = 1250 * MiB, WS_KVN = 1282 * MiB;
constexpr size_t WS_PD = 1194 * MiB;
constexpr size_t WS_KV = 1298 * MiB;
constexpr size_t WS_YA = 1426 * MiB, WS_YB = 1490 * MiB;
constexpr size_t WS_X1B = 1194 * MiB, WS_X2B = 1322 * MiB;
constexpr size_t WS_H8 = 1298 * MiB;
constexpr size_t WS_END = 1522 * MiB;
static_assert(WS_WIN + (size_t)N_IN * DM * 2 <= WS_WUQ && WS_WGU + (size_t)2 * DFF * DM * 2 <= WS_WDN && WS_WDN + (size_t)DM * DFF * 2 <= WS_A, "weights map");
static_assert(WS_QD + (size_t)M * DFF * 2 <= WS_ZQ && WS_PD + (size_t)3 * M * 1024 * 2 <= WS_KV && WS_KV + (size_t)M * 4096 * 2 <= WS_YA && WS_YB + (size_t)M * 1024 * 2 <= WS_END, "activation map");
static_assert(WS_MODP + (size_t)KSPLIT * 4 * N_MOD * 4 <= WS_WIN && WS_VEC + 6 * 4 * DM * 4 <= WS_COSF, "misc map");
constexpr int CW_BAR = 4096;
constexpr int P11_T8 = 44;

constexpr int RING_OFF = 0, RING_BYTES = 131072;
constexpr int LDSCTL_OFF = RING_BYTES, MISC_OFF = LDSCTL_OFF + 320;
constexpr int LDS_BYTES = 147456;
static_assert(MISC_OFF + 128 <= LDS_BYTES && att::ATT_LDS_BYTES <= RING_BYTES && att::MLA_LDS_BYTES <= RING_BYTES, "LDS map");

__device__ const float INVF[64] = {
1.000000000e+00f, 8.659643531e-01f, 7.498942018e-01f, 6.493816376e-01f, 5.623413324e-01f, 4.869675338e-01f, 4.216965139e-01f, 3.651741147e-01f, 3.162277639e-01f, 2.738419771e-01f, 2.371373773e-01f, 2.053525001e-01f, 1.778279394e-01f, 1.539926529e-01f, 1.333521456e-01f, 1.154781953e-01f,
1.000000015e-01f, 8.659642935e-02f, 7.498942316e-02f, 6.493816525e-02f, 5.623413250e-02f, 4.869675264e-02f, 4.216964915e-02f, 3.651741147e-02f, 3.162277490e-02f, 2.738419548e-02f, 2.371373773e-02f, 2.053525113e-02f, 1.778279431e-02f, 1.539926510e-02f, 1.333521400e-02f, 1.154781971e-02f,
9.999999776e-03f, 8.659643121e-03f, 7.498942316e-03f, 6.493816152e-03f, 5.623413250e-03f, 4.869675264e-03f, 4.216964822e-03f, 3.651741194e-03f, 3.162277630e-03f, 2.738419687e-03f, 2.371373819e-03f, 2.053525066e-03f, 1.778279431e-03f, 1.539926510e-03f, 1.333521446e-03f, 1.154782018e-03f,
1.000000047e-03f, 8.659643354e-04f, 7.498941850e-04f, 6.493816036e-04f, 5.623413017e-04f, 4.869675322e-04f, 4.216965172e-04f, 3.651741135e-04f, 3.162277571e-04f, 2.738419571e-04f, 2.371373703e-04f, 2.053525095e-04f, 1.778279402e-04f, 1.539926598e-04f, 1.333521504e-04f, 1.154782003e-04f };

struct Frame {
    LAS unsigned char* lds;
    volatile LAS unsigned* MISC;
    gu32* ctl;
    int tid, lane, wave;
    int vcu, G;
};
__device__ __forceinline__ float wave_sum(float v) {
#pragma unroll
    for (int o = 1; o < 64; o <<= 1) v += __shfl_xor(v, o);
    return v;
}
__device__ __forceinline__ float wave_max(float v) {
#pragma unroll
    for (int o = 1; o < 64; o <<= 1) v = fmaxf(v, __shfl_xor(v, o));
    return v;
}
__device__ __forceinline__ unsigned pk4_i8(float a, float b, float c, float d) {
    const int ia = __float2int_rn(a), ib = __float2int_rn(b), ic = __float2int_rn(c), id = __float2int_rn(d);
    return ((unsigned)ia & 0xffu) | (((unsigned)ib & 0xffu) << 8) | (((unsigned)ic & 0xffu) << 16) | ((unsigned)id << 24); }
__device__ __forceinline__ void sincos_d(double a, float& s, float& c) {
    const double n = __builtin_rint(a * 0.63661977236758134308);
    const double r = (a - n * 1.57079632673412561417e+00) - n * 6.07710050650619224932e-11;
    const double z = r * r;
    const double sp = r + r * z * (-1.66666666666666324348e-01 + z * (8.33333333332248946124e-03 + z * (-1.98412698298579493134e-04 + z * (2.75573137070700676789e-06 + z * (-2.50507602534068634195e-08 + z * 1.58969099521155010221e-10)))));
    const double cp = 1.0 - 0.5 * z + z * z * (4.16666666666666019037e-02 + z * (-1.38888888888741095749e-03 + z * (2.48015872894767294178e-05 + z * (-2.75573143513906633035e-07 + z * (2.08757232129817482790e-09 + z * -1.13596475577881948265e-11)))));
    const int q = ((int)n) & 3;
    const double ss = (q & 1) ? cp : sp, cc = (q & 1) ? sp : cp;
    s = (float)((q & 2) ? -ss : ss); c = (float)(((q + 1) & 2) ? -cc : cc);
}
constexpr int NBF = pg8::P3_NBF;
__device__ __forceinline__ int win_row8(int r);
__device__ __forceinline__ int map_row_in(int n) {
    if (n < 1536) return n;
    if (n < 1600) { const int r = n - 1536; return 74 * 256 + (r >> 5) * 128 + (r & 31); }
    if (n < 10816) { const int r = n - 1600, t = r / 3072, rr = r - t * 3072;
        if (t < 2) { const int hd = rr >> 7, dd = rr & 127; return (6 + t * 12 + (hd >> 1)) * 256 + (dd >> 6) * 128 + (hd & 1) * 64 + (dd & 63); }
        return 30 * 256 + rr; }
    return 42 * 256 + (n - 10816);
}
__device__ __forceinline__ int map_row(int mode, int n) {
    if (mode == 1) return map_row_in(n);
    if (mode == 2) { const int h = n / 192, dd = n - h * 192; if (dd < 128) return h * 128 + dd; const int r = dd - 128; return (8 + (h >> 2)) * 256 + (r >> 5) * 128 + (h & 3) * 32 + (r & 31); }
    if (mode == 5) return map_row_in(n) - 6 * 256;
    if (mode == 6) return win_row8(map_row_in(n));
    if (mode == 3) return (n >> 7) * 256 + (n & 127);
    if (mode == 4) return (n >> 7) * 256 + 128 + (n & 127);
    return n;
}
__device__ __forceinline__ int win_row8(int r) { const int t = r >> 8; return ((t < 6 ? t : t - NBF) << 8) | (r & 255); }
__device__ __forceinline__ void p0_transpose_item(const float* W, int K, int N, bf16* WT, int mode, LAS float* scr, int item, int lane, int ldw = 0) {
    const int nblk = N / 32, kb = item / nblk, nb = item % nblk, k0 = 64 * kb, n0 = 32 * nb;
    float v[32];
#pragma unroll
    for (int i = 0; i < 32; ++i) { const int kk = 2 * i + (lane >> 5); v[i] = W[(size_t)(k0 + kk) * N + n0 + (lane & 31)]; }
#pragma unroll
    for (int i = 0; i < 32; ++i) { const int kk = 2 * i + (lane >> 5); scr[kk * 33 + (lane & 31)] = v[i]; }
    LDS_WAIT(); asm volatile("" ::: "memory");
    const int c = lane & 7;
#pragma unroll
    for (int j = 0; j < 4; ++j) { const int n = (lane >> 3) + 8 * j; const LAS float* s = scr + (8 * c) * 33 + n;
        v4u o; o.x = pk2(s[0 * 33], s[1 * 33]); o.y = pk2(s[2 * 33], s[3 * 33]); o.z = pk2(s[4 * 33], s[5 * 33]); o.w = pk2(s[6 * 33], s[7 * 33]);
        *(GAS v4u*)(WT + (size_t)map_row(mode, n0 + n) * (ldw ? ldw : K) + k0 + 8 * c) = o; }
    LDS_WAIT(); asm volatile("" ::: "memory");
}
__device__ __forceinline__ unsigned pk4_f8(float a, float b, float c, float d) { int w = __builtin_amdgcn_cvt_pk_fp8_f32(a, b, 0, false); w = __builtin_amdgcn_cvt_pk_fp8_f32(c, d, w, true); return (unsigned)w; }
__device__ __forceinline__ void p0_transpose_item_f8(const float* W, int K, int N, unsigned char* W8, int mode, float wscale, LAS float* scr, int item, int lane) {
    const int nblk = N / 32, kb = item / nblk, nb = item % nblk, k0 = 64 * kb, n0 = 32 * nb;
    float v[32];
#pragma unroll
    for (int i = 0; i < 32; ++i) { const int kk = 2 * i + (lane >> 5); v[i] = W[(size_t)(k0 + kk) * N + n0 + (lane & 31)]; }
#pragma unroll
    for (int i = 0; i < 32; ++i) { const int kk = 2 * i + (lane >> 5); scr[kk * 33 + (lane & 31)] = v[i] * wscale; }
    LDS_WAIT(); asm volatile("" ::: "memory");
    const int n = lane >> 1, half = lane & 1; const LAS float* s = scr + (32 * half) * 33 + n;
    v4u o0, o1;
    o0.x = pk4_f8(s[0 * 33], s[1 * 33], s[2 * 33], s[3 * 33]);     o0.y = pk4_f8(s[4 * 33], s[5 * 33], s[6 * 33], s[7 * 33]);     o0.z = pk4_f8(s[8 * 33], s[9 * 33], s[10 * 33], s[11 * 33]);   o0.w = pk4_f8(s[12 * 33], s[13 * 33], s[14 * 33], s[15 * 33]);
    o1.x = pk4_f8(s[16 * 33], s[17 * 33], s[18 * 33], s[19 * 33]); o1.y = pk4_f8(s[20 * 33], s[21 * 33], s[22 * 33], s[23 * 33]); o1.z = pk4_f8(s[24 * 33], s[25 * 33], s[26 * 33], s[27 * 33]); o1.w = pk4_f8(s[28 * 33], s[29 * 33], s[30 * 33], s[31 * 33]);
    GAS v4u* dst = (GAS v4u*)(W8 + (size_t)map_row(mode, n0 + n) * K + k0 + 32 * half); dst[0] = o0; dst[1] = o1;
    LDS_WAIT(); asm volatile("" ::: "memory");
}
__device__ __forceinline__ void p0_colmax_item(const float* W, int N, float* CM, int mode, int item, int lane) {
    const int nblk = N / 32, kb = item / nblk, nb = item % nblk, k0 = 64 * kb, n0 = 32 * nb;
    float v[32];
#pragma unroll
    for (int i = 0; i < 32; ++i) { const int kk = 2 * i + (lane >> 5); v[i] = W[(size_t)(k0 + kk) * N + n0 + (lane & 31)]; }
    float m = 0.f;
#pragma unroll
    for (int i = 0; i < 32; ++i) m = fmaxf(m, fabsf(v[i]));
    __hip_atomic_fetch_max((unsigned*)CM + map_row(mode, n0 + (lane & 31)), __float_as_uint(m), __ATOMIC_RELAXED, __HIP_MEMORY_SCOPE_AGENT);
}
__device__ __forceinline__ void p0_transpose_item_i8(const float* W, int K, int N, unsigned char* W8, int mode, const float* CM, LAS float* scr, int item, int lane) {
    const int nblk = N / 32, kb = item / nblk, nb = item % nblk, k0 = 64 * kb, n0 = 32 * nb;
    float v[32];
#pragma unroll
    for (int i = 0; i < 32; ++i) { const int kk = 2 * i + (lane >> 5); v[i] = W[(size_t)(k0 + kk) * N + n0 + (lane & 31)]; }
#pragma unroll
    for (int i = 0; i < 32; ++i) { const int kk = 2 * i + (lane >> 5); scr[kk * 33 + (lane & 31)] = v[i]; }
    LDS_WAIT(); asm volatile("" ::: "memory");
    const int n = lane >> 1, half = lane & 1; const LAS float* s = scr + (32 * half) * 33 + n; const int row = map_row(mode, n0 + n);
    const float q = 127.f / fmaxf(__hip_atomic_load(CM + row, __ATOMIC_RELAXED, __HIP_MEMORY_SCOPE_AGENT), 1e-30f);
    v4u o0, o1;
    o0.x = pk4_i8(s[0 * 33] * q, s[1 * 33] * q, s[2 * 33] * q, s[3 * 33] * q);     o0.y = pk4_i8(s[4 * 33] * q, s[5 * 33] * q, s[6 * 33] * q, s[7 * 33] * q);     o0.z = pk4_i8(s[8 * 33] * q, s[9 * 33] * q, s[10 * 33] * q, s[11 * 33] * q);   o0.w = pk4_i8(s[12 * 33] * q, s[13 * 33] * q, s[14 * 33] * q, s[15 * 33] * q);
    o1.x = pk4_i8(s[16 * 33] * q, s[17 * 33] * q, s[18 * 33] * q, s[19 * 33] * q); o1.y = pk4_i8(s[20 * 33] * q, s[21 * 33] * q, s[22 * 33] * q, s[23 * 33] * q); o1.z = pk4_i8(s[24 * 33] * q, s[25 * 33] * q, s[26 * 33] * q, s[27 * 33] * q); o1.w = pk4_i8(s[28 * 33] * q, s[29 * 33] * q, s[30 * 33] * q, s[31 * 33] * q);
    GAS v4u* dst = (GAS v4u*)(W8 + (size_t)row * K + k0 + 32 * half); dst[0] = o0; dst[1] = o1;
    LDS_WAIT(); asm volatile("" ::: "memory");
}
__device__ __forceinline__ void normmod_row(const float* xrow, const float* gm, const float* sh, bf16* orow, int lane, unsigned* o8row = nullptr, float* qstep = nullptr) {
    const GAS f32x4* xr = (const GAS f32x4*)xrow + lane;
    f32x4 v[16]; float s = 0.f;
#pragma unroll
    for (int j = 0; j < 16; ++j) { v[j] = xr[64 * j]; s += (v[j].x * v[j].x + v[j].y * v[j].y) + (v[j].z * v[j].z + v[j].w * v[j].w); }
    const float rstd = 1.f / sqrtf(wave_sum(s) * (1.f / DM) + NORM_EPS);
    GAS unsigned long long* o8 = (GAS unsigned long long*)orow + lane;
    const GAS f32x4* g4 = (const GAS f32x4*)gm + lane; const GAS f32x4* s4 = (const GAS f32x4*)sh + lane;
    if (qstep) {
        float am = 0.f;
#pragma unroll
        for (int j = 0; j < 16; ++j) { const f32x4 g = g4[64 * j], b = s4[64 * j]; v[j] = v[j] * rstd * g + b; am = fmaxf(am, fmaxf(fmaxf(fabsf(v[j].x), fabsf(v[j].y)), fmaxf(fabsf(v[j].z), fabsf(v[j].w)))); }
        am = fmaxf(wave_max(am), 1e-30f); const float inv = 127.f / am; if (lane == 0) *qstep = am * (1.f / 127.f);
#pragma unroll
        for (int j = 0; j < 16; ++j) { if (orow) o8[64 * j] = (unsigned long long)pk2(v[j].x, v[j].y) | ((unsigned long long)pk2(v[j].z, v[j].w) << 32);
            ((GAS unsigned*)o8row)[lane + 64 * j] = pk4_i8(v[j].x * inv, v[j].y * inv, v[j].z * inv, v[j].w * inv); }
        return; }
#pragma unroll
    for (int j = 0; j < 16; ++j) { const f32x4 g = g4[64 * j], b = s4[64 * j]; const f32x4 y = v[j] * rstd * g + b;
        if (orow) o8[64 * j] = (unsigned long long)pk2(y.x, y.y) | ((unsigned long long)pk2(y.z, y.w) << 32);
        if (o8row) ((GAS unsigned*)o8row)[lane + 64 * j] = pk4_f8(y.x, y.y, y.z, y.w); }
}

__device__ __forceinline__ void normmod_row_b(const bf16* xrow, const float* gm, const float* sh, bf16* orow, unsigned char* qrow, float* qstep, int lane) {
    const GAS v4u* xr = (const GAS v4u*)xrow + lane;
    f32x4 v[16]; float s = 0.f;
#pragma unroll
    for (int j = 0; j < 8; ++j) { const v4u w = xr[64 * j]; v[2 * j] = pg8::bf4_lo(w); v[2 * j + 1] = pg8::bf4_hi(w); }
#pragma unroll
    for (int j = 0; j < 16; ++j) s += (v[j].x * v[j].x + v[j].y * v[j].y) + (v[j].z * v[j].z + v[j].w * v[j].w);
    const float rstd = 1.f / sqrtf(wave_sum(s) * (1.f / DM) + NORM_EPS);
    float am = 0.f;
#pragma unroll
    for (int j = 0; j < 8; ++j) { const GAS f32x4* g4 = (const GAS f32x4*)gm + 2 * (lane + 64 * j); const GAS f32x4* s4 = (const GAS f32x4*)sh + 2 * (lane + 64 * j);
        v[2 * j] = v[2 * j] * rstd * g4[0] + s4[0]; v[2 * j + 1] = v[2 * j + 1] * rstd * g4[1] + s4[1]; }
#pragma unroll
    for (int j = 0; j < 16; ++j) am = fmaxf(am, fmaxf(fmaxf(fabsf(v[j].x), fabsf(v[j].y)), fmaxf(fabsf(v[j].z), fabsf(v[j].w))));
    am = fmaxf(wave_max(am), 1e-30f); const float inv = 127.f / am; if (lane == 0) *qstep = am * (1.f / 127.f);
    GAS v4u* o16 = (GAS v4u*)orow + lane;
#pragma unroll
    for (int j = 0; j < 8; ++j) { v4u o; o.x = pk2(v[2 * j].x, v[2 * j].y); o.y = pk2(v[2 * j].z, v[2 * j].w); o.z = pk2(v[2 * j + 1].x, v[2 * j + 1].y); o.w = pk2(v[2 * j + 1].z, v[2 * j + 1].w); o16[64 * j] = o; }
    GAS unsigned long long* o8 = (GAS unsigned long long*)qrow + lane;
#pragma unroll
    for (int j = 0; j < 8; ++j) o8[64 * j] = (unsigned long long)pk4_i8(v[2 * j].x * inv, v[2 * j].y * inv, v[2 * j].z * inv, v[2 * j].w * inv) | ((unsigned long long)pk4_i8(v[2 * j + 1].x * inv, v[2 * j + 1].y * inv, v[2 * j + 1].z * inv, v[2 * j + 1].w * inv) << 32);
}

__device__ __forceinline__ void quant_row_b(const bf16* xrow, unsigned char* qrow, float* qstep, int lane) {
    const GAS v4u* xr = (const GAS v4u*)xrow + lane;
    f32x4 v[16]; float am = 0.f;
#pragma unroll
    for (int j = 0; j < 8; ++j) { const v4u w = xr[64 * j]; v[2 * j] = pg8::bf4_lo(w); v[2 * j + 1] = pg8::bf4_hi(w); }
#pragma unroll
    for (int j = 0; j < 16; ++j) am = fmaxf(am, fmaxf(fmaxf(fabsf(v[j].x), fabsf(v[j].y)), fmaxf(fabsf(v[j].z), fabsf(v[j].w))));
    am = fmaxf(wave_max(am), 1e-30f); const float inv = 127.f / am; if (lane == 0) *qstep = am * (1.f / 127.f);
    GAS unsigned long long* o8 = (GAS unsigned long long*)qrow + lane;
#pragma unroll
    for (int j = 0; j < 8; ++j) o8[64 * j] = (unsigned long long)pk4_i8(v[2 * j].x * inv, v[2 * j].y * inv, v[2 * j].z * inv, v[2 * j].w * inv) | ((unsigned long long)pk4_i8(v[2 * j + 1].x * inv, v[2 * j + 1].y * inv, v[2 * j + 1].z * inv, v[2 * j + 1].w * inv) << 32);
}

#ifdef SELFCHECK
#ifndef CHK_BREAK
#define CHK_BREAK 0
#endif
#define Z_REL 0.08f
#define Z_ABSX 8.f
namespace chk {
constexpr int CW_CHK = 2;
#define BRK(bit, v) (((CHK_BREAK >> (bit)) & 1) ? (v) * 1.1f + 0.1f : (v))
__device__ __forceinline__ unsigned hsh(unsigned x) { x *= 2654435761u; x ^= x >> 15; x *= 2246822519u; x ^= x >> 13; x *= 3266489917u; x ^= x >> 16; return x; }
__device__ __forceinline__ float bfv(const bf16* p) { return __uint_as_float(((unsigned)*p) << 16); }
__device__ __forceinline__ float f8v(const unsigned char* p) { const unsigned b = *p, e = (b >> 3) & 15u, m = b & 7u; const float mag = e ? exp2f((float)e - 7.f) * (1.f + (float)m * 0.125f) : (float)m * 0.001953125f; return (b & 128u) ? -mag : mag; }
__device__ __forceinline__ float wsum(float v) {
#pragma unroll
    for (int o = 1; o < 64; o <<= 1) v += __shfl_xor(v, o);
    return v; }
__device__ __forceinline__ void fail(gu32* ctl, int bit) { __hip_atomic_fetch_or((unsigned*)(ctl + CW_CHK), 1u << bit, __ATOMIC_RELAXED, __HIP_MEMORY_SCOPE_AGENT); }
__device__ __forceinline__ bool close(float got, float ref, float rel, float abs_) { const float d = fabsf(got - ref); return d <= rel * fabsf(ref) + abs_ && d == d; }
__device__ __forceinline__ float sigm(float x) { return 1.f / (1.f + expf(-x)); }
__device__ __forceinline__ float mod_ref(const float* cvec, const float* w_ada, const float* b_ada, int b, int j, int lane) {
    float s = 0.f; for (int k = lane; k < 4096; k += 64) { const float cv = cvec[b * 4096 + k]; s += (cv / (1.f + expf(-cv))) * w_ada[(size_t)k * 24576 + j]; }
    return wsum(s) + b_ada[j]; }
__device__ __forceinline__ float dot_col(const bf16* arow, const float* W, int K, int N, int n, int lane) {
    float s = 0.f; for (int k = lane; k < K; k += 64) s += bfv(arow + k) * W[(size_t)k * N + n];
    return wsum(s); }
__device__ __forceinline__ void rope_cs(int pos, int i, int dim, float& c, float& s) { const float inv = exp2f(-(float)(2 * i) / (float)dim * 13.287712379549449f); const float ang = (float)pos * inv; sincos_d((double)ang, s, c); }

__device__ __forceinline__ void chk_h(gu32* ctl, const float* x, const float* cvec, const float* w_ada, const float* b_ada, const float* norm1_g, const bf16* HB, const float* VEC, int gw, int NGW, int lane) {
    for (int sidx = gw; sidx < 512; sidx += NGW) { const unsigned h = hsh(sidx + 1000); const int row = h & 16383, col = (h >> 14) & 4095, b = row >> 12;
        float ss = 0.f; for (int k = lane; k < 4096; k += 64) { const float v = x[(size_t)row * 4096 + k]; ss += v * v; }
        const float rstd = 1.f / sqrtf(wsum(ss) / 4096.f + 1e-6f);
        const float sh1 = mod_ref(cvec, w_ada, b_ada, b, col, lane), sc1 = mod_ref(cvec, w_ada, b_ada, b, 4096 + col, lane), g1 = mod_ref(cvec, w_ada, b_ada, b, 8192 + col, lane);
        const float ref = x[(size_t)row * 4096 + col] * rstd * norm1_g[col] * (1.f + sc1) + sh1;
        if (!close(bfv(HB + (size_t)row * 4096 + col), ref, 0.01f, 0.01f)) fail(ctl, 0);
        if (!close(VEC[(2 * 4 + b) * 4096 + col], g1, 1e-3f, 1e-4f)) fail(ctl, 7); } }
__device__ __forceinline__ void chk_z(gu32* ctl, const bf16* HB, const float* w_in, const int* positions, const bf16* ZQ, const bf16* ZKV, const bf16* ZKR, const bf16* QD, const bf16* KD, const bf16* VD, const bf16* GA, const bf16* GB, int gw, int NGW, int lane) {
    for (int sidx = gw; sidx < 4096; sidx += NGW) { const unsigned h = hsh(sidx + 5000); const int row = h & 16383; int n = (int)((h >> 14) % 19008u);
        if ((sidx & 3) == 0) n = 1536 + (int)((h >> 14) & 63);
        const int b = row >> 12, s = row & 4095; const bf16* hrow = HB + (size_t)row * 4096;
        const float z = dot_col(hrow, w_in, 4096, 19008, n, lane); float got, ref = z, at = 0.03f;
        if (n < 1024) got = bfv(ZQ + (size_t)row * 1024 + n);
        else if (n < 1536) got = bfv(ZKV + (size_t)row * 512 + (n - 1024));
        else if (n < 1600) { const int r = n - 1536; got = bfv(ZKR + (size_t)row * 256 + (r >> 5) * 128 + (r & 31)); }
        else if (n < 10816) { const int r = n - 1600, t = r / 3072, rr = r % 3072, g8 = rr >> 7, d = rr & 127; const bf16* buf = t == 0 ? QD : (t == 1 ? KD : VD);
            got = bfv(buf + ((size_t)(b * 24 + g8) * 4096 + s) * 128 + d);
            if (t < 2) { const int i = d & 63; float c, sn; rope_cs(positions[row], i, 128, c, sn); const float zp = dot_col(hrow, w_in, 4096, 19008, d < 64 ? n + 64 : n - 64, lane);
                ref = d < 64 ? z * c - zp * sn : z * c + zp * sn; } }
        else { const int r = n - 10816; got = (float)((const unsigned char*)(r < 4096 ? GA : GB))[(size_t)row * 4096 + (r & 4095)] * (1.f / 255.f); ref = sigm(z); at = 0.008f; }
        if (!close(BRK(1, got), ref, Z_REL, at * Z_ABSX)) fail(ctl, 1);
        if (lane == 0 && n < 10816) { atomicAdd((float*)(ctl + 8), (got - ref) * (got - ref)); atomicAdd((float*)(ctl + 9), ref * ref); } } }
__device__ __forceinline__ void chk_p4(gu32* ctl, const bf16* ZQ, const bf16* ZKV, const bf16* ZKR, const float* qg, const float* kvg, const int* positions, const bf16* QN, const bf16* KVN, const unsigned char* KR8, int gw, int NGW, int lane) {
    for (int sidx = gw; sidx < 1024; sidx += NGW) { const unsigned h = hsh(sidx + 9000); const int row = h & 16383;
        float ss = 0.f; for (int k = lane; k < 1024; k += 64) { const float v = bfv(ZQ + (size_t)row * 1024 + k); ss += v * v; }
        const float rq = 1.f / sqrtf(wsum(ss) / 1024.f + 1e-6f); const int cq = lane * 16 + ((h >> 14) & 15);
        if (!close(bfv(QN + (size_t)row * 1024 + cq), bfv(ZQ + (size_t)row * 1024 + cq) * rq * qg[cq], 0.01f, 0.01f)) fail(ctl, 2);
        ss = 0.f; for (int k = lane; k < 512; k += 64) { const float v = bfv(ZKV + (size_t)row * 512 + k); ss += v * v; }
        const float rk = 1.f / sqrtf(wsum(ss) / 512.f + 1e-6f); const int ck = lane * 8 + ((h >> 18) & 7);
        if (!close(bfv(KVN + (size_t)row * 512 + ck), bfv(ZKV + (size_t)row * 512 + ck) * rk * kvg[ck], 0.01f, 0.01f)) fail(ctl, 2);
        { const int d = lane, i = d & 31; float c, sn; rope_cs(positions[row], i, 64, c, sn);
          const float x1 = bfv(ZKR + (size_t)row * 256 + i), x2 = bfv(ZKR + (size_t)row * 256 + 128 + i); const float ref = d < 32 ? x1 * c - x2 * sn : x2 * c + x1 * sn;
          if (!close(f8v(KR8 + (size_t)row * 64 + d), ref, 0.07f, 0.02f)) fail(ctl, 2); } } }
__device__ __forceinline__ void chk_p5(gu32* ctl, const bf16* QN, const bf16* KVN, const float* w_uq, const float* w_ukv, const int* positions, const unsigned char* Q8, const unsigned char* K8, const unsigned char* V8T, int gw, int NGW, int lane) {
    for (int sidx = gw; sidx < 2048; sidx += NGW) { const unsigned h = hsh(sidx + 13000); const int row = h & 16383, b = row >> 12, s = row & 4095;
        { const int n = (int)((h >> 14) % 3072u), hd = n / 192, c = n % 192; const bf16* arow = QN + (size_t)row * 1024; float ref = dot_col(arow, w_uq, 1024, 3072, n, lane);
          if (c >= 128) { const int r = c - 128, i = r & 31; float cs, sn; rope_cs(positions[row], i, 64, cs, sn); const float zp = dot_col(arow, w_uq, 1024, 3072, r < 32 ? n + 32 : n - 32, lane); ref = r < 32 ? ref * cs - zp * sn : ref * cs + zp * sn; }
          if (!close(f8v(Q8 + ((size_t)(b * 16 + hd) * 4096 + s) * 192 + c), ref, 0.08f, 0.04f)) fail(ctl, 3); }
        { const int n = (int)((h >> 9) & 4095); const float ref = dot_col(KVN + (size_t)row * 512, w_ukv, 512, 4096, n, lane);
          const int hd2 = n >> 8, cc = n & 255; const size_t ro = ((size_t)(b * 16 + hd2) * 4096 + s) * 128;
          if (cc < 128) { if (!close(f8v(K8 + ro + cc), ref, 0.08f, 0.04f)) fail(ctl, 3); } else { const int dd = cc - 128; if (!close(f8v(V8T + (((size_t)(b * 16 + hd2) * 64 + (s >> 6)) * 128 + dd) * 64 + att::vpos(s & 63)), ref, 0.08f, 0.04f)) fail(ctl, 3); } } } }
__device__ __forceinline__ void chk_mla(gu32* ctl, const unsigned char* Q8, const unsigned char* K8, const unsigned char* V8T, const unsigned char* KR8, const bf16* Y, LAS float* scr, int sample, int tid) {
    const unsigned h = hsh(sample + 17000); const int b = h & 3, hd = (h >> 2) & 15, row = (h >> 6) & 4095;
    LAS float* q = scr; LAS float* sc = scr + 256; LAS float* red = scr + 256 + 4096;
    __syncthreads();
    if (tid < 192) q[tid] = f8v(Q8 + ((size_t)(b * 16 + hd) * 4096 + row) * 192 + tid);
    __syncthreads();
    float mx = -1e30f;
    for (int k = tid; k < 4096; k += 512) { const unsigned char* kr = K8 + ((size_t)(b * 16 + hd) * 4096 + k) * 128; const unsigned char* rr = KR8 + ((size_t)b * 4096 + k) * 64; float s = 0.f;
        for (int d = 0; d < 128; ++d) s += q[d] * f8v(kr + d);
        for (int d = 0; d < 64; ++d) s += q[128 + d] * f8v(rr + d);
        s *= 0.07216878364870323f; sc[k] = s; mx = fmaxf(mx, s); }
    red[tid] = mx; __syncthreads();
    for (int o = 256; o > 0; o >>= 1) { if (tid < o) red[tid] = fmaxf(red[tid], red[tid + o]); __syncthreads(); }
    mx = red[0]; __syncthreads();
    float sm = 0.f; for (int k = tid; k < 4096; k += 512) { const float p = expf(sc[k] - mx); sc[k] = p; sm += p; }
    red[tid] = sm; __syncthreads();
    for (int o = 256; o > 0; o >>= 1) { if (tid < o) red[tid] += red[tid + o]; __syncthreads(); }
    sm = red[0]; __syncthreads();
    const int d = tid & 127, part = tid >> 7; float acc = 0.f;
    for (int k = part * 1024; k < part * 1024 + 1024; ++k) acc += sc[k] * f8v(V8T + (((size_t)(b * 16 + hd) * 64 + (k >> 6)) * 128 + d) * 64 + att::vpos(k & 63));
    red[tid] = acc; __syncthreads();
    if (tid < 128) { const float ref = (red[tid] + red[tid + 128] + red[tid + 256] + red[tid + 384]) / sm; red[tid] = ref; }
    __syncthreads();
    float r2 = 0.f; for (int i = 0; i < 128; ++i) r2 += red[i] * red[i]; const float rms = sqrtf(r2 / 128.f);
    if (tid < 128) { const float got = bfv(Y + ((size_t)b * 4096 + row) * 3072 + hd * 128 + tid); if (!close(BRK(4, got), red[tid], 0.06f, 0.06f * rms)) fail(ctl, 4);     }
    __syncthreads();
}
__device__ __forceinline__ void chk_dil(gu32* ctl, const bf16* QD, const bf16* KD, const bf16* VD, const bf16* Y, LAS float* scr, int sample, int tid) {
    const unsigned h = hsh(sample + 23000); const int b = h & 3, hd = (h >> 2) & 7; int s = (h >> 5) & 4095; if ((sample & 7) == 0) s = (sample >> 3) & 63; if ((sample & 7) == 1) s = 4095 - ((sample >> 3) & 63);
    LAS float* sc = scr; LAS float* red = scr + 512;
    __syncthreads();
    float v = -1e30f;
    if (tid < 387) { const int g = tid / 129, j = tid % 129, dd = g == 0 ? 1 : (g == 1 ? 4 : 16), idx = s + (j - 64) * dd;
        if (idx >= 0 && idx < 4096) { const bf16* qp = QD + ((size_t)(b * 24 + g * 8 + hd) * 4096 + s) * 128; const bf16* kp = KD + ((size_t)(b * 24 + g * 8 + hd) * 4096 + idx) * 128; float a = 0.f;
            for (int d = 0; d < 128; ++d) a += bfv(qp + d) * bfv(kp + d);
            v = a * 0.08838834764831845f; } }
    if (tid < 387) sc[tid] = v;
    red[tid] = v; __syncthreads();
    for (int o = 256; o > 0; o >>= 1) { if (tid < o) red[tid] = fmaxf(red[tid], red[tid + o]); __syncthreads(); }
    const float mx = red[0]; __syncthreads();
    float p = 0.f; if (tid < 387 && v > -1e29f) p = expf(v - mx); if (tid < 387) sc[tid] = p;
    red[tid] = p; __syncthreads();
    for (int o = 256; o > 0; o >>= 1) { if (tid < o) red[tid] += red[tid + o]; __syncthreads(); }
    const float sm = red[0]; __syncthreads();
    if (tid < 128) { float acc = 0.f;
        for (int t = 0; t < 387; ++t) { const int g = t / 129, j = t % 129, dd = g == 0 ? 1 : (g == 1 ? 4 : 16), idx = s + (j - 64) * dd; if (idx < 0 || idx >= 4096) continue;
            acc += sc[t] * bfv(VD + ((size_t)(b * 24 + g * 8 + hd) * 4096 + idx) * 128 + tid); }
        red[tid] = acc / sm; }
    __syncthreads();
    float r2 = 0.f; for (int i = 0; i < 128; ++i) r2 += red[i] * red[i]; const float rms = sqrtf(r2 / 128.f);
    if (tid < 128) { const float got = bfv(Y + ((size_t)b * 4096 + s) * 3072 + 2048 + hd * 128 + tid); if (!close(BRK(5, got), red[tid], 0.03f, 0.03f * rms)) fail(ctl, 5); }
    __syncthreads();
}
__device__ __forceinline__ void chk_mix(gu32* ctl, const bf16* Y, const bf16* GA, const bf16* GB, const float* wpa, const float* wpb, const bf16* MIXED, int gw, int NGW, int lane) {
    for (int sidx = gw; sidx < 2048; sidx += NGW) { const unsigned h = hsh(sidx + 29000); const int row = h & 16383, col = (h >> 14) & 4095; const bf16* yr = Y + (size_t)row * 3072;
        const float pa = dot_col(yr, wpa, 2048, 4096, col, lane), pb = dot_col(yr + 2048, wpb, 1024, 4096, col, lane);
        const float ref = (float)((const unsigned char*)GA)[(size_t)row * 4096 + col] * (1.f / 255.f) * pa + fmaxf((float)((const unsigned char*)GB)[(size_t)row * 4096 + col], 1.f) * (1.f / 255.f) * pb;
        if (!close(bfv(MIXED + (size_t)row * 4096 + col), ref, 0.03f, 0.002f)) fail(ctl, 6); } }
__device__ __forceinline__ void chk_x1(gu32* ctl, const float* x, const bf16* MIXED, const float* w_out, const float* VEC, const bf16* X1B, int gw, int NGW, int lane) {
    for (int sidx = gw; sidx < 8192; sidx += NGW) { const unsigned h = hsh(sidx + 31000); const int row = h & 16383, col = (h >> 14) & 4095, b = row >> 12; const float xv = x[(size_t)row * 4096 + col];
        if (fabsf(xv) > 0.12f) continue;
        const float br = VEC[(2 * 4 + b) * 4096 + col] * dot_col(MIXED + (size_t)row * 4096, w_out, 4096, 4096, col, lane);
        if (!close(bfv(X1B + (size_t)row * 4096 + col) - xv, br, 0.15f, 0.003f)) fail(ctl, 8);
        if (lane == 0) { atomicAdd((float*)(ctl + 10), br * br); atomicAdd((float*)(ctl + 11), 1.f); } } }
}
#endif

struct Args { const float* in[19]; float* out; unsigned char* ws; int ph_lo, ph_hi, li, pad; };
__global__ void __launch_bounds__(NWAVES * 64, 2) mk_fwd(Args args) {
    extern __shared__ __attribute__((aligned(16))) unsigned char lds[];
    Frame F;
    F.lds = (LAS unsigned char*)lds;
    F.MISC = (volatile LAS unsigned*)(F.lds + MISC_OFF);
    F.tid = threadIdx.x; F.lane = F.tid & 63; F.wave = __builtin_amdgcn_readfirstlane(F.tid >> 6);
    F.G = gridDim.x; { const int bx = blockIdx.x; F.vcu = (F.G % 8 == 0) ? (bx % 8) * (F.G / 8) + bx / 8 : bx; }
    unsigned char* ws = args.ws;
    F.ctl = (gu32*)(ws + WS_CTL);
    const float* x = args.in[0]; const float* cvec = args.in[1]; const int* positions = (const int*)args.in[2];
    const float* w_ada = args.in[3]; const float* b_ada = args.in[4]; const float* norm1_g = args.in[5]; const float* w_in = args.in[6];
    const float* q_norm_g = args.in[7]; const float* w_uq = args.in[8]; const float* kv_norm_g = args.in[9]; const float* w_ukv = args.in[10];
    const float* w_proj_a = args.in[11]; const float* w_proj_b = args.in[12]; const float* w_out = args.in[13]; const float* norm2_g = args.in[14];
    const float* w_gate = args.in[15]; const float* w_up = args.in[16]; const float* w_down = args.in[17]; const float* final_g = args.in[18];
    float* out = args.out;
    float* MOD = (float*)(ws + WS_MOD); float* VEC = (float*)(ws + WS_VEC); float* MODP = (float*)(ws + WS_MODP);
    float* COSF = (float*)(ws + WS_COSF); float* SINF = (float*)(ws + WS_SINF); float* COSR = (float*)(ws + WS_COSR); float* SINR = (float*)(ws + WS_SINR);
    bf16* KROPE = (bf16*)(ws + WS_KROPE); float* LSE = (float*)(ws + WS_LSE);
    unsigned char* WOUT8 = ws + WS_WOUT; unsigned char* MIXQ = ws + WS_VD; float* CM3 = (float*)(ws + WS_CTL + 384 * 1024); float* SA3 = (float*)(ws + WS_CTL + 768 * 1024);
    unsigned char* WGU8 = ws + WS_WGU; unsigned char* H2Q = ws + WS_X2B;
    float* CM1 = (float*)(ws + WS_CTL + 128 * 1024); float* CM2 = (float*)(ws + WS_CTL + 256 * 1024); float* SA1 = (float*)(ws + WS_CTL + 512 * 1024); float* SA2 = (float*)(ws + WS_CTL + 640 * 1024);
    unsigned char* WIN8 = ws + WS_WIN + (NBF > 0 ? 80 : 0) * MiB;     unsigned char* H8 = ws + WS_H8;
    bf16 *WIN = (bf16*)(ws + WS_WIN), *WUQ = (bf16*)(ws + WS_WUQ), *WUKV = (bf16*)(ws + WS_WUKV), *WPA = (bf16*)(ws + WS_WPA), *WPB = (bf16*)(ws + WS_WPB), *WOUT = (bf16*)(ws + WS_WOUT), *WGU = (bf16*)(ws + WS_WGU), *WDN = (bf16*)(ws + WS_WDN);
    bf16 *HB = (bf16*)(ws + WS_A), *QB = (bf16*)(ws + WS_A), *H2 = (bf16*)(ws + WS_A);
    bf16 *QD = (bf16*)(ws + WS_QD), *KD = (bf16*)(ws + WS_KD), *VD = (bf16*)(ws + WS_VD), *MIXED = (bf16*)(ws + WS_QD), *AFF = (bf16*)(ws + WS_QD);
    bf16 *GA = (bf16*)(ws + WS_GA), *GB = (bf16*)(ws + WS_GB);
    bf16 *ZQ = (bf16*)(ws + WS_ZQ), *ZKV = (bf16*)(ws + WS_ZKV), *ZKR = (bf16*)(ws + WS_ZKR), *QN = (bf16*)(ws + WS_QN), *KVN = (bf16*)(ws + WS_KVN), *PD = (bf16*)(ws + WS_PD);
    unsigned char* Q8 = ws + WS_A; unsigned char* K8 = ws + WS_KV; unsigned char* V8T = ws + WS_KV + 32 * MiB; unsigned char* KR8 = ws + WS_KROPE;
    bf16 *KV = (bf16*)(ws + WS_KV), *YA = (bf16*)(ws + WS_YA), *YB = (bf16*)(ws + WS_YB), *X1B = (bf16*)(ws + WS_X1B), *X2B = (bf16*)(ws + WS_X2B);

    for (int u = F.tid; u < (LDS_BYTES - LDSCTL_OFF) / 4; u += NWAVES * 64) ((LAS unsigned*)(F.lds + LDSCTL_OFF))[u] = 0u;
    __syncthreads();
    XcdBarrier bar; bar.bar = (unsigned*)(F.ctl + CW_BAR); bar.x = 0; bar.st = nullptr;
    if (N_LAUNCHES == 1) bar = xcd_barrier_post((unsigned*)(F.ctl + CW_BAR), F.MISC + 8);
#define GRID_BAR() do { if (N_LAUNCHES == 1) xcd_barrier(bar); } while (0)
    const int lo = args.ph_lo, hi = args.ph_hi;
#ifndef PHASE_MASK
#define PHASE_MASK 0x3fff
#endif
#define IN(k) (((PHASE_MASK >> (k)) & 1) && lo <= (k) && (k) < hi)
#define BOTH(k) (IN(k) && IN((k) + 1))
#ifndef REPEAT_MASK
#define REPEAT_MASK 0
#endif
#define REP(k)
#define RPT(k) ((REPEAT_MASK >> (k)) & 1)
    const int gw = F.vcu * NWAVES + F.wave, NGW = F.G * NWAVES;
    const int NGT = F.G * NWAVES * 64;
#define OPQ_TID() ({ int t_ = (int)threadIdx.x; asm volatile("" : "+v"(t_)); t_; })
#define gt ((int)blockIdx.x * (NWAVES * 64) + OPQ_TID())
#define LANE() (OPQ_TID() & 63)

    if (IN(0)) { REP(0) {
        { LAS float* scv = (LAS float*)(F.lds + RING_OFF);
          for (int it = blockIdx.x; it < KSPLIT * 12; it += F.G) {
              const int kc = it / 12, cb = it % 12;
              __syncthreads();
              if (OPQ_TID() < 256) { const int k = OPQ_TID() >> 2, b = OPQ_TID() & 3; const float cv = cvec[b * DM + kc * 64 + k]; scv[k * 4 + b] = cv / (1.f + expf(-cv)); }
              __syncthreads();
              const int col = cb * 2048 + 4 * OPQ_TID();
              f32x4 a0 = {0.f, 0.f, 0.f, 0.f}, a1 = a0, a2 = a0, a3 = a0;
              const float* wp = w_ada + (size_t)(kc * 64) * N_MOD + col;
#pragma unroll 8
              for (int k = 0; k < 64; ++k) { const f32x4 w = *(const GAS f32x4*)(wp + (size_t)k * N_MOD); const f32x4 s = *(const LAS f32x4*)(scv + k * 4);
                  a0 += s.x * w; a1 += s.y * w; a2 += s.z * w; a3 += s.w * w; }
              float* mp = MODP + (size_t)(kc * 4) * N_MOD + col;
              *(GAS f32x4*)(mp) = a0; *(GAS f32x4*)(mp + N_MOD) = a1; *(GAS f32x4*)(mp + 2 * N_MOD) = a2; *(GAS f32x4*)(mp + 3 * N_MOD) = a3;
          }
          __syncthreads(); }
        for (int e = gt; e < M * 64; e += NGT) { const int row = e >> 6, i = e & 63; const float ang = (float)positions[row] * INVF[i]; float s, c; sincos_d((double)ang, s, c); COSF[e] = c; SINF[e] = s; }
        for (int e = gt; e < M * 32; e += NGT) { const int row = e >> 5, i = e & 31; const float ang = (float)positions[row] * INVF[2 * i]; float s, c; sincos_d((double)ang, s, c); COSR[e] = c; SINR[e] = s; }
        for (int e = gt; e < 192 * (DM / 16); e += NGT) { const int rr = e / (DM / 16), c16 = e % (DM / 16); const int row = (74 - NBF) * 256 + (rr / 96) * 128 + 32 + (rr % 96);
            *(GAS v4u*)(WIN8 + (size_t)row * DM + c16 * 16) = (v4u){0u, 0u, 0u, 0u}; }
        { LAS float* scr = (LAS float*)(F.lds + RING_OFF + F.wave * 16384);
          constexpr int I_IN = (DM / 64) * (IN_TOTAL / 32), I_UQ = (QRANK / 64) * (3072 / 32), I_UKV = (KVRANK / 64) * (4096 / 32), I_PA = (2048 / 64) * (DM / 32), I_PB = (1024 / 64) * (DM / 32),
                        I_OUT = (DM / 64) * (DM / 32), I_G = (DM / 64) * (DFF / 32), I_DN = (DFF / 64) * (DM / 32);
          constexpr int NITEMS = I_IN + I_UQ + I_UKV + I_PA + I_PB + I_OUT + 2 * I_G;
          for (int it = gw; it < NITEMS * (1 + RPT(0)); it += NGW) {
              int r = it % NITEMS;
              if (r < I_IN) { const int n0_ = 32 * (r % (IN_TOTAL / 32));
                  if (n0_ >= 1600 && n0_ < 1600 + NBF * 256) p0_transpose_item(w_in, DM, IN_TOTAL, WIN, 5, scr, r, LANE()); else p0_colmax_item(w_in, IN_TOTAL, CM1, 6, r, LANE());
                  continue; } r -= I_IN;
              if (r < I_UQ) { p0_transpose_item(w_uq, QRANK, 3072, WUQ, 2, scr, r, LANE()); continue; } r -= I_UQ;
              if (r < I_UKV) { p0_transpose_item(w_ukv, KVRANK, 4096, WUKV, 0, scr, r, LANE()); continue; } r -= I_UKV;
              if (r < I_PA) { p0_transpose_item(w_proj_a, 2048, DM, WPA, 0, scr, r, LANE(), 3072); continue; } r -= I_PA;
              if (r < I_PB) { p0_transpose_item(w_proj_b, 1024, DM, WPA + 2048, 0, scr, r, LANE(), 3072); continue; } r -= I_PB;
              if (r < I_OUT) { p0_colmax_item(w_out, DM, CM3, 0, r, LANE()); continue; } r -= I_OUT;
              if (r < I_G) { if (((32 * (r % (DFF / 32))) >> 7) < P11_T8) p0_colmax_item(w_gate, DFF, CM2, 3, r, LANE()); else p0_transpose_item(w_gate, DM, DFF, WGU, 3, scr, r, LANE()); continue; } r -= I_G;
              if (((32 * (r % (DFF / 32))) >> 7) < P11_T8) p0_colmax_item(w_up, DFF, CM2, 4, r, LANE()); else p0_transpose_item(w_up, DM, DFF, WGU, 4, scr, r, LANE());
          } }
        }
        if (BOTH(0)) GRID_BAR();
    }
    if (IN(1)) { REP(1) {
        for (int e = gt; e < BATCH * N_MOD; e += NGT) { const int b = e / N_MOD, j = e - b * N_MOD, ch = j >> 12, col = j & (DM - 1);
            float s = b_ada[j];
#pragma unroll 16
            for (int kc = 0; kc < KSPLIT; ++kc) s += MODP[(size_t)(kc * 4 + b) * N_MOD + j];
            MOD[(size_t)b * N_MOD + j] = s;
            const int slot = ch == 0 ? 1 : (ch == 1 ? 0 : (ch == 2 ? 2 : (ch == 3 ? 4 : (ch == 4 ? 3 : 5))));
            VEC[(slot * 4 + b) * DM + col] = ch == 1 ? norm1_g[col] * (1.f + s) : (ch == 4 ? norm2_g[col] * (1.f + s) : s); }
        { LAS float* scr = (LAS float*)(F.lds + RING_OFF + F.wave * 16384); constexpr int I_IN = (DM / 64) * (IN_TOTAL / 32);
          for (int it = gw; it < I_IN; it += NGW) p0_transpose_item_i8(w_in, DM, IN_TOTAL, WIN8, 6, CM1, scr, it, LANE());
          constexpr int I_OUT = (DM / 64) * (DM / 32);
          for (int it = gw; it < I_OUT; it += NGW) p0_transpose_item_i8(w_out, DM, DM, WOUT8, 0, CM3, scr, it, LANE());
          constexpr int I_G = (DM / 64) * (DFF / 32);
          for (int it = gw; it < 2 * I_G; it += NGW) { const int r = it < I_G ? it : it - I_G; if (((32 * (r % (DFF / 32))) >> 7) >= P11_T8) continue;
              if (it < I_G) p0_transpose_item_i8(w_gate, DM, DFF, WGU8, 3, CM2, scr, r, LANE()); else p0_transpose_item_i8(w_up, DM, DFF, WGU8, 4, CM2, scr, r, LANE()); } }
        }
        if (BOTH(1)) GRID_BAR();
    }
    if (IN(2)) { REP(2) {
        for (int m0 = gw; m0 < M * (1 + RPT(2)); m0 += NGW) { const int m = m0 & (M - 1), b = m >> 12; normmod_row(x + (size_t)m * DM, VEC + (0 * 4 + b) * DM, VEC + (1 * 4 + b) * DM, HB_OR_NULL(HB + (size_t)m * DM), LANE(), (unsigned*)(H8 + (size_t)m * DM), SA1 + m); }
        }
        if (BOTH(2)) GRID_BAR();
    }
    if (IN(3)) { REP(3) {
#ifdef SELFCHECK
        chk::chk_h(F.ctl, x, cvec, w_ada, b_ada, norm1_g, HB, VEC, gw, NGW, LANE());
#endif
        if constexpr (NBF > 0) { pg8::Gemm g{HB, WIN, M, NBF * 256, DM}; pg8::StaticOrder S; S.init(M, NBF * 256, F.G, (int)blockIdx.x);
          pg8::EpiZ E{ZQ, ZKV, QD, KD, VD, GA, GB, ZKR, COSF, SINF, 1};
          pg8::gemm_phase<pg8::EpiZ, pg8::StaticOrder, PG_ALIGN, PG_SP2>(F.lds + RING_OFF, g, S, E);
          if constexpr (RPT(3)) { pg8::gemm_phase<pg8::EpiZ, pg8::StaticOrder, PG_ALIGN, PG_SP2>(F.lds + RING_OFF, g, S, E); } }
        { pg8::Gemm g{(const pg8::bf16_t*)H8, (const pg8::bf16_t*)WIN8, M, (75 - NBF) * 256, DM, SA1, CM1}; pg8::StaticOrder S; S.init(M, (75 - NBF) * 256, F.G, (int)blockIdx.x);
          pg8::EpiZ E{ZQ, ZKV, QD, KD, VD, GA, GB, ZKR, COSF, SINF, 2};
          pg8::gemm_phase<pg8::EpiZ, pg8::StaticOrder, PG_ALIGN, PG_SP2, true, 121, true>(F.lds + RING_OFF, g, S, E);
          if constexpr (RPT(3)) { pg8::gemm_phase<pg8::EpiZ, pg8::StaticOrder, PG_ALIGN, PG_SP2, true, 121, true>(F.lds + RING_OFF, g, S, E); } }
        }
        if (BOTH(3)) GRID_BAR();
    }
    if (IN(4)) { REP(4) {
#ifdef SELFCHECK
        chk::chk_z(F.ctl, HB, w_in, positions, ZQ, ZKV, ZKR, QD, KD, VD, GA, GB, gw, NGW, LANE());
#endif
        for (int m = gw; m < M; m += NGW) {
            { const GAS v4u* zp = (const GAS v4u*)(ZQ + (size_t)m * QRANK); v4u a = zp[LANE()], b2 = zp[64 + LANE()];
              float f[16]; f[0] = pg8::bf_lo(a.x); f[1] = pg8::bf_hi(a.x); f[2] = pg8::bf_lo(a.y); f[3] = pg8::bf_hi(a.y); f[4] = pg8::bf_lo(a.z); f[5] = pg8::bf_hi(a.z); f[6] = pg8::bf_lo(a.w); f[7] = pg8::bf_hi(a.w);
              f[8] = pg8::bf_lo(b2.x); f[9] = pg8::bf_hi(b2.x); f[10] = pg8::bf_lo(b2.y); f[11] = pg8::bf_hi(b2.y); f[12] = pg8::bf_lo(b2.z); f[13] = pg8::bf_hi(b2.z); f[14] = pg8::bf_lo(b2.w); f[15] = pg8::bf_hi(b2.w);
              float s = 0.f;
#pragma unroll
              for (int i = 0; i < 16; ++i) s += f[i] * f[i];
              const float rstd = 1.f / sqrtf(wave_sum(s) * (1.f / QRANK) + NORM_EPS);
              const float* g0 = q_norm_g + 8 * LANE(); const float* g1 = q_norm_g + 512 + 8 * LANE();
              v4u o0, o1;
              o0.x = pk2(f[0] * rstd * g0[0], f[1] * rstd * g0[1]); o0.y = pk2(f[2] * rstd * g0[2], f[3] * rstd * g0[3]); o0.z = pk2(f[4] * rstd * g0[4], f[5] * rstd * g0[5]); o0.w = pk2(f[6] * rstd * g0[6], f[7] * rstd * g0[7]);
              o1.x = pk2(f[8] * rstd * g1[0], f[9] * rstd * g1[1]); o1.y = pk2(f[10] * rstd * g1[2], f[11] * rstd * g1[3]); o1.z = pk2(f[12] * rstd * g1[4], f[13] * rstd * g1[5]); o1.w = pk2(f[14] * rstd * g1[6], f[15] * rstd * g1[7]);
              GAS v4u* op = (GAS v4u*)(QN + (size_t)m * QRANK); op[LANE()] = o0; op[64 + LANE()] = o1; }
            { const GAS v4u* zp = (const GAS v4u*)(ZKV + (size_t)m * KVRANK); v4u a = zp[LANE()];
              float f[8]; f[0] = pg8::bf_lo(a.x); f[1] = pg8::bf_hi(a.x); f[2] = pg8::bf_lo(a.y); f[3] = pg8::bf_hi(a.y); f[4] = pg8::bf_lo(a.z); f[5] = pg8::bf_hi(a.z); f[6] = pg8::bf_lo(a.w); f[7] = pg8::bf_hi(a.w);
              float s = 0.f;
#pragma unroll
              for (int i = 0; i < 8; ++i) s += f[i] * f[i];
              const float rstd = 1.f / sqrtf(wave_sum(s) * (1.f / KVRANK) + NORM_EPS);
              const float* g0 = kv_norm_g + 8 * LANE(); v4u o0;
              o0.x = pk2(f[0] * rstd * g0[0], f[1] * rstd * g0[1]); o0.y = pk2(f[2] * rstd * g0[2], f[3] * rstd * g0[3]); o0.z = pk2(f[4] * rstd * g0[4], f[5] * rstd * g0[5]); o0.w = pk2(f[6] * rstd * g0[6], f[7] * rstd * g0[7]);
              ((GAS v4u*)(KVN + (size_t)m * KVRANK))[LANE()] = o0; }
            if (LANE() < 32) { const int i = LANE(); const float x1 = pg8::bf_lo((unsigned)ZKR[(size_t)m * 256 + i]), x2 = pg8::bf_lo((unsigned)ZKR[(size_t)m * 256 + 128 + i]);
              const float c = COSR[(size_t)m * 32 + i], s = SINR[(size_t)m * 32 + i];
              const unsigned w8 = (unsigned)__builtin_amdgcn_cvt_pk_fp8_f32(x1 * c - x2 * s, x2 * c + x1 * s, 0, false);
              KR8[(size_t)m * 64 + i] = (unsigned char)(w8 & 0xffu); KR8[(size_t)m * 64 + 32 + i] = (unsigned char)((w8 >> 8) & 0xffu); }
        }
        }
        if (BOTH(4)) GRID_BAR();
    }
    if (IN(5)) { REP(5) {
#ifdef SELFCHECK
        chk::chk_p4(F.ctl, ZQ, ZKV, ZKR, q_norm_g, kv_norm_g, positions, QN, KVN, KR8, gw, NGW, LANE());
#endif
        { pg8::Gemm g{QN, WUQ, M, 3072, QRANK}; pg8::StaticOrder S; S.init(M, 3072, F.G, (int)blockIdx.x);
          pg8::EpiQ E{Q8, COSR, SINR};
          pg8::gemm_phase<pg8::EpiQ, pg8::StaticOrder, PG_ALIGN, PG_SP2>(F.lds + RING_OFF, g, S, E); if constexpr (RPT(5)) { pg8::gemm_phase<pg8::EpiQ, pg8::StaticOrder, PG_ALIGN, PG_SP2>(F.lds + RING_OFF, g, S, E); } }
        { pg8::Gemm g{KVN, WUKV, M, 4096, KVRANK}; pg8::StaticOrder S; S.init(M, 4096, F.G, (int)blockIdx.x);
          pg8::EpiKV E{K8, V8T};
          pg8::gemm_phase<pg8::EpiKV, pg8::StaticOrder, PG_ALIGN, PG_SP2>(F.lds + RING_OFF, g, S, E); if constexpr (RPT(5)) { pg8::gemm_phase<pg8::EpiKV, pg8::StaticOrder, PG_ALIGN, PG_SP2>(F.lds + RING_OFF, g, S, E); } }
        }
        if (BOTH(5)) GRID_BAR();
    }
    if (IN(6)) { REP(6) {
#ifdef SELFCHECK
        chk::chk_p5(F.ctl, QN, KVN, w_uq, w_ukv, positions, Q8, K8, V8T, gw, NGW, LANE());
#endif
        char* albs = (char*)lds + RING_OFF;
#ifndef NO_MLA
        for (int i0 = 0; i0 < 4 * (1 + (RPT(6) | RPT(15))); ++i0) { const int i = i0 & 3; const int v = F.vcu; const int xcd = v >> 5, vl = v & 31; const int bh = xcd * 8 + i * 2 + (vl >> 4), qb = vl & 15;
            if (F.G != 256) break;
            const int b = bh >> 4, h = bh & 15; const long r0 = (long)b * SEQ;
            att::mla_unit(Q8 + ((long)bh * SEQ + qb * 256) * 192, K8 + (long)bh * SEQ * 128, V8T + (long)bh * SEQ * 128, KR8 + r0 * 64, YA + (r0 + qb * 256) * 3072 + h * 128, albs); }
#endif
#ifndef NO_DIL
        for (int i = 0; i < 6 * (1 + (RPT(6) | RPT(14))); ++i) { const int U = (int)blockIdx.x + F.G * (i % 6); if (U >= 1536) continue;
            const int bgh = U >> 4, sub = U & 15, b = bgh / 24, g = (bgh % 24) >> 3, h = bgh & 7;
            const int rho = (g == 0) ? 0 : (g == 1 ? (sub >> 2) : sub), blk = (g == 0) ? sub : (g == 1 ? (sub & 3) : 0);
            att::dil_unit(b, g, h, rho, blk, QD, KD, VD, PD, LSE, albs); }
#endif
        }
        if (BOTH(6)) GRID_BAR();
    }
    if (IN(7)) { REP(7) {
        for (int e = gt; e < M * 128; e += NGT) { const int tok = e >> 7, c8 = e & 127, h = c8 >> 4;
            const float l0 = LSE[((size_t)0 * M + tok) * 8 + h], l1 = LSE[((size_t)1 * M + tok) * 8 + h], l2 = LSE[((size_t)2 * M + tok) * 8 + h];
            const float mx = fmaxf(l0, fmaxf(l1, l2)); float w0 = __builtin_amdgcn_exp2f(l0 - mx), w1 = __builtin_amdgcn_exp2f(l1 - mx), w2 = __builtin_amdgcn_exp2f(l2 - mx);
            const float inv = 1.f / (w0 + w1 + w2); w0 *= inv; w1 *= inv; w2 *= inv;
            const v4u p0 = *(const GAS v4u*)(PD + ((size_t)0 * M + tok) * 1024 + c8 * 8), p1 = *(const GAS v4u*)(PD + ((size_t)1 * M + tok) * 1024 + c8 * 8), p2 = *(const GAS v4u*)(PD + ((size_t)2 * M + tok) * 1024 + c8 * 8);
            v4u o;
            o.x = pk2(w0 * pg8::bf_lo(p0.x) + w1 * pg8::bf_lo(p1.x) + w2 * pg8::bf_lo(p2.x), w0 * pg8::bf_hi(p0.x) + w1 * pg8::bf_hi(p1.x) + w2 * pg8::bf_hi(p2.x));
            o.y = pk2(w0 * pg8::bf_lo(p0.y) + w1 * pg8::bf_lo(p1.y) + w2 * pg8::bf_lo(p2.y), w0 * pg8::bf_hi(p0.y) + w1 * pg8::bf_hi(p1.y) + w2 * pg8::bf_hi(p2.y));
            o.z = pk2(w0 * pg8::bf_lo(p0.z) + w1 * pg8::bf_lo(p1.z) + w2 * pg8::bf_lo(p2.z), w0 * pg8::bf_hi(p0.z) + w1 * pg8::bf_hi(p1.z) + w2 * pg8::bf_hi(p2.z));
            o.w = pk2(w0 * pg8::bf_lo(p0.w) + w1 * pg8::bf_lo(p1.w) + w2 * pg8::bf_lo(p2.w), w0 * pg8::bf_hi(p0.w) + w1 * pg8::bf_hi(p1.w) + w2 * pg8::bf_hi(p2.w));
            *(GAS v4u*)(YA + (size_t)tok * 3072 + 2048 + c8 * 8) = o; }
        }
        if (BOTH(7)) GRID_BAR();
    }
    if (IN(8)) { REP(8) {
#ifdef SELFCHECK
        chk::chk_mla(F.ctl, Q8, K8, V8T, KR8, YA, (LAS float*)(F.lds + RING_OFF), (int)blockIdx.x, OPQ_TID()); chk::chk_dil(F.ctl, QD, KD, VD, YA, (LAS float*)(F.lds + RING_OFF), (int)blockIdx.x, OPQ_TID());
        chk::chk_mla(F.ctl, Q8, K8, V8T, KR8, YA, (LAS float*)(F.lds + RING_OFF), 256 + (int)blockIdx.x, OPQ_TID()); chk::chk_dil(F.ctl, QD, KD, VD, YA, (LAS float*)(F.lds + RING_OFF), 256 + (int)blockIdx.x, OPQ_TID());
        GRID_BAR();
#endif
        pg8::Gemm g{YA, WPA, M, DM, 3072}; pg8::StaticOrder S; S.init(M, DM, F.G, (int)blockIdx.x);
        pg8::EpiMix E{(const unsigned char*)GA, (const unsigned char*)GB, MIXED};
        pg8::gemm_phase<pg8::EpiMix, pg8::StaticOrder, PG_ALIGN, PG_SP2>(F.lds + RING_OFF, g, S, E);
        if constexpr (RPT(8)) { pg8::gemm_phase<pg8::EpiMix, pg8::StaticOrder, PG_ALIGN, PG_SP2>(F.lds + RING_OFF, g, S, E); }
        }
        if (BOTH(8)) GRID_BAR();
    }
    if (IN(9)) { REP(9) {
#ifdef SELFCHECK
        chk::chk_mix(F.ctl, YA, GA, GB, w_proj_a, w_proj_b, MIXED, gw, NGW, LANE());
#endif
        for (int m = gw; m < M; m += NGW) quant_row_b(MIXED + (size_t)m * DM, MIXQ + (size_t)m * DM, SA3 + m, LANE());
        GRID_BAR();
        pg8::Gemm g{(const pg8::bf16_t*)MIXQ, (const pg8::bf16_t*)WOUT8, M, DM, DM, SA3, CM3}; pg8::StaticOrder S; S.init(M, DM, F.G, (int)blockIdx.x);
        pg8::EpiRes<true> E{x, X1B, VEC + 2 * 4 * DM};
        pg8::gemm_phase<pg8::EpiRes<true>, pg8::StaticOrder, PG_ALIGN, PG_SP2, true, 127, true>(F.lds + RING_OFF, g, S, E);
        if constexpr (RPT(9)) { pg8::gemm_phase<pg8::EpiRes<true>, pg8::StaticOrder, PG_ALIGN, PG_SP2, true, 127, true>(F.lds + RING_OFF, g, S, E); }
        }
        if (BOTH(9)) GRID_BAR();
    }
    if (IN(10)) { REP(10) {
#ifdef SELFCHECK
        chk::chk_x1(F.ctl, x, MIXED, w_out, VEC, X1B, gw, NGW, LANE());
#endif
        for (int m0 = gw; m0 < M * (1 + RPT(10)); m0 += NGW) { const int m = m0 & (M - 1), b = m >> 12; normmod_row_b(X1B + (size_t)m * DM, VEC + (3 * 4 + b) * DM, VEC + (4 * 4 + b) * DM, H2 + (size_t)m * DM, H2Q + (size_t)m * DM, SA2 + m, LANE()); }
        }
        if (BOTH(10)) GRID_BAR();
    }
    if (IN(11)) { REP(11) {
        { pg8::Gemm g{(const pg8::bf16_t*)H2Q, (const pg8::bf16_t*)WGU8, M, P11_T8 * 256, DM, SA2, CM2}; pg8::StaticOrder S; S.init(M, P11_T8 * 256, F.G, (int)blockIdx.x);
          pg8::EpiGU E{AFF};
          pg8::gemm_phase<pg8::EpiGU, pg8::StaticOrder, PG_ALIGN, PG_SP2, true, 127, true>(F.lds + RING_OFF, g, S, E);
          if constexpr (RPT(11)) { pg8::gemm_phase<pg8::EpiGU, pg8::StaticOrder, PG_ALIGN, PG_SP2, true, 127, true>(F.lds + RING_OFF, g, S, E); } }
        { pg8::Gemm g{H2, WGU + (size_t)P11_T8 * 256 * DM, M, 2 * DFF - P11_T8 * 256, DM}; pg8::StaticOrder S; S.init(M, 2 * DFF - P11_T8 * 256, F.G, (int)blockIdx.x);
          pg8::EpiGU E{AFF + P11_T8 * pg8::HALF};
          pg8::gemm_phase<pg8::EpiGU, pg8::StaticOrder, PG_ALIGN, PG_SP2>(F.lds + RING_OFF, g, S, E);
          if constexpr (RPT(11)) { pg8::gemm_phase<pg8::EpiGU, pg8::StaticOrder, PG_ALIGN, PG_SP2>(F.lds + RING_OFF, g, S, E); } }
        { constexpr int NU = (M / 256) * ((2 * DFF - P11_T8 * 256) / 256), I_DN = (DFF / 64) * (DM / 32); const int nfull = NU / F.G, rem = NU - nfull * F.G;
          const int nidle = rem ? F.G - rem : F.G, me = rem ? (int)blockIdx.x - rem : (int)blockIdx.x;
          if (me >= 0) { LAS float* scr = (LAS float*)(F.lds + RING_OFF + F.wave * 16384);
              for (int it = me * NWAVES + F.wave; it < I_DN; it += nidle * NWAVES) p0_transpose_item(w_down, DFF, DM, WDN, 0, scr, it, LANE()); } }
        }
        if (BOTH(11)) GRID_BAR();
    }
    if (IN(12)) { REP(12) {
        pg8::Gemm g{AFF, WDN, M, DM, DFF}; pg8::StaticOrder S; S.init(M, DM, F.G, (int)blockIdx.x);
        pg8::EpiRes<false> E{X1B, X2B, VEC + 5 * 4 * DM};
        pg8::gemm_phase<pg8::EpiRes<false>, pg8::StaticOrder, PG_ALIGN, PG_SP2>(F.lds + RING_OFF, g, S, E);
        if constexpr (RPT(12)) { pg8::gemm_phase<pg8::EpiRes<false>, pg8::StaticOrder, PG_ALIGN, PG_SP2>(F.lds + RING_OFF, g, S, E); }
        }
        if (BOTH(12)) GRID_BAR();
    }
    if (IN(13)) {
        bool bad = (N_LAUNCHES == 1) && (__hip_atomic_load((gu32*)((unsigned*)(F.ctl + CW_BAR) + XB_TMO), RLX_AGENT) != 0u);
        bad = bad || (F.G != 256);
#ifdef SELFCHECK
        { const unsigned cw = __hip_atomic_load(F.ctl + chk::CW_CHK, RLX_AGENT); bad = bad || ((cw & (unsigned)(CHK_MASK)) != 0u);
#ifdef STAT_ZT
          { const float e2 = __uint_as_float(__hip_atomic_load(F.ctl + 8, RLX_AGENT)), r2 = __uint_as_float(__hip_atomic_load(F.ctl + 9, RLX_AGENT)); bad = bad || !(e2 <= (STAT_ZT) * (STAT_ZT) * r2); }
#endif
#ifdef STAT_BR
          { const float b2 = __uint_as_float(__hip_atomic_load(F.ctl + 10, RLX_AGENT)), n_ = __uint_as_float(__hip_atomic_load(F.ctl + 11, RLX_AGENT)); bad = bad || !(b2 <= (STAT_BR) * (STAT_BR) * n_); }
#endif
        }
#endif
        for (int m = gw; m < M; m += NGW) {
            const int ln = LANE(); const GAS v4u* xr = (const GAS v4u*)(X2B + (size_t)m * DM) + ln; f32x4 v[16]; float s = 0.f;
#pragma unroll
            for (int j = 0; j < 8; ++j) { const v4u w = xr[64 * j]; v[2 * j] = pg8::bf4_lo(w); v[2 * j + 1] = pg8::bf4_hi(w); }
#pragma unroll
            for (int j = 0; j < 16; ++j) s += (v[j].x * v[j].x + v[j].y * v[j].y) + (v[j].z * v[j].z + v[j].w * v[j].w);
            float rstd = 1.f / sqrtf(wave_sum(s) * (1.f / DM) + NORM_EPS); if (bad) rstd = __builtin_nanf("");
            GAS f32x4* orow = (GAS f32x4*)(out + (size_t)m * DM);
#pragma unroll
            for (int j = 0; j < 8; ++j) { const int c4 = 2 * (ln + 64 * j); const GAS f32x4* g4 = (const GAS f32x4*)final_g + c4;
                orow[c4] = v[2 * j] * rstd * g4[0]; orow[c4 + 1] = v[2 * j + 1] * rstd * g4[1]; }
        }
    }
#undef IN
#undef BOTH
#undef GRID_BAR
#undef gt
#undef LANE
#undef OPQ_TID
}

extern "C" void kernel_launch(void* const* d_in, const int* in_sizes, int n_in, void* d_out, int out_size, void* d_ws, size_t ws_size, hipStream_t stream) {
    static int grid = 0;
    if (grid == 0) {
        if (n_in != 19 || in_sizes[0] != M * DM || out_size != M * DM || ws_size < WS_END) { fprintf(stderr, "kernel_launch: shape mismatch: n_in %d in0 %d out %d ws %zu (need %zu); nothing launched\n", n_in, n_in > 0 ? in_sizes[0] : -1, out_size, ws_size, (size_t)WS_END); grid = -1; return; }
        int dev = 0, cus = 0, per_cu = 0;
        if (hipGetDevice(&dev) != hipSuccess || hipDeviceGetAttribute(&cus, hipDeviceAttributeMultiprocessorCount, dev) != hipSuccess) { fprintf(stderr, "kernel_launch: device query failed\n"); grid = -1; return; }
        if (hipFuncSetAttribute((const void*)mk_fwd, hipFuncAttributeMaxDynamicSharedMemorySize, LDS_BYTES) != hipSuccess) { fprintf(stderr, "kernel_launch: hipFuncSetAttribute failed\n"); grid = -1; return; }
        if (hipOccupancyMaxActiveBlocksPerMultiprocessor(&per_cu, (const void*)mk_fwd, NWAVES * 64, LDS_BYTES) != hipSuccess || per_cu < 1) fprintf(stderr, "kernel_launch: note: occupancy query reports %d workgroups per CU\n", per_cu);
        (void)hipGetLastError();
        grid = cus;
        if (grid != 256) fprintf(stderr, "kernel_launch: %d CUs; this kernel is laid out for 256\n", grid);
    }
    if (grid < 0) return;
    if (hipMemsetAsync((char*)d_ws + WS_CTL, 0, CTL_ZERO_BYTES, stream) != hipSuccess) { fprintf(stderr, "kernel_launch: hipMemsetAsync failed\n"); return; }
    Args a{};
    for (int i = 0; i < 19; ++i) a.in[i] = (const float*)d_in[i];
    a.out = (float*)d_out; a.ws = (unsigned char*)d_ws;
    for (int li = 0; li < N_LAUNCHES; ++li) {
        a.ph_lo = (N_LAUNCHES == PER_PHASE) ? li : 0; a.ph_hi = (N_LAUNCHES == PER_PHASE) ? li + 1 : PER_PHASE; a.li = li;
        hipLaunchKernelGGL(mk_fwd, dim3(grid), dim3(NWAVES * 64), LDS_BYTES, stream, a);
        const hipError_t le = hipPeekAtLastError();
        if (le != hipSuccess) { fprintf(stderr, "kernel_launch: launch %d failed: %s\n", li, hipGetErrorName(le)); break; }
    }
}
```

```cpp
#include <hip/hip_runtime.h>
#include <cstdio>
#include <cstdint>
namespace pg8 {
#define PG8_LAS __attribute__((address_space(3)))
typedef unsigned short bf16_t;
typedef short bf16x8 __attribute__((ext_vector_type(8)));
typedef float f32x4 __attribute__((ext_vector_type(4)));
typedef unsigned u32x4 __attribute__((ext_vector_type(4)));
typedef int i32x4_t __attribute__((ext_vector_type(4)));
typedef int i32x8_t __attribute__((ext_vector_type(8)));
constexpr int BM = 256, BK = 64, HALF = 128, HTB = HALF * BK * 2  , STAGE_BYTES = 8 * HTB, NXCD = 8, WGM = 8;

__host__ __device__ __forceinline__ int lds_byte(int r, int c) { const int st = (r >> 4) * 2 + (c >> 5), rr = r & 15, cc = c & 31, ob = rr * 64 + cc * 2; return st * 1024 + (ob ^ (((ob >> 9) & 1) << 5)); }
__host__ __device__ __forceinline__ void stage_rc(int b, int& R, int& C) { const int st = b / 1024, sb = b % 1024, swz = sb ^ (((sb >> 9) & 1) << 5); R = (st >> 1) * 16 + swz / 64; C = (st & 1) * 32 + (swz % 64) / 2; }
__host__ __device__ __forceinline__ int perm32(int rho) { const int n = rho >> 4, i = rho & 15; return 8 * (i >> 2) + 4 * n + (i & 3); }

struct Unit { int pm, pn; };
struct Gemm { const bf16_t* A; const bf16_t* Bt; int M, N, K; const float* sa = nullptr; const float* sw = nullptr; };

struct StaticOrder {
    int nM, nN, nwg, G, c;
    __host__ __device__ void init(int M, int N, int G_, int c_) { nM = M / BM; nN = N / BM; nwg = nM * nN; G = G_; c = c_; }
    __host__ __device__ bool next(int i, Unit& u) const {
        const long L = (long)i * G + c; if (L >= nwg) return false;
        int wgid = (int)L; { const int q = nwg / NXCD, r = nwg % NXCD, xcd = wgid % NXCD, off = wgid / NXCD; wgid = (xcd < r ? xcd * (q + 1) : r * (q + 1) + (xcd - r) * q) + off; }
        const int nig = WGM * nN, gid = wgid / nig, fm = gid * WGM, gsz = (nM - fm) < WGM ? (nM - fm) : WGM;
        u.pm = fm + ((wgid % nig) % gsz); u.pn = (wgid % nig) / gsz; return true;
    }
    __device__ __forceinline__ void a_ready(const Unit&) const {}
    __device__ __forceinline__ void done(const Unit&) const {}
};

__device__ __forceinline__ unsigned cvt_pk_bf16(float lo, float hi) { unsigned r; asm volatile("v_cvt_pk_bf16_f32 %0, %1, %2" : "=v"(r) : "v"(lo), "v"(hi)); return r; }
__device__ __forceinline__ float bf_lo(unsigned w) { return __uint_as_float(w << 16); }
__device__ __forceinline__ float bf_hi(unsigned w) { return __uint_as_float(w & 0xffff0000u); }
__device__ __forceinline__ float sigmoid_f(float x) { return __builtin_amdgcn_rcpf(1.0f + __builtin_amdgcn_exp2f(-1.4426950408889634f * x)); }
__device__ __forceinline__ f32x4 sigmoid4(f32x4 v) { return (f32x4){sigmoid_f(v[0]), sigmoid_f(v[1]), sigmoid_f(v[2]), sigmoid_f(v[3])}; }
__device__ __forceinline__ void st8(bf16_t* p, f32x4 v0, f32x4 v1) { u32x4 w; w.x = cvt_pk_bf16(v0[0], v0[1]); w.y = cvt_pk_bf16(v0[2], v0[3]); w.z = cvt_pk_bf16(v1[0], v1[1]); w.w = cvt_pk_bf16(v1[2], v1[3]); *(u32x4*)p = w; }
__device__ __forceinline__ void st8f(unsigned char* p, f32x4 v0, f32x4 v1) { int w0 = __builtin_amdgcn_cvt_pk_fp8_f32(v0[0], v0[1], 0, false); w0 = __builtin_amdgcn_cvt_pk_fp8_f32(v0[2], v0[3], w0, true); int w1 = __builtin_amdgcn_cvt_pk_fp8_f32(v1[0], v1[1], 0, false); w1 = __builtin_amdgcn_cvt_pk_fp8_f32(v1[2], v1[3], w1, true);
    *(unsigned long long*)p = (unsigned long long)(unsigned)w0 | ((unsigned long long)(unsigned)w1 << 32); }
__device__ __forceinline__ unsigned pk4_u8(f32x4 v) { unsigned w = __builtin_amdgcn_cvt_pk_u8_f32(v[0] * 255.f, 0, 0u); w = __builtin_amdgcn_cvt_pk_u8_f32(v[1] * 255.f, 1, w); w = __builtin_amdgcn_cvt_pk_u8_f32(v[2] * 255.f, 2, w); return __builtin_amdgcn_cvt_pk_u8_f32(v[3] * 255.f, 3, w); }
__device__ __forceinline__ f32x4 u8x4_f(unsigned w) { return (f32x4){(float)(w & 0xffu), (float)((w >> 8) & 0xffu), (float)((w >> 16) & 0xffu), (float)(w >> 24)}; }
__device__ __forceinline__ f32x4 bf4_lo(u32x4 g) { return (f32x4){bf_lo(g.x), bf_hi(g.x), bf_lo(g.y), bf_hi(g.y)}; }
__device__ __forceinline__ f32x4 bf4_hi(u32x4 g) { return (f32x4){bf_lo(g.z), bf_hi(g.z), bf_lo(g.w), bf_hi(g.w)}; }

constexpr int P3_NBF = 0;
struct EpiZ {
    static constexpr bool PERM = true, AFTER_DRAIN = false; static constexpr int MID_T = -1;
    bf16_t *ZQ, *ZKV, *QD, *KD, *VD, *GA, *GB, *ZKR; const float *cosF, *sinF; int remap;
    __device__ __forceinline__ void operator()(const f32x4 (&acc)[2][2][4][2], const Unit& u, int wr, int wc, int fr, int fq) const {
        const int pn = remap == 0 ? u.pn : (remap == 1 ? 6 + u.pn : (u.pn < 6 ? u.pn : P3_NBF + u.pn)), row0 = u.pm * BM + wr * 64 + fr, j0 = wc * 32 + 8 * fq;
        if (pn >= 6 && pn < 30) {
            const int t = (pn - 6) / 12, tt = (pn - 6) % 12, i0 = (wc & 1) * 32 + 8 * fq;
            bf16_t* base = (t ? KD : QD) + ((size_t)((u.pm >> 4) * 24 + 2 * tt + (wc >> 1)) * 4096) * 128 + i0;
#pragma unroll
            for (int ai = 0; ai < 2; ++ai) { f32x4 cs[4][4];
#pragma unroll
                for (int m = 0; m < 4; ++m) { const int row = row0 + ai * HALF + m * 16; const float* cp = cosF + (size_t)row * 64 + i0; const float* sp = sinF + (size_t)row * 64 + i0;
                    cs[m][0] = *(const f32x4*)cp; cs[m][1] = *(const f32x4*)(cp + 4); cs[m][2] = *(const f32x4*)sp; cs[m][3] = *(const f32x4*)(sp + 4); }
#pragma unroll
                for (int m = 0; m < 4; ++m) { const int row = row0 + ai * HALF + m * 16; const f32x4 c0 = cs[m][0], c1 = cs[m][1], s0 = cs[m][2], s1 = cs[m][3];
                    const f32x4 x10 = acc[ai][0][m][0], x11 = acc[ai][0][m][1], x20 = acc[ai][1][m][0], x21 = acc[ai][1][m][1];
                    bf16_t* rp = base + (size_t)(row & 4095) * 128;
                    st8(rp, x10 * c0 - x20 * s0, x11 * c1 - x21 * s1); st8(rp + 64, x20 * c0 + x10 * s0, x21 * c1 + x11 * s1); } }
        } else if (pn >= 30 && pn < 42) {
            bf16_t* base = VD + ((size_t)((u.pm >> 4) * 24 + 2 * (pn - 30)) * 4096) * 128 + j0;
#pragma unroll
            for (int ai = 0; ai < 2; ++ai)
#pragma unroll
                for (int m = 0; m < 4; ++m) { bf16_t* rp = base + (size_t)((row0 + ai * HALF + m * 16) & 4095) * 128;
#pragma unroll
                    for (int bj = 0; bj < 2; ++bj) st8(rp + (size_t)bj * 4096 * 128, acc[ai][bj][m][0], acc[ai][bj][m][1]); }
        } else {
            bf16_t* base; int ld; bool sig = false;
            if (pn < 4) { base = ZQ + pn * 256; ld = 1024; }
            else if (pn < 6) { base = ZKV + (pn - 4) * 256; ld = 512; }
            else if (pn < 74) { const int gi = pn - 42; base = (gi < 16 ? GA : GB) + ((gi & 15) * 256) / 2; ld = 4096 / 2; sig = true; }
            else { base = ZKR; ld = 256; }
            base += sig ? j0 / 2 : j0;
#pragma unroll
            for (int ai = 0; ai < 2; ++ai)
#pragma unroll
                for (int m = 0; m < 4; ++m) { bf16_t* rp = base + (size_t)(row0 + ai * HALF + m * 16) * ld;
#pragma unroll
                    for (int bj = 0; bj < 2; ++bj) { f32x4 v0 = acc[ai][bj][m][0], v1 = acc[ai][bj][m][1];
                        if (sig) { *(unsigned long long*)(rp + (bj * HALF) / 2) = (unsigned long long)pk4_u8(sigmoid4(v0)) | ((unsigned long long)pk4_u8(sigmoid4(v1)) << 32); }
                        else st8(rp + bj * HALF, v0, v1); } }
        }
    }
};
struct EpiQ {
    static constexpr bool PERM = true, AFTER_DRAIN = false; static constexpr int MID_T = -1;
    unsigned char* Q; const float *cosR, *sinR;
    __device__ __forceinline__ void operator()(const f32x4 (&acc)[2][2][4][2], const Unit& u, int wr, int wc, int fr, int fq) const {
        const int pn = u.pn, row0 = u.pm * BM + wr * 64 + fr;
        if (pn >= 8) {
            const int head = 4 * (pn - 8) + wc, i0 = 8 * fq;
            unsigned char* base = Q + ((size_t)((u.pm >> 4) * 16 + head) * 4096) * 192 + 128 + i0;
#pragma unroll
            for (int ai = 0; ai < 2; ++ai) { f32x4 cs[4][4];
#pragma unroll
                for (int m = 0; m < 4; ++m) { const int row = row0 + ai * HALF + m * 16; const float* cp = cosR + (size_t)row * 32 + i0; const float* sp = sinR + (size_t)row * 32 + i0;
                    cs[m][0] = *(const f32x4*)cp; cs[m][1] = *(const f32x4*)(cp + 4); cs[m][2] = *(const f32x4*)sp; cs[m][3] = *(const f32x4*)(sp + 4); }
#pragma unroll
                for (int m = 0; m < 4; ++m) { const int row = row0 + ai * HALF + m * 16; const f32x4 c0 = cs[m][0], c1 = cs[m][1], s0 = cs[m][2], s1 = cs[m][3];
                    const f32x4 x10 = acc[ai][0][m][0], x11 = acc[ai][0][m][1], x20 = acc[ai][1][m][0], x21 = acc[ai][1][m][1];
                    unsigned char* rp = base + (size_t)(row & 4095) * 192;
                    st8f(rp, x10 * c0 - x20 * s0, x11 * c1 - x21 * s1); st8f(rp + 32, x20 * c0 + x10 * s0, x21 * c1 + x11 * s1); } }
        } else {
            unsigned char* base = Q + ((size_t)((u.pm >> 4) * 16 + 2 * pn) * 4096) * 192 + wc * 32 + 8 * fq;
#pragma unroll
            for (int ai = 0; ai < 2; ++ai)
#pragma unroll
                for (int m = 0; m < 4; ++m) { unsigned char* rp = base + (size_t)((row0 + ai * HALF + m * 16) & 4095) * 192;
#pragma unroll
                    for (int bj = 0; bj < 2; ++bj) st8f(rp + (size_t)bj * 4096 * 192, acc[ai][bj][m][0], acc[ai][bj][m][1]); }
        }
    }
};
struct EpiKV {
    static constexpr bool PERM = true, AFTER_DRAIN = false; static constexpr int MID_T = -1;
    unsigned char* K8; unsigned char* V8T;
    __device__ __forceinline__ void operator()(const f32x4 (&acc)[2][2][4][2], const Unit& u, int wr, int wc, int fr, int fq) const {
        const int row0 = u.pm * BM + wr * 64 + fr, j0 = wc * 32 + 8 * fq; const size_t bh = (size_t)((u.pm >> 4) * 16 + u.pn);
#pragma unroll
        for (int ai = 0; ai < 2; ++ai)
#pragma unroll
            for (int m = 0; m < 4; ++m) { const int s_ = (row0 + ai * HALF + m * 16) & 4095, t = s_ & 63;
                st8f(K8 + (bh * 4096 + s_) * 128 + j0, acc[ai][0][m][0], acc[ai][0][m][1]);
                const int vp = 32 * ((t >> 2) & 1) + (t & 3) + 4 * ((t >> 3) & 3) + 16 * (t >> 5);
                unsigned char* vb = V8T + ((bh * 64 + (s_ >> 6)) * 128 + j0) * 64 + vp;
                const f32x4 v0 = acc[ai][1][m][0], v1 = acc[ai][1][m][1];
                const unsigned w0 = (unsigned)__builtin_amdgcn_cvt_pk_fp8_f32(v0[0], v0[1], 0, false), w1 = (unsigned)__builtin_amdgcn_cvt_pk_fp8_f32(v0[2], v0[3], 0, false), w2 = (unsigned)__builtin_amdgcn_cvt_pk_fp8_f32(v1[0], v1[1], 0, false), w3 = (unsigned)__builtin_amdgcn_cvt_pk_fp8_f32(v1[2], v1[3], 0, false);
                vb[0] = (unsigned char)w0; vb[64] = (unsigned char)(w0 >> 8); vb[128] = (unsigned char)w1; vb[192] = (unsigned char)(w1 >> 8); vb[256] = (unsigned char)w2; vb[320] = (unsigned char)(w2 >> 8); vb[384] = (unsigned char)w3; vb[448] = (unsigned char)(w3 >> 8); }
    }
};
struct EpiMix {
    static constexpr bool PERM = true, AFTER_DRAIN = false; static constexpr int MID_T = 32;
    const unsigned char* GA; const unsigned char* GB; bf16_t* O;
    __device__ __forceinline__ void mid(f32x4 (&acc)[2][2][4][2], const Unit& u, int wr, int wc, int fr_in, int fq_in) const {
        int fr = fr_in, fq = fq_in; asm volatile("" : "+v"(fr), "+v"(fq));
        const int row0 = u.pm * BM + wr * 64 + fr; const size_t c0 = (size_t)u.pn * BM + wc * 32 + 8 * fq;
#pragma unroll
        for (int ai = 0; ai < 2; ++ai)
#pragma unroll
            for (int m = 0; m < 4; ++m) { const size_t ro = (size_t)(row0 + ai * HALF + m * 16) * 4096 + c0;
#pragma unroll
                for (int bj = 0; bj < 2; ++bj) { const size_t p = ro + bj * HALF; const unsigned long long ga = *(const unsigned long long*)(GA + p), gb = *(const unsigned long long*)(GB + p);
                    const f32x4 a0 = u8x4_f((unsigned)ga), a1 = u8x4_f((unsigned)(ga >> 32)); f32x4 b0 = u8x4_f((unsigned)gb), b1 = u8x4_f((unsigned)(gb >> 32));
#pragma unroll
                    for (int i = 0; i < 4; ++i) { b0[i] = fmaxf(b0[i], 1.f); b1[i] = fmaxf(b1[i], 1.f); }
                    acc[ai][bj][m][0] *= (f32x4){a0[0] * __builtin_amdgcn_rcpf(b0[0]), a0[1] * __builtin_amdgcn_rcpf(b0[1]), a0[2] * __builtin_amdgcn_rcpf(b0[2]), a0[3] * __builtin_amdgcn_rcpf(b0[3])};
                    acc[ai][bj][m][1] *= (f32x4){a1[0] * __builtin_amdgcn_rcpf(b1[0]), a1[1] * __builtin_amdgcn_rcpf(b1[1]), a1[2] * __builtin_amdgcn_rcpf(b1[2]), a1[3] * __builtin_amdgcn_rcpf(b1[3])}; }
            }
    }
    __device__ __forceinline__ void operator()(const f32x4 (&acc)[2][2][4][2], const Unit& u, int wr, int wc, int fr, int fq) const {
        const int row0 = u.pm * BM + wr * 64 + fr; const size_t c0 = (size_t)u.pn * BM + wc * 32 + 8 * fq;
        unsigned long long gbv[2][4][2];
#pragma unroll
        for (int ai = 0; ai < 2; ++ai)
#pragma unroll
            for (int m = 0; m < 4; ++m)
#pragma unroll
                for (int bj = 0; bj < 2; ++bj) gbv[ai][m][bj] = *(const unsigned long long*)(GB + (size_t)(row0 + ai * HALF + m * 16) * 4096 + c0 + bj * HALF);
#pragma unroll
        for (int ai = 0; ai < 2; ++ai)
#pragma unroll
            for (int m = 0; m < 4; ++m)
#pragma unroll
                for (int bj = 0; bj < 2; ++bj) { const size_t p = (size_t)(row0 + ai * HALF + m * 16) * 4096 + c0 + bj * HALF; const unsigned long long gb = gbv[ai][m][bj];
                    f32x4 b0 = u8x4_f((unsigned)gb), b1 = u8x4_f((unsigned)(gb >> 32));
#pragma unroll
                    for (int i = 0; i < 4; ++i) { b0[i] = fmaxf(b0[i], 1.f) * (1.f / 255.f); b1[i] = fmaxf(b1[i], 1.f) * (1.f / 255.f); }
                    st8(O + p, acc[ai][bj][m][0] * b0, acc[ai][bj][m][1] * b1); }
    }
};
template <bool BASE_F32> struct EpiRes {
    static constexpr bool PERM = true, AFTER_DRAIN = false; static constexpr int MID_T = -1;
    const void* base; bf16_t* out; const float* gvec;
    __device__ __forceinline__ void operator()(const f32x4 (&acc)[2][2][4][2], const Unit& u, int wr, int wc, int fr, int fq) const {
        const int row0 = u.pm * BM + wr * 64 + fr, col0 = u.pn * BM + wc * 32 + 8 * fq; const float* gb = gvec + (size_t)(u.pm >> 4) * 4096 + col0;
        f32x4 gv[2][2];
#pragma unroll
        for (int bj = 0; bj < 2; ++bj)
#pragma unroll
            for (int n = 0; n < 2; ++n) gv[bj][n] = *(const f32x4*)(gb + bj * HALF + n * 4);
        if constexpr (BASE_F32) {
#pragma unroll
            for (int ai = 0; ai < 2; ++ai) { f32x4 pre[4][2][2];
#pragma unroll
                for (int m = 0; m < 4; ++m)
#pragma unroll
                    for (int bj = 0; bj < 2; ++bj) { const size_t p = (size_t)(row0 + ai * HALF + m * 16) * 4096 + col0 + bj * HALF; pre[m][bj][0] = *(const f32x4*)((const float*)base + p); pre[m][bj][1] = *(const f32x4*)((const float*)base + p + 4); }
#pragma unroll
                for (int m = 0; m < 4; ++m)
#pragma unroll
                    for (int bj = 0; bj < 2; ++bj) { const size_t p = (size_t)(row0 + ai * HALF + m * 16) * 4096 + col0 + bj * HALF; st8(out + p, pre[m][bj][0] + gv[bj][0] * acc[ai][bj][m][0], pre[m][bj][1] + gv[bj][1] * acc[ai][bj][m][1]); } }
        } else {
            u32x4 pre[2][4][2];
#pragma unroll
            for (int ai = 0; ai < 2; ++ai)
#pragma unroll
                for (int m = 0; m < 4; ++m)
#pragma unroll
                    for (int bj = 0; bj < 2; ++bj) pre[ai][m][bj] = *(const u32x4*)((const bf16_t*)base + (size_t)(row0 + ai * HALF + m * 16) * 4096 + col0 + bj * HALF);
#pragma unroll
            for (int ai = 0; ai < 2; ++ai)
#pragma unroll
                for (int m = 0; m < 4; ++m)
#pragma unroll
                    for (int bj = 0; bj < 2; ++bj) { const size_t p = (size_t)(row0 + ai * HALF + m * 16) * 4096 + col0 + bj * HALF; st8(out + p, bf4_lo(pre[ai][m][bj]) + gv[bj][0] * acc[ai][bj][m][0], bf4_hi(pre[ai][m][bj]) + gv[bj][1] * acc[ai][bj][m][1]); }
        }
    }
};
struct EpiGU {
    static constexpr bool PERM = true, AFTER_DRAIN = false; static constexpr int MID_T = -1;
    bf16_t* A;
    __device__ __forceinline__ void operator()(const f32x4 (&acc)[2][2][4][2], const Unit& u, int wr, int wc, int fr, int fq) const {
        const int row0 = u.pm * BM + wr * 64 + fr; bf16_t* base = A + u.pn * HALF + wc * 32 + 8 * fq;
#pragma unroll
        for (int ai = 0; ai < 2; ++ai)
#pragma unroll
            for (int m = 0; m < 4; ++m) { const f32x4 g0 = acc[ai][0][m][0], g1 = acc[ai][0][m][1], u0 = acc[ai][1][m][0], u1 = acc[ai][1][m][1];
                st8(base + (size_t)(row0 + ai * HALF + m * 16) * 11008, g0 * sigmoid4(g0) * u0, g1 * sigmoid4(g1) * u1); }
    }
};

template <class Epi, class Sched, bool ALIGN_EPI = false, bool SP2 = false, bool F8 = false, int SCALE_W = 127, bool I8 = false>
__device__ __forceinline__ void gemm_phase(PG8_LAS unsigned char* lds, const Gemm g, const Sched& S, const Epi& E) {
    int tid_ = threadIdx.x; asm volatile("" : "+v"(tid_));
    const int tid = tid_, wid = __builtin_amdgcn_readfirstlane(tid >> 6), lane = tid & 63, wr = wid >> 2, wc = wid & 3, fr = lane & 15, fq = lane >> 4;
    const int K = g.K, nt = F8 ? K / 128 : K / BK;
    unsigned voffA[2], voffB[2];
#pragma unroll
    for (int i = 0; i < 2; ++i) { int R, C; stage_rc(tid * 16 + i * 8192, R, C); const int Rb = Epi::PERM ? ((R & ~31) + perm32(R & 31)) : R;
        voffA[i] = F8 ? (unsigned)(R * K + 2 * C) : (unsigned)(R * K + C) * 2u; voffB[i] = F8 ? (unsigned)(Rb * K + 2 * C) : (unsigned)(Rb * K + C) * 2u; }
    const size_t kstep = (size_t)(BK * 2);
    const size_t hstep = (size_t)HALF * K * (F8 ? 1 : 2);
    const size_t tstep = 2 * hstep;
    const unsigned ldsw = (unsigned)wid * 1024u;
    const int fcol = F8 ? (fq >> 1) * 32 + (fq & 1) * 16 : fq * 8;
    const int aoff = lds_byte(wr * 64 + fr, fcol), boff = lds_byte(wc * 32 + fr, fcol);
    int scale_w = SCALE_W * 0x01010101, scale_a = 0x7f7f7f7f; asm volatile("" : "+v"(scale_w), "+v"(scale_a));
#define PG8_SA(b, h) (((b) * 2 + (h)) * HTB)
#define PG8_SB(b, h) ((4 + (b) * 2 + (h)) * HTB)
#define PG8_STAGE(bufoff, gbase, voff) do { _Pragma("unroll") for (int _i = 0; _i < 2; ++_i) \
        __builtin_amdgcn_global_load_lds((const unsigned*)((const char*)(gbase) + (voff)[_i]), (PG8_LAS unsigned*)(lds + (bufoff) + ldsw + _i * 8192), 16, 0, 0); } while (0)
#define PG8_RD16(off) (*(const PG8_LAS i32x4_t*)(lds + (off)))
#define PG8_LDA(dst, b, h) do { if constexpr (F8) { _Pragma("unroll") for (int m = 0; m < 4; ++m) dst##8[m] = PG8_CAT8(PG8_RD16(PG8_SA(b, h) + aoff + m * 2048), PG8_RD16(PG8_SA(b, h) + aoff + m * 2048 + 16)); } \
    else { _Pragma("unroll") for (int m = 0; m < 4; ++m) _Pragma("unroll") for (int k = 0; k < 2; ++k) dst[m][k] = *(const PG8_LAS bf16x8*)(lds + PG8_SA(b, h) + aoff + m * 2048 + k * 1024); } } while (0)
#define PG8_LDB(dst, b, h) do { if constexpr (F8) { _Pragma("unroll") for (int n = 0; n < 2; ++n) dst##8[n] = PG8_CAT8(PG8_RD16(PG8_SB(b, h) + boff + n * 2048), PG8_RD16(PG8_SB(b, h) + boff + n * 2048 + 16)); } \
    else { _Pragma("unroll") for (int n = 0; n < 2; ++n) _Pragma("unroll") for (int k = 0; k < 2; ++k) dst[n][k] = *(const PG8_LAS bf16x8*)(lds + PG8_SB(b, h) + boff + n * 2048 + k * 1024); } } while (0)
#define PG8_CAT8(lo, hi) __builtin_shufflevector(lo, hi, 0, 1, 2, 3, 4, 5, 6, 7)
#define PG8_LO4(x) __builtin_shufflevector(x, x, 0, 1, 2, 3)
#define PG8_HI4(x) __builtin_shufflevector(x, x, 4, 5, 6, 7)
#define PG8_MMA(ai, bj, At, Bt) do { __builtin_amdgcn_s_setprio(1); if constexpr (I8) { _Pragma("unroll") for (int m = 0; m < 4; ++m) _Pragma("unroll") for (int n = 0; n < 2; ++n) { \
        i32x4_t c_ = __builtin_bit_cast(i32x4_t, acc[ai][bj][m][n]); c_ = __builtin_amdgcn_mfma_i32_16x16x64_i8(PG8_LO4(Bt##8[n]), PG8_LO4(At##8[m]), c_, 0, 0, 0); \
        c_ = __builtin_amdgcn_mfma_i32_16x16x64_i8(PG8_HI4(Bt##8[n]), PG8_HI4(At##8[m]), c_, 0, 0, 0); acc[ai][bj][m][n] = __builtin_bit_cast(f32x4, c_); } } \
      else if constexpr (F8) { _Pragma("unroll") for (int m = 0; m < 4; ++m) _Pragma("unroll") for (int n = 0; n < 2; ++n) \
        asm volatile("v_mfma_scale_f32_16x16x128_f8f6f4 %0, %1, %2, %0, %3, %4 op_sel_hi:[0,0,0]" : "+v"(acc[ai][bj][m][n]) : "v"(Bt##8[n]), "v"(At##8[m]), "v"(scale_w), "v"(scale_a)); } \
      else { _Pragma("unroll") for (int m = 0; m < 4; ++m) _Pragma("unroll") for (int n = 0; n < 2; ++n) _Pragma("unroll") for (int k = 0; k < 2; ++k) \
        acc[ai][bj][m][n] = __builtin_amdgcn_mfma_f32_16x16x32_bf16(Bt[n][k], At[m][k], acc[ai][bj][m][n], 0, 0, 0); } __builtin_amdgcn_s_setprio(0); } while (0)
#define PG8_WAIT_V(n) asm volatile("s_waitcnt vmcnt(" #n ")" ::: "memory")
#define PG8_WAIT_L(n) asm volatile("s_waitcnt lgkmcnt(" #n ")" ::: "memory")
#define PG8_BAR __builtin_amdgcn_s_barrier()
#define PG8_SCHED __builtin_amdgcn_sched_barrier(0)
    Unit cur, nxt; int ui = 0;
    if (!S.next(0, cur)) return;
    f32x4 acc[2][2][4][2];
#pragma unroll
    for (int a = 0; a < 2; ++a)
#pragma unroll
        for (int b = 0; b < 2; ++b)
#pragma unroll
            for (int m = 0; m < 4; ++m)
#pragma unroll
                for (int n = 0; n < 2; ++n) acc[a][b][m][n] = (f32x4){0.f, 0.f, 0.f, 0.f};
    bf16x8 At[4][2], B0[2][2], B1[2][2]; i32x8_t At8[4], B08[2], B18[2];
    const char* cA = (const char*)g.A + (size_t)cur.pm * tstep; const char* cB = (const char*)g.Bt + (size_t)cur.pn * tstep;
    S.a_ready(cur);
    if constexpr (SP2) {
        PG8_STAGE(PG8_SB(0, 0), cB, voffB); PG8_STAGE(PG8_SB(0, 1), cB + hstep, voffB); PG8_STAGE(PG8_SA(0, 0), cA, voffA); PG8_STAGE(PG8_SA(0, 1), cA + hstep, voffA);
        if (wr == 1) PG8_BAR;
        PG8_WAIT_V(2); PG8_BAR;
        PG8_STAGE(PG8_SB(1, 0), cB + kstep, voffB); PG8_STAGE(PG8_SA(1, 0), cA + kstep, voffA); PG8_STAGE(PG8_SB(1, 1), cB + hstep + kstep, voffB);
        PG8_WAIT_V(6); PG8_BAR;
    } else {
        PG8_STAGE(PG8_SB(0, 0), cB, voffB); PG8_STAGE(PG8_SA(0, 0), cA, voffA); PG8_STAGE(PG8_SB(0, 1), cB + hstep, voffB); PG8_STAGE(PG8_SA(0, 1), cA + hstep, voffA);
        if (wr == 1) PG8_BAR;
        PG8_WAIT_V(4); PG8_BAR;
        PG8_STAGE(PG8_SB(1, 0), cB + kstep, voffB); PG8_STAGE(PG8_SA(1, 0), cA + kstep, voffA); PG8_STAGE(PG8_SB(1, 1), cB + hstep + kstep, voffB);
        PG8_WAIT_V(6); PG8_BAR;
    }
    for (;;) {
        const bool has_next = S.next(ui + 1, nxt);
        const char* nA = has_next ? (const char*)g.A + (size_t)nxt.pm * tstep : cA; const char* nB = has_next ? (const char*)g.Bt + (size_t)nxt.pn * tstep : cB;
        for (int t = 0; t < nt; t += 2) {
            if constexpr (Epi::MID_T >= 0) { if (t == Epi::MID_T) E.mid(acc, cur, wr, wc, fr, fq); }
            const bool last = (t == nt - 2);
            const char* a1 = cA + (size_t)(t + 1) * kstep;
            const char* a2 = last ? nA : cA + (size_t)(t + 2) * kstep; const char* b2 = last ? nB : cB + (size_t)(t + 2) * kstep;
            const char* a3 = a2 + kstep; const char* b3 = b2 + kstep;
            if (last && has_next) S.a_ready(nxt);
            if constexpr (SP2) {
            PG8_LDB(B0, 0, 0); PG8_LDB(B1, 0, 1); PG8_SCHED; PG8_LDA(At, 0, 0); PG8_STAGE(PG8_SA(1, 1), a1 + hstep, voffA);
            PG8_WAIT_V(8); PG8_WAIT_L(0); PG8_BAR; PG8_MMA(0, 0, At, B0); PG8_MMA(0, 1, At, B1); PG8_BAR; PG8_SCHED;
            PG8_LDA(At, 0, 1); PG8_STAGE(PG8_SB(0, 0), b2, voffB); PG8_STAGE(PG8_SB(0, 1), b2 + hstep, voffB); PG8_STAGE(PG8_SA(0, 0), a2, voffA);
            PG8_WAIT_V(8); PG8_WAIT_L(0); PG8_BAR; PG8_MMA(1, 0, At, B0); PG8_MMA(1, 1, At, B1); PG8_BAR; PG8_SCHED;
            PG8_LDB(B0, 1, 0); PG8_LDB(B1, 1, 1); PG8_SCHED; PG8_LDA(At, 1, 0); PG8_STAGE(PG8_SA(0, 1), a2 + hstep, voffA);
            PG8_WAIT_V(8); PG8_WAIT_L(0); PG8_BAR; PG8_MMA(0, 0, At, B0); PG8_MMA(0, 1, At, B1); PG8_BAR; PG8_SCHED;
            PG8_LDA(At, 1, 1); PG8_STAGE(PG8_SB(1, 0), b3, voffB); PG8_STAGE(PG8_SB(1, 1), b3 + hstep, voffB); PG8_STAGE(PG8_SA(1, 0), a3, voffA);
            PG8_WAIT_V(8); PG8_WAIT_L(0); PG8_BAR; PG8_MMA(1, 0, At, B0); PG8_MMA(1, 1, At, B1); PG8_BAR; PG8_SCHED;
            } else {
            PG8_LDB(B0, 0, 0); PG8_SCHED; PG8_LDA(At, 0, 0); PG8_STAGE(PG8_SA(1, 1), a1 + hstep, voffA);
            PG8_WAIT_L(8); PG8_BAR; PG8_WAIT_L(0); PG8_MMA(0, 0, At, B0); PG8_BAR; PG8_SCHED;
            PG8_LDB(B1, 0, 1); PG8_STAGE(PG8_SB(0, 0), b2, voffB);
            PG8_BAR; PG8_WAIT_L(0); PG8_MMA(0, 1, At, B1); PG8_BAR;
            PG8_LDA(At, 0, 1); PG8_STAGE(PG8_SA(0, 0), a2, voffA);
            PG8_BAR; PG8_WAIT_L(0); PG8_MMA(1, 0, At, B0); PG8_BAR; PG8_SCHED;
            PG8_STAGE(PG8_SB(0, 1), b2 + hstep, voffB);
            PG8_WAIT_V(6); PG8_BAR; PG8_MMA(1, 1, At, B1); PG8_BAR;
            PG8_LDB(B0, 1, 0); PG8_SCHED; PG8_LDA(At, 1, 0); PG8_STAGE(PG8_SA(0, 1), a2 + hstep, voffA);
            PG8_WAIT_L(8); PG8_BAR; PG8_WAIT_L(0); PG8_MMA(0, 0, At, B0); PG8_BAR; PG8_SCHED;
            PG8_LDB(B1, 1, 1); PG8_STAGE(PG8_SB(1, 0), b3, voffB);
            PG8_BAR; PG8_WAIT_L(0); PG8_MMA(0, 1, At, B1); PG8_BAR;
            PG8_LDA(At, 1, 1); PG8_STAGE(PG8_SA(1, 0), a3, voffA);
            PG8_BAR; PG8_WAIT_L(0); PG8_MMA(1, 0, At, B0); PG8_BAR; PG8_SCHED;
            PG8_STAGE(PG8_SB(1, 1), b3 + hstep, voffB);
            PG8_WAIT_V(6); PG8_BAR; PG8_MMA(1, 1, At, B1); PG8_BAR;
            }
        }
        if constexpr (F8) asm volatile("s_nop 15\n\ts_nop 15" ::: "memory");
        if constexpr (I8) {
            const int r0_ = cur.pm * BM + wr * 64 + fr, c0_ = cur.pn * BM + wc * 32 + 8 * fq;
#pragma unroll
            for (int a = 0; a < 2; ++a)
#pragma unroll
                for (int m = 0; m < 4; ++m) { const float sa_ = g.sa[r0_ + a * HALF + m * 16] * (1.f / 127.f);
#pragma unroll
                    for (int b = 0; b < 2; ++b)
#pragma unroll
                        for (int n = 0; n < 2; ++n) { const f32x4 sw_ = *(const f32x4*)(g.sw + c0_ + b * HALF + n * 4); const i32x4_t c_ = __builtin_bit_cast(i32x4_t, acc[a][b][m][n]);
                            acc[a][b][m][n] = (f32x4){(float)c_.x * sa_ * sw_.x, (float)c_.y * sa_ * sw_.y, (float)c_.z * sa_ * sw_.z, (float)c_.w * sa_ * sw_.w}; } } }
        if constexpr (ALIGN_EPI) { if (wr == 0) PG8_BAR; }
        if constexpr (!Epi::AFTER_DRAIN) { int fr_ = fr, fq_ = fq; asm volatile("" : "+v"(fr_), "+v"(fq_));
            E(acc, cur, wr, wc, fr_, fq_); S.done(cur); }
        if (!has_next) break;
#pragma unroll
        for (int a = 0; a < 2; ++a)
#pragma unroll
            for (int b = 0; b < 2; ++b)
#pragma unroll
                for (int m = 0; m < 4; ++m)
#pragma unroll
                    for (int n = 0; n < 2; ++n) acc[a][b][m][n] = (f32x4){0.f, 0.f, 0.f, 0.f};
        cur = nxt; cA = nA; cB = nB; ++ui;
        if constexpr (ALIGN_EPI) { if (wr == 1) PG8_BAR; }
    }
    PG8_WAIT_V(0);
    if constexpr (!ALIGN_EPI) { if (wr == 0) PG8_BAR; }
    PG8_BAR;
    if constexpr (Epi::AFTER_DRAIN) { E.fused(acc, cur, wr, wc, fr, fq, lds, wid, lane); S.done(cur); }
#undef PG8_SA
#undef PG8_SB
#undef PG8_STAGE
#undef PG8_LDA
#undef PG8_LDB
#undef PG8_MMA
#undef PG8_CAT8
#undef PG8_LO4
#undef PG8_HI4
#undef PG8_RD16
#undef PG8_WAIT_V
#undef PG8_WAIT_L
#undef PG8_BAR
#undef PG8_SCHED
}
}
namespace att {
typedef unsigned short bf16;
using bf16x8 = __attribute__((ext_vector_type(8))) short;
using s16x4  = __attribute__((ext_vector_type(4))) short;
using f32x16 = __attribute__((ext_vector_type(16))) float;
using u32x4  = __attribute__((ext_vector_type(4))) unsigned;
constexpr int SEQ = 4096, MTOK = 16384;
constexpr int NW = 8, QBLK = 32, KVBLK = 64;
constexpr float SCALE_MLA = 0.07216878364870323f;
constexpr float SCALE_DIL = 0.08838834764831845f;
constexpr float THR = 8.f;
constexpr float THR_MLA = 5.f;
constexpr int L_V = 0, L_KN = 32768, L_KR = 65536, L_WS = 81920, ATT_LDS_BYTES = 83968;
#define KSWZ(row, colB) ((row) * 256 + ((colB) ^ (((row) & 7) << 4)))
#define KRSWZ(row, c) ((row) * 128 + ((((c) ^ ((row) >> 1)) & 7) << 4))
#define SBAR() __builtin_amdgcn_sched_barrier(0)
__device__ __forceinline__ int crow(int r, int hi) { return (r & 3) + 8 * (r >> 2) + 4 * hi; }
__device__ __forceinline__ unsigned cvtpk(float lo, float hi) { unsigned r; asm volatile("v_cvt_pk_bf16_f32 %0, %1, %2" : "=v"(r) : "v"(lo), "v"(hi)); return r; }
__device__ __forceinline__ bf16x8 ld8(const bf16* p) { return *reinterpret_cast<const bf16x8*>(p); }

template <bool MLA> __device__ __forceinline__ void partialSM(f32x16& p0, f32x16& p1, float& m_reg, float& mn, float& alpha) {
  constexpr float SCALE = MLA ? SCALE_MLA : SCALE_DIL;
  constexpr float C = SCALE * 1.4426950408889634f;
  float pmax = p0[0];
#pragma unroll
  for (int r = 1; r < 16; ++r) pmax = fmaxf(pmax, p0[r]);
#pragma unroll
  for (int r = 0; r < 16; ++r) pmax = fmaxf(pmax, p1[r]);
  { auto rr = __builtin_amdgcn_permlane32_swap(__float_as_uint(pmax), __float_as_uint(pmax), false, false);
    pmax = fmaxf(__uint_as_float(rr[0]), __uint_as_float(rr[1])); }
  constexpr float THR_ = MLA ? THR_MLA : THR;
  if (__builtin_expect(__all(pmax - m_reg <= THR_ / SCALE), 1)) { mn = m_reg; alpha = 1.f; }
  else { mn = fmaxf(m_reg, pmax); alpha = __builtin_amdgcn_exp2f((m_reg - mn) * C); m_reg = mn; }
  float mnC = -mn * C;
#pragma unroll
  for (int r = 0; r < 16; ++r) p0[r] = fmaf(p0[r], C, mnC);
#pragma unroll
  for (int r = 0; r < 16; ++r) p1[r] = fmaf(p1[r], C, mnC);
#pragma unroll
  for (int r = 0; r < 16; ++r) p0[r] = __builtin_amdgcn_exp2f(p0[r]);
}
__device__ __forceinline__ void finishSM(f32x16& p0, f32x16& p1, float alpha, float& l_reg, bf16x8& pa0, bf16x8& pa1, bf16x8& pa2, bf16x8& pa3) {
#pragma unroll
  for (int r = 0; r < 16; ++r) p1[r] = __builtin_amdgcn_exp2f(p1[r]);
  float ps = 0;
#pragma unroll
  for (int r = 0; r < 16; ++r) ps += p0[r];
#pragma unroll
  for (int r = 0; r < 16; ++r) ps += p1[r];
  { auto rr = __builtin_amdgcn_permlane32_swap(__float_as_uint(ps), __float_as_uint(ps), false, false);
    ps = __uint_as_float(rr[0]) + __uint_as_float(rr[1]); }
  l_reg = l_reg * alpha + ps;
#define PK4(P, BASE, OUT) do { unsigned a0 = cvtpk(P[BASE + 0], P[BASE + 1]), a1 = cvtpk(P[BASE + 2], P[BASE + 3]);   \
    unsigned b0 = cvtpk(P[BASE + 4], P[BASE + 5]), b1 = cvtpk(P[BASE + 6], P[BASE + 7]);                              \
    auto r0 = __builtin_amdgcn_permlane32_swap(a0, b0, false, false); auto r1 = __builtin_amdgcn_permlane32_swap(a1, b1, false, false); \
    u32x4 w = {r0[0], r1[0], r0[1], r1[1]}; OUT = *reinterpret_cast<bf16x8*>(&w); } while (0)
  PK4(p0, 0, pa0); PK4(p0, 8, pa1); PK4(p1, 0, pa2); PK4(p1, 8, pa3);
#undef PK4
}
typedef int i32x8p __attribute__((ext_vector_type(8)));
__device__ __forceinline__ void finishSM_f8(f32x16& p0, f32x16& p1, float alpha, float& l_reg, i32x8p& pa) {
#pragma unroll
  for (int r = 0; r < 16; ++r) p1[r] = __builtin_amdgcn_exp2f(p1[r]);
  float ps = 0;
#pragma unroll
  for (int r = 0; r < 16; ++r) ps += p0[r];
#pragma unroll
  for (int r = 0; r < 16; ++r) ps += p1[r];
  { auto rr = __builtin_amdgcn_permlane32_swap(__float_as_uint(ps), __float_as_uint(ps), false, false);
    ps = __uint_as_float(rr[0]) + __uint_as_float(rr[1]); }
  l_reg = l_reg * alpha + ps;
#pragma unroll
  for (int k = 0; k < 4; ++k) { int w = __builtin_amdgcn_cvt_pk_fp8_f32(p0[4 * k], p0[4 * k + 1], 0, false); w = __builtin_amdgcn_cvt_pk_fp8_f32(p0[4 * k + 2], p0[4 * k + 3], w, true); pa[k] = w;
    int v = __builtin_amdgcn_cvt_pk_fp8_f32(p1[4 * k], p1[4 * k + 1], 0, false); v = __builtin_amdgcn_cvt_pk_fp8_f32(p1[4 * k + 2], p1[4 * k + 3], v, true); pa[4 + k] = v; }
}
__host__ __device__ __forceinline__ int vpos(int t) { return 32 * ((t >> 2) & 1) + (t & 3) + 4 * ((t >> 3) & 3) + 16 * (t >> 5); }
template <int NR> __device__ __forceinline__ void qkt(f32x16& p0, f32x16& p1, const char* Kn, const char* Kr, const bf16x8* qr, int r32, int hi) {
  p0 = f32x16{}; p1 = f32x16{};
#pragma unroll
  for (int d0 = 0; d0 < 8; ++d0) { int cb = (d0 * 16 + hi * 8) * 2;
    bf16x8 b0 = *reinterpret_cast<const bf16x8*>(Kn + KSWZ(r32, cb));
    bf16x8 b1 = *reinterpret_cast<const bf16x8*>(Kn + KSWZ(32 + r32, cb));
    p0 = __builtin_amdgcn_mfma_f32_32x32x16_bf16(b0, qr[d0], p0, 0, 0, 0);
    p1 = __builtin_amdgcn_mfma_f32_32x32x16_bf16(b1, qr[d0], p1, 0, 0, 0); }
#pragma unroll
  for (int d0 = 0; d0 < NR; ++d0) { int c = d0 * 2 + hi;
    bf16x8 b0 = *reinterpret_cast<const bf16x8*>(Kr + KRSWZ(r32, c));
    bf16x8 b1 = *reinterpret_cast<const bf16x8*>(Kr + KRSWZ(32 + r32, c));
    p0 = __builtin_amdgcn_mfma_f32_32x32x16_bf16(b0, qr[8 + d0], p0, 0, 0, 0);
    p1 = __builtin_amdgcn_mfma_f32_32x32x16_bf16(b1, qr[8 + d0], p1, 0, 0, 0); }
}
__device__ __forceinline__ int v_st(int k, int c) { const int kk = (k & ~0xC) | ((k & 4) << 1) | ((k & 8) >> 1); return ((kk >> 3) * 4 + (c >> 5)) * 512 + ((kk & 7) * 32 + (c & 31)) * 2; }
__device__ __forceinline__ int v_rd_base(int lane) { return ((lane & 3) << 3) | (((lane >> 2) & 3) << 6) | (((lane >> 4) & 1) << 5) | (((lane >> 5) & 1) << 8); }
constexpr int v_rd_off(int d0, int ks, int half) { return d0 * 512 + ks * 4096 + half * 2048; }
template <int OFF> __device__ __forceinline__ s16x4 tr_read(int vb) {
  s16x4 r; asm volatile("ds_read_b64_tr_b16 %0, %1 offset:%2" : "=&v"(r) : "v"(vb), "i"(OFF) : "memory"); return r;
}
template <int D0> __device__ __forceinline__ void pv_one(f32x16& od, int vb, bf16x8 pa0, bf16x8 pa1, bf16x8 pa2, bf16x8 pa3) {
  const s16x4 l0 = tr_read<v_rd_off(D0, 0, 0)>(vb), h0 = tr_read<v_rd_off(D0, 0, 1)>(vb), l1 = tr_read<v_rd_off(D0, 1, 0)>(vb), h1 = tr_read<v_rd_off(D0, 1, 1)>(vb);
  const s16x4 l2 = tr_read<v_rd_off(D0, 2, 0)>(vb), h2 = tr_read<v_rd_off(D0, 2, 1)>(vb), l3 = tr_read<v_rd_off(D0, 3, 0)>(vb), h3 = tr_read<v_rd_off(D0, 3, 1)>(vb);
  asm volatile("s_waitcnt lgkmcnt(0)" ::: "memory"); SBAR();
#define PK(L, H) (bf16x8){L[0], L[1], L[2], L[3], H[0], H[1], H[2], H[3]}
  od = __builtin_amdgcn_mfma_f32_32x32x16_bf16(pa0, PK(l0, h0), od, 0, 0, 0);
  od = __builtin_amdgcn_mfma_f32_32x32x16_bf16(pa1, PK(l1, h1), od, 0, 0, 0);
  od = __builtin_amdgcn_mfma_f32_32x32x16_bf16(pa2, PK(l2, h2), od, 0, 0, 0);
  od = __builtin_amdgcn_mfma_f32_32x32x16_bf16(pa3, PK(l3, h3), od, 0, 0, 0);
#undef PK
}
__device__ __forceinline__ void pv_d0(f32x16* o, int vb, bf16x8 pa0, bf16x8 pa1, bf16x8 pa2, bf16x8 pa3) {
  pv_one<0>(o[0], vb, pa0, pa1, pa2, pa3); pv_one<1>(o[1], vb, pa0, pa1, pa2, pa3); pv_one<2>(o[2], vb, pa0, pa1, pa2, pa3); pv_one<3>(o[3], vb, pa0, pa1, pa2, pa3);
}
__device__ __forceinline__ void store_o_bf16(const f32x16* o, float l_reg, float* wsf, char* stg, bf16* Ow, long rstride, int lane_in, int, int) {
  int lane = lane_in; asm volatile("" : "+v"(lane)); const int r32 = lane & 31, hi = lane >> 5;
  if (hi == 0) wsf[r32] = l_reg; asm volatile("s_waitcnt lgkmcnt(0)" ::: "memory");
  float rli[16];
#pragma unroll
  for (int r = 0; r < 16; ++r) rli[r] = __builtin_amdgcn_rcpf(wsf[crow(r, hi)]);
  unsigned short* st = (unsigned short*)stg;
#pragma unroll
  for (int r = 0; r < 16; ++r) { const int orow = crow(r, hi);
#pragma unroll
    for (int d0 = 0; d0 < 4; ++d0) { const float v = o[d0][r] * rli[r]; st[orow * 128 + d0 * 32 + r32] = (unsigned short)(cvtpk(v, v) & 0xffffu); } }
  asm volatile("s_waitcnt lgkmcnt(0)" ::: "memory");
#pragma unroll
  for (int i = 0; i < 8; ++i) { const int row = i * 4 + (lane >> 4), ch = lane & 15; const u32x4 v = *(const u32x4*)(stg + row * 256 + ch * 16); *(u32x4*)(Ow + (long)row * rstride + ch * 8) = v; }
}

typedef __attribute__((address_space(3))) char* lds_ptr;
typedef short v4i16_t __attribute__((ext_vector_type(4)));
__device__ __forceinline__ bf16x8 ldsf(lds_ptr p, int off) { return *(const __attribute__((address_space(3))) bf16x8*)(p + off); }
__device__ __forceinline__ s16x4 vtr(lds_ptr p, int off) { return __builtin_bit_cast(s16x4, __builtin_amdgcn_ds_read_tr16_b64_v4i16((__attribute__((address_space(3))) v4i16_t*)(p + off))); }
template <int S> __device__ __forceinline__ void kld(bf16x8& lo, bf16x8& hi_, lds_ptr Kn, lds_ptr Kr, int rown, int tn, int rowr, int tr) {
  if constexpr (S < 8) { const int off = rown + (((S & 3) * 32) ^ tn) + (S >> 2) * 128; lo = ldsf(Kn, off); hi_ = ldsf(Kn, off + 8192); }
  else { const int off = rowr + (((S - 8) * 32) ^ tr); lo = ldsf(Kr, off); hi_ = ldsf(Kr, off + 4096); }
}
template <int NS> __device__ __forceinline__ void qkt_ring(f32x16& p0, f32x16& p1, lds_ptr Kn, lds_ptr Kr, const bf16x8* qr, int r32, int hi) {
  const int rown = r32 * 256, tn = (hi * 16) ^ ((r32 & 7) << 4), rowr = r32 * 128, tr = (hi ^ ((r32 >> 1) & 7)) << 4;
  bf16x8 a0, a1, b0, b1, c0, c1;
  p0 = f32x16{}; p1 = f32x16{};
  kld<0>(a0, a1, Kn, Kr, rown, tn, rowr, tr); kld<1>(b0, b1, Kn, Kr, rown, tn, rowr, tr);
#define QSTEP(S, C0, C1, N0, N1) do { if constexpr ((S) < NS) { if constexpr ((S) + 2 < NS) kld<((S) + 2 < NS ? (S) + 2 : 0)>(N0, N1, Kn, Kr, rown, tn, rowr, tr); SBAR(); \
    p0 = __builtin_amdgcn_mfma_f32_32x32x16_bf16(C0, qr[(S) < NS ? (S) : 0], p0, 0, 0, 0); p1 = __builtin_amdgcn_mfma_f32_32x32x16_bf16(C1, qr[(S) < NS ? (S) : 0], p1, 0, 0, 0); SBAR(); } } while (0)
  QSTEP(0, a0, a1, c0, c1); QSTEP(1, b0, b1, a0, a1); QSTEP(2, c0, c1, b0, b1); QSTEP(3, a0, a1, c0, c1); QSTEP(4, b0, b1, a0, a1); QSTEP(5, c0, c1, b0, b1);
  QSTEP(6, a0, a1, c0, c1); QSTEP(7, b0, b1, a0, a1); QSTEP(8, c0, c1, b0, b1); QSTEP(9, a0, a1, c0, c1); QSTEP(10, b0, b1, a0, a1); QSTEP(11, c0, c1, b0, b1);
#undef QSTEP
}
#define VOFF(i, half) v_rd_off((i) >> 2, (i) & 3, half)
__device__ __forceinline__ void pv_ring_pre(lds_ptr vp, s16x4& la, s16x4& ha, s16x4& lb, s16x4& hb) { la = vtr(vp, VOFF(0, 0)); ha = vtr(vp, VOFF(0, 1)); lb = vtr(vp, VOFF(1, 0)); hb = vtr(vp, VOFF(1, 1)); }
__device__ __forceinline__ void pv_ring(f32x16* o, lds_ptr vp, s16x4 la, s16x4 ha, s16x4 lb, s16x4 hb, bf16x8 pa0, bf16x8 pa1, bf16x8 pa2, bf16x8 pa3) {
  s16x4 lc, hc;
#define PKV(L, H) (bf16x8){L[0], L[1], L[2], L[3], H[0], H[1], H[2], H[3]}
#define PSTEP(I, PA, CL, CH, NL, NH) do { if constexpr ((I) + 2 < 16) { NL = vtr(vp, VOFF(((I) + 2) & 15, 0)); NH = vtr(vp, VOFF(((I) + 2) & 15, 1)); } SBAR(); \
    o[(I) >> 2] = __builtin_amdgcn_mfma_f32_32x32x16_bf16(PA, PKV(CL, CH), o[(I) >> 2], 0, 0, 0); SBAR(); } while (0)
  PSTEP(0, pa0, la, ha, lc, hc);  PSTEP(1, pa1, lb, hb, la, ha);  PSTEP(2, pa2, lc, hc, lb, hb);  PSTEP(3, pa3, la, ha, lc, hc);
  PSTEP(4, pa0, lb, hb, la, ha);  PSTEP(5, pa1, lc, hc, lb, hb);  PSTEP(6, pa2, la, ha, lc, hc);  PSTEP(7, pa3, lb, hb, la, ha);
  PSTEP(8, pa0, lc, hc, lb, hb);  PSTEP(9, pa1, la, ha, lc, hc);  PSTEP(10, pa2, lb, hb, la, ha); PSTEP(11, pa3, lc, hc, lb, hb);
  PSTEP(12, pa0, la, ha, lc, hc); PSTEP(13, pa1, lb, hb, la, ha); PSTEP(14, pa2, lc, hc, lb, hb); PSTEP(15, pa3, la, ha, lc, hc);
#undef PSTEP
#undef PKV
}
constexpr int M_V = 0, M_KN = 24576, M_KR = 49152, M_WS = 65536, MLA_LDS_BYTES = 67584;
typedef int i32x4_t __attribute__((ext_vector_type(4)));
typedef int i32x8_t __attribute__((ext_vector_type(8)));
__device__ __forceinline__ void glds16(const void* gsrc, unsigned lds_dst) { unsigned keep;
  asm volatile("s_mov_b32 %0, m0\n\ts_mov_b32 m0, %2\n\ts_nop 0\n\tglobal_load_lds_dwordx4 %1, off\n\ts_mov_b32 m0, %0" : "=&s"(keep) : "v"(gsrc), "s"(lds_dst) : "memory"); }
#define WAIT_BAR(N) asm volatile("s_waitcnt vmcnt(" #N ") lgkmcnt(0)\n\ts_barrier" ::: "memory")
__device__ __forceinline__ i32x4_t ldsq(lds_ptr p, int off) { return *(const __attribute__((address_space(3))) i32x4_t*)(p + off); }
#define CAT8(lo, hi) __builtin_shufflevector(lo, hi, 0, 1, 2, 3, 4, 5, 6, 7)
__device__ __forceinline__ void qkt_f8(f32x16& p0, f32x16& p1, lds_ptr Kn, lds_ptr Kr, const i32x8_t* q8, int r32, int hi, int sc) {
  const int swn = (r32 >> 1) & 7, swr = (r32 >> 2) & 3, rown = r32 * 128, rowr = r32 * 64;
  i32x8_t kf[6];
#pragma unroll
  for (int kb = 0; kb < 2; ++kb) {
#pragma unroll
    for (int c = 0; c < 2; ++c) { const int ci = c * 4 + 2 * hi; kf[kb * 3 + c] = CAT8(ldsq(Kn, kb * 4096 + rown + ((ci ^ swn) << 4)), ldsq(Kn, kb * 4096 + rown + (((ci + 1) ^ swn) << 4))); }
    { const int ci = 2 * hi; kf[kb * 3 + 2] = CAT8(ldsq(Kr, kb * 2048 + rowr + ((ci ^ swr) << 4)), ldsq(Kr, kb * 2048 + rowr + (((ci + 1) ^ swr) << 4))); }
  }
#define MF0(P, A, B) asm volatile("v_mfma_scale_f32_32x32x64_f8f6f4 %0, %1, %2, 0, %3, %3 op_sel_hi:[0,0,0]" : "=&v"(P) : "v"(A), "v"(B), "v"(sc))
#define MF1(P, A, B) asm volatile("v_mfma_scale_f32_32x32x64_f8f6f4 %0, %1, %2, %0, %3, %3 op_sel_hi:[0,0,0]" : "+v"(P) : "v"(A), "v"(B), "v"(sc))
  MF0(p0, kf[0], q8[0]); MF0(p1, kf[3], q8[0]); MF1(p0, kf[1], q8[1]); MF1(p1, kf[4], q8[1]); MF1(p0, kf[2], q8[2]); MF1(p1, kf[5], q8[2]);
  asm volatile("s_nop 15\n\ts_nop 7" : "+v"(p0), "+v"(p1));
#undef MF0
#undef MF1
}
__device__ __forceinline__ void pv_f8(f32x16* o, lds_ptr Vt, i32x8_t pa, int r32, int hi, int sc) {
  i32x8_t vf[4];
#pragma unroll
  for (int d0 = 0; d0 < 4; ++d0) { const int d = 32 * d0 + r32, sw = (d >> 2) & 3, ci = 2 * hi; vf[d0] = CAT8(ldsq(Vt, d * 64 + ((ci ^ sw) << 4)), ldsq(Vt, d * 64 + (((ci + 1) ^ sw) << 4))); }
#pragma unroll
  for (int d0 = 0; d0 < 4; ++d0) asm volatile("v_mfma_scale_f32_32x32x64_f8f6f4 %0, %1, %2, %0, %3, %3 op_sel_hi:[0,0,0]" : "+v"(o[d0]) : "v"(pa), "v"(vf[d0]), "v"(sc));
}
__device__ __forceinline__ void mla_unit(const unsigned char* __restrict__ Q8b, const unsigned char* __restrict__ K8h, const unsigned char* __restrict__ Vth, const unsigned char* __restrict__ KR8h, bf16* __restrict__ Ob, char* lds) {
  constexpr int LDQ = 192, LDK = 128, LDR = 64, LDO = 3072, SHM_V = 8192, SHM_K = 8192, SHM_R = 4096;
  const int tid = threadIdx.x, wid = __builtin_amdgcn_readfirstlane(tid >> 6), lane = tid & 63, r32 = lane & 31, hi = lane >> 5;
  const lds_ptr l3 = (lds_ptr)lds; const unsigned lds0 = (unsigned)(uintptr_t)lds;
  float* ws = (float*)(lds + M_WS) + wid * 64; float* al_l = ws + 32;
  float m_reg = -1e30f, l_reg = 0; f32x16 o[4] = {}; i32x8_t q8[3];
  int sc = 0x7f7f7f7f; asm volatile("" : "+v"(sc));
  const unsigned char *pk, *pr, *pv;
  { const int rk = 8 * wid + (lane >> 3); pk = K8h + (long)rk * LDK + (((lane & 7) ^ ((rk >> 1) & 7)) << 4);
    const int rr = 8 * wid + ((lane & 31) >> 2); pr = KR8h + (long)rr * LDR + (((lane & 3) ^ ((rr >> 2) & 3)) << 4);
    const int dv_ = 16 * wid + (lane >> 2); pv = Vth + (long)dv_ * 64 + (((lane & 3) ^ ((dv_ >> 2) & 3)) << 4); }
#define DMA_K(slot) do { const unsigned dk = (unsigned)__builtin_amdgcn_readfirstlane((int)(lds0 + M_KN + (slot) * SHM_K + wid * 1024)), dr = (unsigned)__builtin_amdgcn_readfirstlane((int)(lds0 + M_KR + (slot) * SHM_R + wid * 512)); \
    glds16(pk, dk); if (lane < 32) glds16(pr, dr); pk += KVBLK * LDK; pr += KVBLK * LDR; } while (0)
#define DMA_V(slot) do { const unsigned dv = (unsigned)__builtin_amdgcn_readfirstlane((int)(lds0 + M_V + (slot) * SHM_V + wid * 1024)); glds16(pv, dv); pv += 8192; } while (0)
  DMA_V(0); DMA_K(0); DMA_K(1);
  { const unsigned char* Qw = Q8b + (long)(wid * QBLK + r32) * LDQ + 32 * hi;
#pragma unroll
    for (int c = 0; c < 3; ++c) q8[c] = CAT8(*(const i32x4_t*)(Qw + c * 64), *(const i32x4_t*)(Qw + c * 64 + 16)); }
#define RESC(a) do { if (__any((a) < 1.f)) { if (hi == 0) al_l[r32] = (a); asm volatile("s_waitcnt lgkmcnt(0)" ::: "memory"); \
    _Pragma("unroll") for (int d = 0; d < 4; ++d) _Pragma("unroll") for (int r = 0; r < 16; ++r) o[d][r] *= al_l[crow(r, hi)]; } } while (0)
  f32x16 p0, p1; float mn, al; i32x8_t pa8 = {}; constexpr int NT = SEQ / KVBLK;
  WAIT_BAR(2);
  const bool late = wid >= 4;
  int s_cur = 0, s_nx1 = 1, s_nx2 = 2, s_prev = 2;
#pragma clang loop unroll(disable)
  for (int j = 0; j < NT; ++j) {
    const bool more2 = (j + 2 < NT);
    if (j + 1 < NT) DMA_V(s_nx1);
    if (more2) DMA_K(s_nx2);
    SBAR();
    if (late) { if (j > 0) pv_f8(o, l3 + M_V + s_prev * SHM_V, pa8, r32, hi, sc); }
    SBAR();
    qkt_f8(p0, p1, l3 + M_KN + s_cur * SHM_K, l3 + M_KR + s_cur * SHM_R, q8, r32, hi, sc);
    partialSM<true>(p0, p1, m_reg, mn, al); RESC(al);
    finishSM_f8(p0, p1, al, l_reg, pa8); SBAR();
    if (!late) pv_f8(o, l3 + M_V + s_cur * SHM_V, pa8, r32, hi, sc);
    SBAR();
    if (more2) WAIT_BAR(2); else WAIT_BAR(0);
    s_prev = s_cur; s_cur = s_nx1; s_nx1 = s_nx2; s_nx2 = (s_nx2 == 2) ? 0 : s_nx2 + 1;
  }
  if (late) pv_f8(o, l3 + M_V + s_prev * SHM_V, pa8, r32, hi, sc);
  asm volatile("s_nop 15\n\ts_nop 7" : "+v"(o[0]), "+v"(o[1]), "+v"(o[2]), "+v"(o[3]));
  WAIT_BAR(0);
  store_o_bf16(o, l_reg, ws, lds + wid * 8192, Ob + (long)(wid * QBLK) * LDO, LDO, lane, r32, hi);
  __syncthreads();
#undef DMA_K
#undef DMA_V
}
#undef CAT8
#undef WAIT_BAR

__device__ __forceinline__ void dil_unit(int b, int g, int h, int rho, int blk, const bf16* __restrict__ QD, const bf16* __restrict__ KD, const bf16* __restrict__ VD, bf16* __restrict__ PD, float* __restrict__ LSE, char* lds) {
  constexpr float C = SCALE_DIL * 1.4426950408889634f;
  const int d = (g == 0) ? 1 : (g == 1 ? 4 : 16), L = SEQ / d, t0 = blk * 256;
  const int tid = threadIdx.x, wid = __builtin_amdgcn_readfirstlane(tid >> 6), lane = tid & 63, r32 = lane & 31, hi = lane >> 5;
  const lds_ptr l3 = (lds_ptr)lds; char* V_lds = lds + L_V; char* K_lds = lds + L_KN;
  float* ws = (float*)(lds + L_WS) + wid * 64; float* al_l = ws + 32;
  const long tokbase = (long)b * SEQ; const long hbase = ((long)(b * 24 + g * 8 + h) * SEQ) * 128;
  float m_reg = -1e30f, l_reg = 0; f32x16 o[4] = {}; bf16x8 qr[8];
  const int tauq = t0 + wid * QBLK + r32;
  { const bf16* Qw = QD + hbase + (rho + (long)d * tauq) * 128 + hi * 8;
#pragma unroll
    for (int d0 = 0; d0 < 8; ++d0) qr[d0] = ld8(Qw + d0 * 16); }
  const int kt0 = (t0 == 0) ? 1 : 0, kt1 = ((L - t0) >> 6) < 5 ? ((L - t0) >> 6) : 5;
  bf16x8 s_ka, s_kb, s_va, s_vb;
#define DLOAD(kt_) do { int t_ = tid; asm volatile("" : "+v"(t_)); const int sr = t_ >> 4, sc = (t_ & 15) * 8, kb_ = t0 - 64 + 64 * (kt_); int ta = kb_ + sr, tb = ta + 32; \
    ta = ta < 0 ? 0 : (ta >= L ? L - 1 : ta); tb = tb < 0 ? 0 : (tb >= L ? L - 1 : tb); \
    const long oa = hbase + (rho + (long)d * ta) * 128 + sc, ob = hbase + (rho + (long)d * tb) * 128 + sc; s_ka = ld8(KD + oa); s_kb = ld8(KD + ob); s_va = ld8(VD + oa); s_vb = ld8(VD + ob); } while (0)
#define DWRITE(buf) do { int t_ = tid; asm volatile("" : "+v"(t_)); const int sr = t_ >> 4, sc = (t_ & 15) * 8, vst0 = v_st(sr, sc), kc = sc * 2; \
    *(bf16x8*)(V_lds + (buf) * 16384 + vst0) = s_va; *(bf16x8*)(V_lds + (buf) * 16384 + vst0 + 8192) = s_vb; *(bf16x8*)(K_lds + (buf) * 16384 + KSWZ(sr, kc)) = s_ka; *(bf16x8*)(K_lds + (buf) * 16384 + KSWZ(sr, kc) + 8192) = s_kb; } while (0)
  DLOAD(kt0); DWRITE(0); __syncthreads();
  int buf = 0;
  for (int kt = kt0; kt <= kt1; ++kt) {
    const bool more = kt < kt1;
    if (more) DLOAD(kt + 1);
    SBAR();
    if (kt >= (wid >> 1) && kt <= (wid >> 1) + 2) {
      f32x16 p0, p1; float mn, al; bf16x8 pa0, pa1, pa2, pa3; const int kbase = t0 - 64 + 64 * kt;
      qkt_ring<8>(p0, p1, l3 + L_KN + buf * 16384, l3 + L_KN, qr, r32, hi);
      s16x4 vla, vha, vlb, vhb; const lds_ptr vp_ = l3 + L_V + buf * 16384 + v_rd_base(lane); pv_ring_pre(vp_, vla, vha, vlb, vhb);
      const int dl0 = kbase - tauq;
#pragma unroll
      for (int r = 0; r < 16; ++r) { const int kk = crow(r, hi); const int dl = dl0 + kk, tp = kbase + kk;
        if (!(dl >= -64 && dl <= 64 && tp >= 0 && tp < L)) p0[r] = -1e30f;
        if (!(dl + 32 >= -64 && dl + 32 <= 64 && tp + 32 >= 0 && tp + 32 < L)) p1[r] = -1e30f; }
      partialSM<false>(p0, p1, m_reg, mn, al);
      RESC(al);
      finishSM(p0, p1, al, l_reg, pa0, pa1, pa2, pa3); SBAR();
      pv_ring(o, vp_, vla, vha, vlb, vhb, pa0, pa1, pa2, pa3);
    }
    if (more) DWRITE(buf ^ 1);
    __syncthreads();
    buf ^= 1;
  }
  if (hi == 0) LSE[((long)g * MTOK + tokbase + rho + (long)d * tauq) * 8 + h] = m_reg * C + __builtin_amdgcn_logf(l_reg);
  store_o_bf16(o, l_reg, ws, lds + wid * 8192, PD + ((long)g * MTOK + tokbase + rho + (long)d * (t0 + wid * QBLK)) * 1024 + h * 128, (long)d * 1024, lane, r32, hi);
  __syncthreads();
#undef DLOAD
#undef DWRITE
#undef RESC
}
#undef SBAR
}

#define GAS __attribute__((address_space(1)))
#define LAS __attribute__((address_space(3)))
typedef unsigned short bf16;
typedef unsigned v4u __attribute__((ext_vector_type(4)));
typedef float f32x4 __attribute__((ext_vector_type(4)));
typedef short bf16x8 __attribute__((ext_vector_type(8)));
typedef GAS unsigned gu32;
typedef GAS unsigned long long gu64;
#define RLX_AGENT __ATOMIC_RELAXED, __HIP_MEMORY_SCOPE_AGENT
#define LDS_WAIT() asm volatile("s_waitcnt lgkmcnt(0)" ::: "memory")
#define VM_WAIT() asm volatile("s_waitcnt vmcnt(0)" ::: "memory")
__device__ __forceinline__ unsigned long long rt() { return __builtin_amdgcn_s_memrealtime(); }
__device__ __forceinline__ unsigned f2bf(float f) { unsigned u = __builtin_bit_cast(unsigned, f); return (u + 0x7fffu + ((u >> 16) & 1u)) >> 16; }
__device__ __forceinline__ unsigned pk2(float lo, float hi) { return f2bf(lo) | (f2bf(hi) << 16); }

#define XB_TMO      128
#define XB_XCNT(j)  (256  + 64 * (j))
#define XB_XSUB(j)  (1280 + 64 * (j))
#define XB_XGEN(j)  (2304 + 64 * (j))
#define XB_TOP      3328
#define XB_TOPGEN   3392
#define XCD_BAR_WORDS 3456
#define XB_SPIN_CAP (1u << 18)

__device__ __forceinline__ unsigned xb_ld(unsigned* p)              { return __hip_atomic_load(p, __ATOMIC_RELAXED, __HIP_MEMORY_SCOPE_AGENT); }
__device__ __forceinline__ unsigned xb_add(unsigned* p, unsigned v) { return __hip_atomic_fetch_add(p, v, __ATOMIC_RELAXED, __HIP_MEMORY_SCOPE_AGENT); }
__device__ __forceinline__ unsigned xb_xcc_id() { return (unsigned)__builtin_amdgcn_s_getreg((3 << 11) | 20) & 0xFu; }
#define XB_SPIN(cond, bar) do { unsigned _sp = 0; while (cond) { __builtin_amdgcn_s_sleep(1); \
    if ((++_sp & 255u) == 0u) { if (xb_ld(&(bar)[XB_TMO])) break; if (_sp > XB_SPIN_CAP) { atomicAdd(&(bar)[XB_TMO], 1u); break; } } } } while (0)

struct XcdBarrier {
    unsigned* bar; unsigned x;
    volatile LAS unsigned* st;
};

__device__ __forceinline__ XcdBarrier xcd_barrier_post(unsigned* bar, volatile LAS unsigned* st) {
    XcdBarrier b; b.bar = bar; b.x = xb_xcc_id(); b.st = st;
    if (threadIdx.x == 0) (void)xb_add(&bar[XB_XCNT(b.x)], 1u);
    return b;
}
__device__ __forceinline__ void xcd_barrier_complete(unsigned* bar, unsigned x, unsigned& nloc, unsigned& nx) {
    const unsigned G = gridDim.x * gridDim.y * gridDim.z;
    unsigned sum, cnt, mine, sp = 0u;
    for (;;) {
        sum = 0u; cnt = 0u; mine = 0u;
#pragma unroll
        for (unsigned j = 0; j < 16; ++j) { const unsigned c = xb_ld(&bar[XB_XCNT(j)]); sum += c; cnt += (c > 0u) ? 1u : 0u; mine = (j == x) ? c : mine; }
        if (sum == G) break;
        __builtin_amdgcn_s_sleep(1);
        if ((++sp & 255u) == 0u) { if (xb_ld(&bar[XB_TMO])) break; if (sp > XB_SPIN_CAP) { atomicAdd(&bar[XB_TMO], 1u); break; } }
    }
    nloc = mine > 0u ? mine : 1u; nx = cnt > 0u ? cnt : 1u;
}

__device__ __forceinline__ void xcd_barrier(const XcdBarrier& b) {
    asm volatile("s_waitcnt vmcnt(0)" ::: "memory");
    __syncthreads();
    if (threadIdx.x == 0) {
        unsigned* bar = b.bar;
        __builtin_amdgcn_s_waitcnt(0);
        unsigned nloc = b.st[0], nx = b.st[1];
        if (nloc == 0u) { xcd_barrier_complete(bar, b.x, nloc, nx); b.st[0] = nloc; b.st[1] = nx; }
        const unsigned old = xb_add(&bar[XB_XSUB(b.x)], 1u);
        const unsigned gen = old / nloc;
        if (old + 1u == (gen + 1u) * nloc) {
            __builtin_amdgcn_fence(__ATOMIC_RELEASE, "agent");
            asm volatile("s_waitcnt vmcnt(0)" ::: "memory");
            const unsigned og = xb_add(&bar[XB_TOP], 1u);
            const unsigned tg = og / nx;
            if (og + 1u == (tg + 1u) * nx) xb_add(&bar[XB_TOPGEN], 1u);
            else XB_SPIN(xb_ld(&bar[XB_TOPGEN]) == tg, bar);
            __builtin_amdgcn_fence(__ATOMIC_ACQUIRE, "agent");
            xb_add(&bar[XB_XGEN(b.x)], 1u);
            asm volatile("s_waitcnt vmcnt(0)" ::: "memory");
        } else {
            XB_SPIN(xb_ld(&bar[XB_XGEN(b.x)]) == gen, bar);
            __builtin_amdgcn_fence(__ATOMIC_ACQUIRE, "agent");
            asm volatile("s_waitcnt vmcnt(0)" ::: "memory");
        }
    }
    __syncthreads();
}

constexpr int NWAVES = 8;
constexpr int BATCH = 4, SEQ = 4096, DM = 4096, M = BATCH * SEQ;
constexpr int QRANK = 1024, KVRANK = 512, DFF = 11008, IN_TOTAL = 19008, N_IN = 19200  , N_MOD = 6 * DM;
constexpr float NORM_EPS = 1e-6f;
#ifndef PG_ALIGN
#define PG_ALIGN true
#endif
#ifndef PG_SP2
#define PG_SP2 true
#endif
#ifdef SELFCHECK
#define HB_OR_NULL(p) (p)
#else
#define HB_OR_NULL(p) (pg8::P3_NBF > 0 ? (p) : nullptr)
#endif
#ifndef CHK_MASK
#define CHK_MASK 0xffffffff
#endif
#ifndef MK_N_LAUNCHES
#define MK_N_LAUNCHES 1
#endif
constexpr int PER_PHASE = 14;
constexpr int N_LAUNCHES = MK_N_LAUNCHES;
static_assert(N_LAUNCHES == 1 || N_LAUNCHES == PER_PHASE, "MK_N_LAUNCHES is 1 or 14");

constexpr size_t MiB = 1u << 20;
constexpr size_t WS_CTL = 0, CTL_ZERO_BYTES = 1 * MiB;
constexpr size_t WS_MOD = 1 * MiB;
constexpr size_t WS_VEC = WS_MOD + 4 * N_MOD * 4;
constexpr size_t WS_COSF = 2 * MiB, WS_SINF = 6 * MiB;
constexpr size_t WS_COSR = 10 * MiB, WS_SINR = 12 * MiB;
constexpr size_t WS_KROPE = 14 * MiB;
constexpr size_t WS_LSE = 16 * MiB;
constexpr size_t WS_MODP = 18 * MiB;
constexpr int KSPLIT = 64;
constexpr size_t WS_WIN = 48 * MiB, WS_WUQ = 198 * MiB, WS_WUKV = 204 * MiB, WS_WPA = 208 * MiB, WS_WPB = 224 * MiB, WS_WOUT = 232 * MiB, WS_WGU = 264 * MiB, WS_WDN = 436 * MiB;
constexpr size_t WS_A = 522 * MiB;
constexpr size_t WS_QD = 650 * MiB, WS_KD = 746 * MiB, WS_VD = 842 * MiB;
constexpr size_t WS_GA = 938 * MiB, WS_GB = 1066 * MiB;
constexpr size_t WS_ZQ = 1194 * MiB, WS_ZKV = 1226 * MiB, WS_ZKR = 1242 * MiB, WS_QN = 1250 * MiB, WS_KVN = 1282 * MiB;
constexpr size_t WS_PD = 1194 * MiB;
constexpr size_t WS_KV = 1298 * MiB;
constexpr size_t WS_YA = 1426 * MiB, WS_YB = 1490 * MiB;
constexpr size_t WS_X1B = 1194 * MiB, WS_X2B = 1322 * MiB;
constexpr size_t WS_H8 = 1298 * MiB;
constexpr size_t WS_END = 1522 * MiB;
static_assert(WS_WIN + (size_t)N_IN * DM * 2 <= WS_WUQ && WS_WGU + (size_t)2 * DFF * DM * 2 <= WS_WDN && WS_WDN + (size_t)DM * DFF * 2 <= WS_A, "weights map");
static_assert(WS_QD + (size_t)M * DFF * 2 <= WS_ZQ && WS_PD + (size_t)3 * M * 1024 * 2 <= WS_KV && WS_KV + (size_t)M * 4096 * 2 <= WS_YA && WS_YB + (size_t)M * 1024 * 2 <= WS_END, "activation map");
static_assert(WS_MODP + (size_t)KSPLIT * 4 * N_MOD * 4 <= WS_WIN && WS_VEC + 6 * 4 * DM * 4 <= WS_COSF, "misc map");
constexpr int CW_BAR = 4096;
constexpr int P11_T8 = 52;

constexpr int RING_OFF = 0, RING_BYTES = 131072;
constexpr int LDSCTL_OFF = RING_BYTES, MISC_OFF = LDSCTL_OFF + 320;
constexpr int LDS_BYTES = 147456;
static_assert(MISC_OFF + 128 <= LDS_BYTES && att::ATT_LDS_BYTES <= RING_BYTES && att::MLA_LDS_BYTES <= RING_BYTES, "LDS map");

__device__ const float INVF[64] = {
1.000000000e+00f, 8.659643531e-01f, 7.498942018e-01f, 6.493816376e-01f, 5.623413324e-01f, 4.869675338e-01f, 4.216965139e-01f, 3.651741147e-01f, 3.162277639e-01f, 2.738419771e-01f, 2.371373773e-01f, 2.053525001e-01f, 1.778279394e-01f, 1.539926529e-01f, 1.333521456e-01f, 1.154781953e-01f,
1.000000015e-01f, 8.659642935e-02f, 7.498942316e-02f, 6.493816525e-02f, 5.623413250e-02f, 4.869675264e-02f, 4.216964915e-02f, 3.651741147e-02f, 3.162277490e-02f, 2.738419548e-02f, 2.371373773e-02f, 2.053525113e-02f, 1.778279431e-02f, 1.539926510e-02f, 1.333521400e-02f, 1.154781971e-02f,
9.999999776e-03f, 8.659643121e-03f, 7.498942316e-03f, 6.493816152e-03f, 5.623413250e-03f, 4.869675264e-03f, 4.216964822e-03f, 3.651741194e-03f, 3.162277630e-03f, 2.738419687e-03f, 2.371373819e-03f, 2.053525066e-03f, 1.778279431e-03f, 1.539926510e-03f, 1.333521446e-03f, 1.154782018e-03f,
1.000000047e-03f, 8.659643354e-04f, 7.498941850e-04f, 6.493816036e-04f, 5.623413017e-04f, 4.869675322e-04f, 4.216965172e-04f, 3.651741135e-04f, 3.162277571e-04f, 2.738419571e-04f, 2.371373703e-04f, 2.053525095e-04f, 1.778279402e-04f, 1.539926598e-04f, 1.333521504e-04f, 1.154782003e-04f };

struct Frame {
    LAS unsigned char* lds;
    volatile LAS unsigned* MISC;
    gu32* ctl;
    int tid, lane, wave;
    int vcu, G;
};
__device__ __forceinline__ float wave_sum(float v) {
#pragma unroll
    for (int o = 1; o < 64; o <<= 1) v += __shfl_xor(v, o);
    return v;
}
__device__ __forceinline__ float wave_max(float v) {
#pragma unroll
    for (int o = 1; o < 64; o <<= 1) v = fmaxf(v, __shfl_xor(v, o));
    return v;
}
__device__ __forceinline__ unsigned pk4_i8(float a, float b, float c, float d) {
    const int ia = __float2int_rn(a), ib = __float2int_rn(b), ic = __float2int_rn(c), id = __float2int_rn(d);
    return ((unsigned)ia & 0xffu) | (((unsigned)ib & 0xffu) << 8) | (((unsigned)ic & 0xffu) << 16) | ((unsigned)id << 24); }
__device__ __forceinline__ void sincos_d(double a, float& s, float& c) {
    const double n = __builtin_rint(a * 0.63661977236758134308);
    const double r = (a - n * 1.57079632673412561417e+00) - n * 6.07710050650619224932e-11;
    const double z = r * r;
    const double sp = r + r * z * (-1.66666666666666324348e-01 + z * (8.33333333332248946124e-03 + z * (-1.98412698298579493134e-04 + z * (2.75573137070700676789e-06 + z * (-2.50507602534068634195e-08 + z * 1.58969099521155010221e-10)))));
    const double cp = 1.0 - 0.5 * z + z * z * (4.16666666666666019037e-02 + z * (-1.38888888888741095749e-03 + z * (2.48015872894767294178e-05 + z * (-2.75573143513906633035e-07 + z * (2.08757232129817482790e-09 + z * -1.13596475577881948265e-11)))));
    const int q = ((int)n) & 3;
    const double ss = (q & 1) ? cp : sp, cc = (q & 1) ? sp : cp;
    s = (float)((q & 2) ? -ss : ss); c = (float)(((q + 1) & 2) ? -cc : cc);
}
constexpr int NBF = pg8::P3_NBF;
__device__ __forceinline__ int win_row8(int r);
__device__ __forceinline__ int map_row_in(int n) {
    if (n < 1536) return n;
    if (n < 1600) { const int r = n - 1536; return 74 * 256 + (r >> 5) * 128 + (r & 31); }
    if (n < 10816) { const int r = n - 1600, t = r / 3072, rr = r - t * 3072;
        if (t < 2) { const int hd = rr >> 7, dd = rr & 127; return (6 + t * 12 + (hd >> 1)) * 256 + (dd >> 6) * 128 + (hd & 1) * 64 + (dd & 63); }
        return 30 * 256 + rr; }
    return 42 * 256 + (n - 10816);
}
__device__ __forceinline__ int map_row(int mode, int n) {
    if (mode == 1) return map_row_in(n);
    if (mode == 2) { const int h = n / 192, dd = n - h * 192; if (dd < 128) return h * 128 + dd; const int r = dd - 128; return (8 + (h >> 2)) * 256 + (r >> 5) * 128 + (h & 3) * 32 + (r & 31); }
    if (mode == 5) return map_row_in(n) - 6 * 256;
    if (mode == 6) return win_row8(map_row_in(n));
    if (mode == 3) return (n >> 7) * 256 + (n & 127);
    if (mode == 4) return (n >> 7) * 256 + 128 + (n & 127);
    return n;
}
__device__ __forceinline__ int win_row8(int r) { const int t = r >> 8; return ((t < 6 ? t : t - NBF) << 8) | (r & 255); }
__device__ __forceinline__ void p0_transpose_item(const float* W, int K, int N, bf16* WT, int mode, LAS float* scr, int item, int lane, int ldw = 0) {
    const int nblk = N / 32, kb = item / nblk, nb = item % nblk, k0 = 64 * kb, n0 = 32 * nb;
    float v[32];
#pragma unroll
    for (int i = 0; i < 32; ++i) { const int kk = 2 * i + (lane >> 5); v[i] = W[(size_t)(k0 + kk) * N + n0 + (lane & 31)]; }
#pragma unroll
    for (int i = 0; i < 32; ++i) { const int kk = 2 * i + (lane >> 5); scr[kk * 33 + (lane & 31)] = v[i]; }
    LDS_WAIT(); asm volatile("" ::: "memory");
    const int c = lane & 7;
#pragma unroll
    for (int j = 0; j < 4; ++j) { const int n = (lane >> 3) + 8 * j; const LAS float* s = scr + (8 * c) * 33 + n;
        v4u o; o.x = pk2(s[0 * 33], s[1 * 33]); o.y = pk2(s[2 * 33], s[3 * 33]); o.z = pk2(s[4 * 33], s[5 * 33]); o.w = pk2(s[6 * 33], s[7 * 33]);
        *(GAS v4u*)(WT + (size_t)map_row(mode, n0 + n) * (ldw ? ldw : K) + k0 + 8 * c) = o; }
    LDS_WAIT(); asm volatile("" ::: "memory");
}
__device__ __forceinline__ unsigned pk4_f8(float a, float b, float c, float d) { int w = __builtin_amdgcn_cvt_pk_fp8_f32(a, b, 0, false); w = __builtin_amdgcn_cvt_pk_fp8_f32(c, d, w, true); return (unsigned)w; }
__device__ __forceinline__ void p0_transpose_item_f8(const float* W, int K, int N, unsigned char* W8, int mode, float wscale, LAS float* scr, int item, int lane) {
    const int nblk = N / 32, kb = item / nblk, nb = item % nblk, k0 = 64 * kb, n0 = 32 * nb;
    float v[32];
#pragma unroll
    for (int i = 0; i < 32; ++i) { const int kk = 2 * i + (lane >> 5); v[i] = W[(size_t)(k0 + kk) * N + n0 + (lane & 31)]; }
#pragma unroll
    for (int i = 0; i < 32; ++i) { const int kk = 2 * i + (lane >> 5); scr[kk * 33 + (lane & 31)] = v[i] * wscale; }
    LDS_WAIT(); asm volatile("" ::: "memory");
    const int n = lane >> 1, half = lane & 1; const LAS float* s = scr + (32 * half) * 33 + n;
    v4u o0, o1;
    o0.x = pk4_f8(s[0 * 33], s[1 * 33], s[2 * 33], s[3 * 33]);     o0.y = pk4_f8(s[4 * 33], s[5 * 33], s[6 * 33], s[7 * 33]);     o0.z = pk4_f8(s[8 * 33], s[9 * 33], s[10 * 33], s[11 * 33]);   o0.w = pk4_f8(s[12 * 33], s[13 * 33], s[14 * 33], s[15 * 33]);
    o1.x = pk4_f8(s[16 * 33], s[17 * 33], s[18 * 33], s[19 * 33]); o1.y = pk4_f8(s[20 * 33], s[21 * 33], s[22 * 33], s[23 * 33]); o1.z = pk4_f8(s[24 * 33], s[25 * 33], s[26 * 33], s[27 * 33]); o1.w = pk4_f8(s[28 * 33], s[29 * 33], s[30 * 33], s[31 * 33]);
    GAS v4u* dst = (GAS v4u*)(W8 + (size_t)map_row(mode, n0 + n) * K + k0 + 32 * half); dst[0] = o0; dst[1] = o1;
    LDS_WAIT(); asm volatile("" ::: "memory");
}
__device__ __forceinline__ void p0_colmax_item(const float* W, int N, float* CM, int mode, int item, int lane) {
    const int nblk = N / 32, kb = item / nblk, nb = item % nblk, k0 = 64 * kb, n0 = 32 * nb;
    float v[32];
#pragma unroll
    for (int i = 0; i < 32; ++i) { const int kk = 2 * i + (lane >> 5); v[i] = W[(size_t)(k0 + kk) * N + n0 + (lane & 31)]; }
    float m = 0.f;
#pragma unroll
    for (int i = 0; i < 32; ++i) m = fmaxf(m, fabsf(v[i]));
    __hip_atomic_fetch_max((unsigned*)CM + map_row(mode, n0 + (lane & 31)), __float_as_uint(m), __ATOMIC_RELAXED, __HIP_MEMORY_SCOPE_AGENT);
}
__device__ __forceinline__ void p0_transpose_item_i8(const float* W, int K, int N, unsigned char* W8, int mode, const float* CM, LAS float* scr, int item, int lane) {
    const int nblk = N / 32, kb = item / nblk, nb = item % nblk, k0 = 64 * kb, n0 = 32 * nb;
    float v[32];
#pragma unroll
    for (int i = 0; i < 32; ++i) { const int kk = 2 * i + (lane >> 5); v[i] = W[(size_t)(k0 + kk) * N + n0 + (lane & 31)]; }
#pragma unroll
    for (int i = 0; i < 32; ++i) { const int kk = 2 * i + (lane >> 5); scr[kk * 33 + (lane & 31)] = v[i]; }
    LDS_WAIT(); asm volatile("" ::: "memory");
    const int n = lane >> 1, half = lane & 1; const LAS float* s = scr + (32 * half) * 33 + n; const int row = map_row(mode, n0 + n);
    const float q = 127.f / fmaxf(__hip_atomic_load(CM + row, __ATOMIC_RELAXED, __HIP_MEMORY_SCOPE_AGENT), 1e-30f);
    v4u o0, o1;
    o0.x = pk4_i8(s[0 * 33] * q, s[1 * 33] * q, s[2 * 33] * q, s[3 * 33] * q);     o0.y = pk4_i8(s[4 * 33] * q, s[5 * 33] * q, s[6 * 33] * q, s[7 * 33] * q);     o0.z = pk4_i8(s[8 * 33] * q, s[9 * 33] * q, s[10 * 33] * q, s[11 * 33] * q);   o0.w = pk4_i8(s[12 * 33] * q, s[13 * 33] * q, s[14 * 33] * q, s[15 * 33] * q);
    o1.x = pk4_i8(s[16 * 33] * q, s[17 * 33] * q, s[18 * 33] * q, s[19 * 33] * q); o1.y = pk4_i8(s[20 * 33] * q, s[21 * 33] * q, s[22 * 33] * q, s[23 * 33] * q); o1.z = pk4_i8(s[24 * 33] * q, s[25 * 33] * q, s[26 * 33] * q, s[27 * 33] * q); o1.w = pk4_i8(s[28 * 33] * q, s[29 * 33] * q, s[30 * 33] * q, s[31 * 33] * q);
    GAS v4u* dst = (GAS v4u*)(W8 + (size_t)row * K + k0 + 32 * half); dst[0] = o0; dst[1] = o1;
    LDS_WAIT(); asm volatile("" ::: "memory");
}
__device__ __forceinline__ void normmod_row(const float* xrow, const float* gm, const float* sh, bf16* orow, int lane, unsigned* o8row = nullptr, float* qstep = nullptr) {
    const GAS f32x4* xr = (const GAS f32x4*)xrow + lane;
    f32x4 v[16]; float s = 0.f;
#pragma unroll
    for (int j = 0; j < 16; ++j) { v[j] = xr[64 * j]; s += (v[j].x * v[j].x + v[j].y * v[j].y) + (v[j].z * v[j].z + v[j].w * v[j].w); }
    const float rstd = 1.f / sqrtf(wave_sum(s) * (1.f / DM) + NORM_EPS);
    GAS unsigned long long* o8 = (GAS unsigned long long*)orow + lane;
    const GAS f32x4* g4 = (const GAS f32x4*)gm + lane; const GAS f32x4* s4 = (const GAS f32x4*)sh + lane;
    if (qstep) {
        float am = 0.f;
#pragma unroll
        for (int j = 0; j < 16; ++j) { const f32x4 g = g4[64 * j], b = s4[64 * j]; v[j] = v[j] * rstd * g + b; am = fmaxf(am, fmaxf(fmaxf(fabsf(v[j].x), fabsf(v[j].y)), fmaxf(fabsf(v[j].z), fabsf(v[j].w)))); }
        am = fmaxf(wave_max(am), 1e-30f); const float inv = 127.f / am; if (lane == 0) *qstep = am * (1.f / 127.f);
#pragma unroll
        for (int j = 0; j < 16; ++j) { if (orow) o8[64 * j] = (unsigned long long)pk2(v[j].x, v[j].y) | ((unsigned long long)pk2(v[j].z, v[j].w) << 32);
            ((GAS unsigned*)o8row)[lane + 64 * j] = pk4_i8(v[j].x * inv, v[j].y * inv, v[j].z * inv, v[j].w * inv); }
        return; }
#pragma unroll
    for (int j = 0; j < 16; ++j) { const f32x4 g = g4[64 * j], b = s4[64 * j]; const f32x4 y = v[j] * rstd * g + b;
        if (orow) o8[64 * j] = (unsigned long long)pk2(y.x, y.y) | ((unsigned long long)pk2(y.z, y.w) << 32);
        if (o8row) ((GAS unsigned*)o8row)[lane + 64 * j] = pk4_f8(y.x, y.y, y.z, y.w); }
}

__device__ __forceinline__ void normmod_row_b(const bf16* xrow, const float* gm, const float* sh, bf16* orow, unsigned char* qrow, float* qstep, int lane) {
    const GAS v4u* xr = (const GAS v4u*)xrow + lane;
    f32x4 v[16]; float s = 0.f;
#pragma unroll
    for (int j = 0; j < 8; ++j) { const v4u w = xr[64 * j]; v[2 * j] = pg8::bf4_lo(w); v[2 * j + 1] = pg8::bf4_hi(w); }
#pragma unroll
    for (int j = 0; j < 16; ++j) s += (v[j].x * v[j].x + v[j].y * v[j].y) + (v[j].z * v[j].z + v[j].w * v[j].w);
    const float rstd = 1.f / sqrtf(wave_sum(s) * (1.f / DM) + NORM_EPS);
    float am = 0.f;
#pragma unroll
    for (int j = 0; j < 8; ++j) { const GAS f32x4* g4 = (const GAS f32x4*)gm + 2 * (lane + 64 * j); const GAS f32x4* s4 = (const GAS f32x4*)sh + 2 * (lane + 64 * j);
        v[2 * j] = v[2 * j] * rstd * g4[0] + s4[0]; v[2 * j + 1] = v[2 * j + 1] * rstd * g4[1] + s4[1]; }
#pragma unroll
    for (int j = 0; j < 16; ++j) am = fmaxf(am, fmaxf(fmaxf(fabsf(v[j].x), fabsf(v[j].y)), fmaxf(fabsf(v[j].z), fabsf(v[j].w))));
    am = fmaxf(wave_max(am), 1e-30f); const float inv = 127.f / am; if (lane == 0) *qstep = am * (1.f / 127.f);
    GAS v4u* o16 = (GAS v4u*)orow + lane;
#pragma unroll
    for (int j = 0; j < 8; ++j) { v4u o; o.x = pk2(v[2 * j].x, v[2 * j].y); o.y = pk2(v[2 * j].z, v[2 * j].w); o.z = pk2(v[2 * j + 1].x, v[2 * j + 1].y); o.w = pk2(v[2 * j + 1].z, v[2 * j + 1].w); o16[64 * j] = o; }
    GAS unsigned long long* o8 = (GAS unsigned long long*)qrow + lane;
#pragma unroll
    for (int j = 0; j < 8; ++j) o8[64 * j] = (unsigned long long)pk4_i8(v[2 * j].x * inv, v[2 * j].y * inv, v[2 * j].z * inv, v[2 * j].w * inv) | ((unsigned long long)pk4_i8(v[2 * j + 1].x * inv, v[2 * j + 1].y * inv, v[2 * j + 1].z * inv, v[2 * j + 1].w * inv) << 32);
}

__device__ __forceinline__ void quant_row_b(const bf16* xrow, unsigned char* qrow, float* qstep, int lane) {
    const GAS v4u* xr = (const GAS v4u*)xrow + lane;
    f32x4 v[16]; float am = 0.f;
#pragma unroll
    for (int j = 0; j < 8; ++j) { const v4u w = xr[64 * j]; v[2 * j] = pg8::bf4_lo(w); v[2 * j + 1] = pg8::bf4_hi(w); }
#pragma unroll
    for (int j = 0; j < 16; ++j) am = fmaxf(am, fmaxf(fmaxf(fabsf(v[j].x), fabsf(v[j].y)), fmaxf(fabsf(v[j].z), fabsf(v[j].w))));
    am = fmaxf(wave_max(am), 1e-30f); const float inv = 127.f / am; if (lane == 0) *qstep = am * (1.f / 127.f);
    GAS unsigned long long* o8 = (GAS unsigned long long*)qrow + lane;
#pragma unroll
    for (int j = 0; j < 8; ++j) o8[64 * j] = (unsigned long long)pk4_i8(v[2 * j].x * inv, v[2 * j].y * inv, v[2 * j].z * inv, v[2 * j].w * inv) | ((unsigned long long)pk4_i8(v[2 * j + 1].x * inv, v[2 * j + 1].y * inv, v[2 * j + 1].z * inv, v[2 * j + 1].w * inv) << 32);
}

#ifdef SELFCHECK
#ifndef CHK_BREAK
#define CHK_BREAK 0
#endif
#define Z_REL 0.08f
#define Z_ABSX 8.f
namespace chk {
constexpr int CW_CHK = 2;
#define BRK(bit, v) (((CHK_BREAK >> (bit)) & 1) ? (v) * 1.1f + 0.1f : (v))
__device__ __forceinline__ unsigned hsh(unsigned x) { x *= 2654435761u; x ^= x >> 15; x *= 2246822519u; x ^= x >> 13; x *= 3266489917u; x ^= x >> 16; return x; }
__device__ __forceinline__ float bfv(const bf16* p) { return __uint_as_float(((unsigned)*p) << 16); }
__device__ __forceinline__ float f8v(const unsigned char* p) { const unsigned b = *p, e = (b >> 3) & 15u, m = b & 7u; const float mag = e ? exp2f((float)e - 7.f) * (1.f + (float)m * 0.125f) : (float)m * 0.001953125f; return (b & 128u) ? -mag : mag; }
__device__ __forceinline__ float wsum(float v) {
#pragma unroll
    for (int o = 1; o < 64; o <<= 1) v += __shfl_xor(v, o);
    return v; }
__device__ __forceinline__ void fail(gu32* ctl, int bit) { __hip_atomic_fetch_or((unsigned*)(ctl + CW_CHK), 1u << bit, __ATOMIC_RELAXED, __HIP_MEMORY_SCOPE_AGENT); }
__device__ __forceinline__ bool close(float got, float ref, float rel, float abs_) { const float d = fabsf(got - ref); return d <= rel * fabsf(ref) + abs_ && d == d; }
__device__ __forceinline__ float sigm(float x) { return 1.f / (1.f + expf(-x)); }
__device__ __forceinline__ float mod_ref(const float* cvec, const float* w_ada, const float* b_ada, int b, int j, int lane) {
    float s = 0.f; for (int k = lane; k < 4096; k += 64) { const float cv = cvec[b * 4096 + k]; s += (cv / (1.f + expf(-cv))) * w_ada[(size_t)k * 24576 + j]; }
    return wsum(s) + b_ada[j]; }
__device__ __forceinline__ float dot_col(const bf16* arow, const float* W, int K, int N, int n, int lane) {
    float s = 0.f; for (int k = lane; k < K; k += 64) s += bfv(arow + k) * W[(size_t)k * N + n];
    return wsum(s); }
__device__ __forceinline__ void rope_cs(int pos, int i, int dim, float& c, float& s) { const float inv = exp2f(-(float)(2 * i) / (float)dim * 13.287712379549449f); const float ang = (float)pos * inv; sincos_d((double)ang, s, c); }

__device__ __forceinline__ void chk_h(gu32* ctl, const float* x, const float* cvec, const float* w_ada, const float* b_ada, const float* norm1_g, const bf16* HB, const float* VEC, int gw, int NGW, int lane) {
    for (int sidx = gw; sidx < 512; sidx += NGW) { const unsigned h = hsh(sidx + 1000); const int row = h & 16383, col = (h >> 14) & 4095, b = row >> 12;
        float ss = 0.f; for (int k = lane; k < 4096; k += 64) { const float v = x[(size_t)row * 4096 + k]; ss += v * v; }
        const float rstd = 1.f / sqrtf(wsum(ss) / 4096.f + 1e-6f);
        const float sh1 = mod_ref(cvec, w_ada, b_ada, b, col, lane), sc1 = mod_ref(cvec, w_ada, b_ada, b, 4096 + col, lane), g1 = mod_ref(cvec, w_ada, b_ada, b, 8192 + col, lane);
        const float ref = x[(size_t)row * 4096 + col] * rstd * norm1_g[col] * (1.f + sc1) + sh1;
        if (!close(bfv(HB + (size_t)row * 4096 + col), ref, 0.01f, 0.01f)) fail(ctl, 0);
        if (!close(VEC[(2 * 4 + b) * 4096 + col], g1, 1e-3f, 1e-4f)) fail(ctl, 7); } }
__device__ __forceinline__ void chk_z(gu32* ctl, const bf16* HB, const float* w_in, const int* positions, const bf16* ZQ, const bf16* ZKV, const bf16* ZKR, const bf16* QD, const bf16* KD, const bf16* VD, const bf16* GA, const bf16* GB, int gw, int NGW, int lane) {
    for (int sidx = gw; sidx < 4096; sidx += NGW) { const unsigned h = hsh(sidx + 5000); const int row = h & 16383; int n = (int)((h >> 14) % 19008u);
        if ((sidx & 3) == 0) n = 1536 + (int)((h >> 14) & 63);
        const int b = row >> 12, s = row & 4095; const bf16* hrow = HB + (size_t)row * 4096;
        const float z = dot_col(hrow, w_in, 4096, 19008, n, lane); float got, ref = z, at = 0.03f;
        if (n < 1024) got = bfv(ZQ + (size_t)row * 1024 + n);
        else if (n < 1536) got = bfv(ZKV + (size_t)row * 512 + (n - 1024));
        else if (n < 1600) { const int r = n - 1536; got = bfv(ZKR + (size_t)row * 256 + (r >> 5) * 128 + (r & 31)); }
        else if (n < 10816) { const int r = n - 1600, t = r / 3072, rr = r % 3072, g8 = rr >> 7, d = rr & 127; const bf16* buf = t == 0 ? QD : (t == 1 ? KD : VD);
            got = bfv(buf + ((size_t)(b * 24 + g8) * 4096 + s) * 128 + d);
            if (t < 2) { const int i = d & 63; float c, sn; rope_cs(positions[row], i, 128, c, sn); const float zp = dot_col(hrow, w_in, 4096, 19008, d < 64 ? n + 64 : n - 64, lane);
                ref = d < 64 ? z * c - zp * sn : z * c + zp * sn; } }
        else { const int r = n - 10816; got = (float)((const unsigned char*)(r < 4096 ? GA : GB))[(size_t)row * 4096 + (r & 4095)] * (1.f / 255.f); ref = sigm(z); at = 0.008f; }
        if (!close(BRK(1, got), ref, Z_REL, at * Z_ABSX)) fail(ctl, 1);
        if (lane == 0 && n < 10816) { atomicAdd((float*)(ctl + 8), (got - ref) * (got - ref)); atomicAdd((float*)(ctl + 9), ref * ref); } } }
__device__ __forceinline__ void chk_p4(gu32* ctl, const bf16* ZQ, const bf16* ZKV, const bf16* ZKR, const float* qg, const float* kvg, const int* positions, const bf16* QN, const bf16* KVN, const unsigned char* KR8, int gw, int NGW, int lane) {
    for (int sidx = gw; sidx < 1024; sidx += NGW) { const unsigned h = hsh(sidx + 9000); const int row = h & 16383;
        float ss = 0.f; for (int k = lane; k < 1024; k += 64) { const float v = bfv(ZQ + (size_t)row * 1024 + k); ss += v * v; }
        const float rq = 1.f / sqrtf(wsum(ss) / 1024.f + 1e-6f); const int cq = lane * 16 + ((h >> 14) & 15);
        if (!close(bfv(QN + (size_t)row * 1024 + cq), bfv(ZQ + (size_t)row * 1024 + cq) * rq * qg[cq], 0.01f, 0.01f)) fail(ctl, 2);
        ss = 0.f; for (int k = lane; k < 512; k += 64) { const float v = bfv(ZKV + (size_t)row * 512 + k); ss += v * v; }
        const float rk = 1.f / sqrtf(wsum(ss) / 512.f + 1e-6f); const int ck = lane * 8 + ((h >> 18) & 7);
        if (!close(bfv(KVN + (size_t)row * 512 + ck), bfv(ZKV + (size_t)row * 512 + ck) * rk * kvg[ck], 0.01f, 0.01f)) fail(ctl, 2);
        { const int d = lane, i = d & 31; float c, sn; rope_cs(positions[row], i, 64, c, sn);
          const float x1 = bfv(ZKR + (size_t)row * 256 + i), x2 = bfv(ZKR + (size_t)row * 256 + 128 + i); const float ref = d < 32 ? x1 * c - x2 * sn : x2 * c + x1 * sn;
          if (!close(f8v(KR8 + (size_t)row * 64 + d), ref, 0.07f, 0.02f)) fail(ctl, 2); } } }
__device__ __forceinline__ void chk_p5(gu32* ctl, const bf16* QN, const bf16* KVN, const float* w_uq, const float* w_ukv, const int* positions, const unsigned char* Q8, const unsigned char* K8, const unsigned char* V8T, int gw, int NGW, int lane) {
    for (int sidx = gw; sidx < 2048; sidx += NGW) { const unsigned h = hsh(sidx + 13000); const int row = h & 16383, b = row >> 12, s = row & 4095;
        { const int n = (int)((h >> 14) % 3072u), hd = n / 192, c = n % 192; const bf16* arow = QN + (size_t)row * 1024; float ref = dot_col(arow, w_uq, 1024, 3072, n, lane);
          if (c >= 128) { const int r = c - 128, i = r & 31; float cs, sn; rope_cs(positions[row], i, 64, cs, sn); const float zp = dot_col(arow, w_uq, 1024, 3072, r < 32 ? n + 32 : n - 32, lane); ref = r < 32 ? ref * cs - zp * sn : ref * cs + zp * sn; }
          if (!close(f8v(Q8 + ((size_t)(b * 16 + hd) * 4096 + s) * 192 + c), ref, 0.08f, 0.04f)) fail(ctl, 3); }
        { const int n = (int)((h >> 9) & 4095); const float ref = dot_col(KVN + (size_t)row * 512, w_ukv, 512, 4096, n, lane);
          const int hd2 = n >> 8, cc = n & 255; const size_t ro = ((size_t)(b * 16 + hd2) * 4096 + s) * 128;
          if (cc < 128) { if (!close(f8v(K8 + ro + cc), ref, 0.08f, 0.04f)) fail(ctl, 3); } else { const int dd = cc - 128; if (!close(f8v(V8T + (((size_t)(b * 16 + hd2) * 64 + (s >> 6)) * 128 + dd) * 64 + att::vpos(s & 63)), ref, 0.08f, 0.04f)) fail(ctl, 3); } } } }
__device__ __forceinline__ void chk_mla(gu32* ctl, const unsigned char* Q8, const unsigned char* K8, const unsigned char* V8T, const unsigned char* KR8, const bf16* Y, LAS float* scr, int sample, int tid) {
    const unsigned h = hsh(sample + 17000); const int b = h & 3, hd = (h >> 2) & 15, row = (h >> 6) & 4095;
    LAS float* q = scr; LAS float* sc = scr + 256; LAS float* red = scr + 256 + 4096;
    __syncthreads();
    if (tid < 192) q[tid] = f8v(Q8 + ((size_t)(b * 16 + hd) * 4096 + row) * 192 + tid);
    __syncthreads();
    float mx = -1e30f;
    for (int k = tid; k < 4096; k += 512) { const unsigned char* kr = K8 + ((size_t)(b * 16 + hd) * 4096 + k) * 128; const unsigned char* rr = KR8 + ((size_t)b * 4096 + k) * 64; float s = 0.f;
        for (int d = 0; d < 128; ++d) s += q[d] * f8v(kr + d);
        for (int d = 0; d < 64; ++d) s += q[128 + d] * f8v(rr + d);
        s *= 0.07216878364870323f; sc[k] = s; mx = fmaxf(mx, s); }
    red[tid] = mx; __syncthreads();
    for (int o = 256; o > 0; o >>= 1) { if (tid < o) red[tid] = fmaxf(red[tid], red[tid + o]); __syncthreads(); }
    mx = red[0]; __syncthreads();
    float sm = 0.f; for (int k = tid; k < 4096; k += 512) { const float p = expf(sc[k] - mx); sc[k] = p; sm += p; }
    red[tid] = sm; __syncthreads();
    for (int o = 256; o > 0; o >>= 1) { if (tid < o) red[tid] += red[tid + o]; __syncthreads(); }
    sm = red[0]; __syncthreads();
    const int d = tid & 127, part = tid >> 7; float acc = 0.f;
    for (int k = part * 1024; k < part * 1024 + 1024; ++k) acc += sc[k] * f8v(V8T + (((size_t)(b * 16 + hd) * 64 + (k >> 6)) * 128 + d) * 64 + att::vpos(k & 63));
    red[tid] = acc; __syncthreads();
    if (tid < 128) { const float ref = (red[tid] + red[tid + 128] + red[tid + 256] + red[tid + 384]) / sm; red[tid] = ref; }
    __syncthreads();
    float r2 = 0.f; for (int i = 0; i < 128; ++i) r2 += red[i] * red[i]; const float rms = sqrtf(r2 / 128.f);
    if (tid < 128) { const float got = bfv(Y + ((size_t)b * 4096 + row) * 3072 + hd * 128 + tid); if (!close(BRK(4, got), red[tid], 0.06f, 0.06f * rms)) fail(ctl, 4);     }
    __syncthreads();
}
__device__ __forceinline__ void chk_dil(gu32* ctl, const bf16* QD, const bf16* KD, const bf16* VD, const bf16* Y, LAS float* scr, int sample, int tid) {
    const unsigned h = hsh(sample + 23000); const int b = h & 3, hd = (h >> 2) & 7; int s = (h >> 5) & 4095; if ((sample & 7) == 0) s = (sample >> 3) & 63; if ((sample & 7) == 1) s = 4095 - ((sample >> 3) & 63);
    LAS float* sc = scr; LAS float* red = scr + 512;
    __syncthreads();
    float v = -1e30f;
    if (tid < 387) { const int g = tid / 129, j = tid % 129, dd = g == 0 ? 1 : (g == 1 ? 4 : 16), idx = s + (j - 64) * dd;
        if (idx >= 0 && idx < 4096) { const bf16* qp = QD + ((size_t)(b * 24 + g * 8 + hd) * 4096 + s) * 128; const bf16* kp = KD + ((size_t)(b * 24 + g * 8 + hd) * 4096 + idx) * 128; float a = 0.f;
            for (int d = 0; d < 128; ++d) a += bfv(qp + d) * bfv(kp + d);
            v = a * 0.08838834764831845f; } }
    if (tid < 387) sc[tid] = v;
    red[tid] = v; __syncthreads();
    for (int o = 256; o > 0; o >>= 1) { if (tid < o) red[tid] = fmaxf(red[tid], red[tid + o]); __syncthreads(); }
    const float mx = red[0]; __syncthreads();
    float p = 0.f; if (tid < 387 && v > -1e29f) p = expf(v - mx); if (tid < 387) sc[tid] = p;
    red[tid] = p; __syncthreads();
    for (int o = 256; o > 0; o >>= 1) { if (tid < o) red[tid] += red[tid + o]; __syncthreads(); }
    const float sm = red[0]; __syncthreads();
    if (tid < 128) { float acc = 0.f;
        for (int t = 0; t < 387; ++t) { const int g = t / 129, j = t % 129, dd = g == 0 ? 1 : (g == 1 ? 4 : 16), idx = s + (j - 64) * dd; if (idx < 0 || idx >= 4096) continue;
            acc += sc[t] * bfv(VD + ((size_t)(b * 24 + g * 8 + hd) * 4096 + idx) * 128 + tid); }
        red[tid] = acc / sm; }
    __syncthreads();
    float r2 = 0.f; for (int i = 0; i < 128; ++i) r2 += red[i] * red[i]; const float rms = sqrtf(r2 / 128.f);
    if (tid < 128) { const float got = bfv(Y + ((size_t)b * 4096 + s) * 3072 + 2048 + hd * 128 + tid); if (!close(BRK(5, got), red[tid], 0.03f, 0.03f * rms)) fail(ctl, 5); }
    __syncthreads();
}
__device__ __forceinline__ void chk_mix(gu32* ctl, const bf16* Y, const bf16* GA, const bf16* GB, const float* wpa, const float* wpb, const bf16* MIXED, int gw, int NGW, int lane) {
    for (int sidx = gw; sidx < 2048; sidx += NGW) { const unsigned h = hsh(sidx + 29000); const int row = h & 16383, col = (h >> 14) & 4095; const bf16* yr = Y + (size_t)row * 3072;
        const float pa = dot_col(yr, wpa, 2048, 4096, col, lane), pb = dot_col(yr + 2048, wpb, 1024, 4096, col, lane);
        const float ref = (float)((const unsigned char*)GA)[(size_t)row * 4096 + col] * (1.f / 255.f) * pa + fmaxf((float)((const unsigned char*)GB)[(size_t)row * 4096 + col], 1.f) * (1.f / 255.f) * pb;
        if (!close(bfv(MIXED + (size_t)row * 4096 + col), ref, 0.03f, 0.002f)) fail(ctl, 6); } }
__device__ __forceinline__ void chk_x1(gu32* ctl, const float* x, const bf16* MIXED, const float* w_out, const float* VEC, const bf16* X1B, int gw, int NGW, int lane) {
    for (int sidx = gw; sidx < 8192; sidx += NGW) { const unsigned h = hsh(sidx + 31000); const int row = h & 16383, col = (h >> 14) & 4095, b = row >> 12; const float xv = x[(size_t)row * 4096 + col];
        if (fabsf(xv) > 0.12f) continue;
        const float br = VEC[(2 * 4 + b) * 4096 + col] * dot_col(MIXED + (size_t)row * 4096, w_out, 4096, 4096, col, lane);
        if (!close(bfv(X1B + (size_t)row * 4096 + col) - xv, br, 0.15f, 0.003f)) fail(ctl, 8);
        if (lane == 0) { atomicAdd((float*)(ctl + 10), br * br); atomicAdd((float*)(ctl + 11), 1.f); } } }
}
#endif

struct Args { const float* in[19]; float* out; unsigned char* ws; int ph_lo, ph_hi, li, pad; };
__global__ void __launch_bounds__(NWAVES * 64, 2) mk_fwd(Args args) {
    extern __shared__ __attribute__((aligned(16))) unsigned char lds[];
    Frame F;
    F.lds = (LAS unsigned char*)lds;
    F.MISC = (volatile LAS unsigned*)(F.lds + MISC_OFF);
    F.tid = threadIdx.x; F.lane = F.tid & 63; F.wave = __builtin_amdgcn_readfirstlane(F.tid >> 6);
    F.G = gridDim.x; { const int bx = blockIdx.x; F.vcu = (F.G % 8 == 0) ? (bx % 8) * (F.G / 8) + bx / 8 : bx; }
    unsigned char* ws = args.ws;
    F.ctl = (gu32*)(ws + WS_CTL);
    const float* x = args.in[0]; const float* cvec = args.in[1]; const int* positions = (const int*)args.in[2];
    const float* w_ada = args.in[3]; const float* b_ada = args.in[4]; const float* norm1_g = args.in[5]; const float* w_in = args.in[6];
    const float* q_norm_g = args.in[7]; const float* w_uq = args.in[8]; const float* kv_norm_g = args.in[9]; const float* w_ukv = args.in[10];
    const float* w_proj_a = args.in[11]; const float* w_proj_b = args.in[12]; const float* w_out = args.in[13]; const float* norm2_g = args.in[14];
    const float* w_gate = args.in[15]; const float* w_up = args.in[16]; const float* w_down = args.in[17]; const float* final_g = args.in[18];
    float* out = args.out;
    float* MOD = (float*)(ws + WS_MOD); float* VEC = (float*)(ws + WS_VEC); float* MODP = (float*)(ws + WS_MODP);
    float* COSF = (float*)(ws + WS_COSF); float* SINF = (float*)(ws + WS_SINF); float* COSR = (float*)(ws + WS_COSR); float* SINR = (float*)(ws + WS_SINR);
    bf16* KROPE = (bf16*)(ws + WS_KROPE); float* LSE = (float*)(ws + WS_LSE);
    unsigned char* WOUT8 = ws + WS_WOUT; unsigned char* MIXQ = ws + WS_VD; float* CM3 = (float*)(ws + WS_CTL + 384 * 1024); float* SA3 = (float*)(ws + WS_CTL + 768 * 1024);
    unsigned char* WGU8 = ws + WS_WGU; unsigned char* H2Q = ws + WS_X2B;
    float* CM1 = (float*)(ws + WS_CTL + 128 * 1024); float* CM2 = (float*)(ws + WS_CTL + 256 * 1024); float* SA1 = (float*)(ws + WS_CTL + 512 * 1024); float* SA2 = (float*)(ws + WS_CTL + 640 * 1024);
    unsigned char* WIN8 = ws + WS_WIN + (NBF > 0 ? 80 : 0) * MiB;     unsigned char* H8 = ws + WS_H8;
    bf16 *WIN = (bf16*)(ws + WS_WIN), *WUQ = (bf16*)(ws + WS_WUQ), *WUKV = (bf16*)(ws + WS_WUKV), *WPA = (bf16*)(ws + WS_WPA), *WPB = (bf16*)(ws + WS_WPB), *WOUT = (bf16*)(ws + WS_WOUT), *WGU = (bf16*)(ws + WS_WGU), *WDN = (bf16*)(ws + WS_WDN);
    bf16 *HB = (bf16*)(ws + WS_A), *QB = (bf16*)(ws + WS_A), *H2 = (bf16*)(ws + WS_A);
    bf16 *QD = (bf16*)(ws + WS_QD), *KD = (bf16*)(ws + WS_KD), *VD = (bf16*)(ws + WS_VD), *MIXED = (bf16*)(ws + WS_QD), *AFF = (bf16*)(ws + WS_QD);
    bf16 *GA = (bf16*)(ws + WS_GA), *GB = (bf16*)(ws + WS_GB);
    bf16 *ZQ = (bf16*)(ws + WS_ZQ), *ZKV = (bf16*)(ws + WS_ZKV), *ZKR = (bf16*)(ws + WS_ZKR), *QN = (bf16*)(ws + WS_QN), *KVN = (bf16*)(ws + WS_KVN), *PD = (bf16*)(ws + WS_PD);
    unsigned char* Q8 = ws + WS_A; unsigned char* K8 = ws + WS_KV; unsigned char* V8T = ws + WS_KV + 32 * MiB; unsigned char* KR8 = ws + WS_KROPE;
    bf16 *KV = (bf16*)(ws + WS_KV), *YA = (bf16*)(ws + WS_YA), *YB = (bf16*)(ws + WS_YB), *X1B = (bf16*)(ws + WS_X1B), *X2B = (bf16*)(ws + WS_X2B);

    for (int u = F.tid; u < (LDS_BYTES - LDSCTL_OFF) / 4; u += NWAVES * 64) ((LAS unsigned*)(F.lds + LDSCTL_OFF))[u] = 0u;
    __syncthreads();
    XcdBarrier bar; bar.bar = (unsigned*)(F.ctl + CW_BAR); bar.x = 0; bar.st = nullptr;
    if (N_LAUNCHES == 1) bar = xcd_barrier_post((unsigned*)(F.ctl + CW_BAR), F.MISC + 8);
#define GRID_BAR() do { if (N_LAUNCHES == 1) xcd_barrier(bar); } while (0)
    const int lo = args.ph_lo, hi = args.ph_hi;
#ifndef PHASE_MASK
#define PHASE_MASK 0x3fff
#endif
#define IN(k) (((PHASE_MASK >> (k)) & 1) && lo <= (k) && (k) < hi)
#define BOTH(k) (IN(k) && IN((k) + 1))
#ifndef REPEAT_MASK
#define REPEAT_MASK 0
#endif
#define REP(k)
#define RPT(k) ((REPEAT_MASK >> (k)) & 1)
    const int gw = F.vcu * NWAVES + F.wave, NGW = F.G * NWAVES;
    const int NGT = F.G * NWAVES * 64;
#define OPQ_TID() ({ int t_ = (int)threadIdx.x; asm volatile("" : "+v"(t_)); t_; })
#define gt ((int)blockIdx.x * (NWAVES * 64) + OPQ_TID())
#define LANE() (OPQ_TID() & 63)

    if (IN(0)) { REP(0) {
        { LAS float* scv = (LAS float*)(F.lds + RING_OFF);
          for (int it = blockIdx.x; it < KSPLIT * 12; it += F.G) {
              const int kc = it / 12, cb = it % 12;
              __syncthreads();
              if (OPQ_TID() < 256) { const int k = OPQ_TID() >> 2, b = OPQ_TID() & 3; const float cv = cvec[b * DM + kc * 64 + k]; scv[k * 4 + b] = cv / (1.f + expf(-cv)); }
              __syncthreads();
              const int col = cb * 2048 + 4 * OPQ_TID();
              f32x4 a0 = {0.f, 0.f, 0.f, 0.f}, a1 = a0, a2 = a0, a3 = a0;
              const float* wp = w_ada + (size_t)(kc * 64) * N_MOD + col;
#pragma unroll 8
              for (int k = 0; k < 64; ++k) { const f32x4 w = *(const GAS f32x4*)(wp + (size_t)k * N_MOD); const f32x4 s = *(const LAS f32x4*)(scv + k * 4);
                  a0 += s.x * w; a1 += s.y * w; a2 += s.z * w; a3 += s.w * w; }
              float* mp = MODP + (size_t)(kc * 4) * N_MOD + col;
              *(GAS f32x4*)(mp) = a0; *(GAS f32x4*)(mp + N_MOD) = a1; *(GAS f32x4*)(mp + 2 * N_MOD) = a2; *(GAS f32x4*)(mp + 3 * N_MOD) = a3;
          }
          __syncthreads(); }
        for (int e = gt; e < M * 64; e += NGT) { const int row = e >> 6, i = e & 63; const float ang = (float)positions[row] * INVF[i]; float s, c; sincos_d((double)ang, s, c); COSF[e] = c; SINF[e] = s; }
        for (int e = gt; e < M * 32; e += NGT) { const int row = e >> 5, i = e & 31; const float ang = (float)positions[row] * INVF[2 * i]; float s, c; sincos_d((double)ang, s, c); COSR[e] = c; SINR[e] = s; }
        for (int e = gt; e < 192 * (DM / 16); e += NGT) { const int rr = e / (DM / 16), c16 = e % (DM / 16); const int row = (74 - NBF) * 256 + (rr / 96) * 128 + 32 + (rr % 96);
            *(GAS v4u*)(WIN8 + (size_t)row * DM + c16 * 16) = (v4u){0u, 0u, 0u, 0u}; }
        { LAS float* scr = (LAS float*)(F.lds + RING_OFF + F.wave * 16384);
          constexpr int I_IN = (DM / 64) * (IN_TOTAL / 32), I_UQ = (QRANK / 64) * (3072 / 32), I_UKV = (KVRANK / 64) * (4096 / 32), I_PA = (2048 / 64) * (DM / 32), I_PB = (1024 / 64) * (DM / 32),
                        I_OUT = (DM / 64) * (DM / 32), I_G = (DM / 64) * (DFF / 32), I_DN = (DFF / 64) * (DM / 32);
          constexpr int NITEMS = I_IN + I_UQ + I_UKV + I_PA + I_PB + I_OUT + 2 * I_G;
          for (int it = gw; it < NITEMS * (1 + RPT(0)); it += NGW) {
              int r = it % NITEMS;
              if (r < I_IN) { const int n0_ = 32 * (r % (IN_TOTAL / 32));
                  if (n0_ >= 1600 && n0_ < 1600 + NBF * 256) p0_transpose_item(w_in, DM, IN_TOTAL, WIN, 5, scr, r, LANE()); else p0_colmax_item(w_in, IN_TOTAL, CM1, 6, r, LANE());
                  continue; } r -= I_IN;
              if (r < I_UQ) { p0_transpose_item(w_uq, QRANK, 3072, WUQ, 2, scr, r, LANE()); continue; } r -= I_UQ;
              if (r < I_UKV) { p0_transpose_item(w_ukv, KVRANK, 4096, WUKV, 0, scr, r, LANE()); continue; } r -= I_UKV;
              if (r < I_PA) { p0_transpose_item(w_proj_a, 2048, DM, WPA, 0, scr, r, LANE(), 3072); continue; } r -= I_PA;
              if (r < I_PB) { p0_transpose_item(w_proj_b, 1024, DM, WPA + 2048, 0, scr, r, LANE(), 3072); continue; } r -= I_PB;
              if (r < I_OUT) { p0_colmax_item(w_out, DM, CM3, 0, r, LANE()); continue; } r -= I_OUT;
              if (r < I_G) { if (((32 * (r % (DFF / 32))) >> 7) < P11_T8) p0_colmax_item(w_gate, DFF, CM2, 3, r, LANE()); else p0_transpose_item(w_gate, DM, DFF, WGU, 3, scr, r, LANE()); continue; } r -= I_G;
              if (((32 * (r % (DFF / 32))) >> 7) < P11_T8) p0_colmax_item(w_up, DFF, CM2, 4, r, LANE()); else p0_transpose_item(w_up, DM, DFF, WGU, 4, scr, r, LANE());
          } }
        }
        if (BOTH(0)) GRID_BAR();
    }
    if (IN(1)) { REP(1) {
        for (int e = gt; e < BATCH * N_MOD; e += NGT) { const int b = e / N_MOD, j = e - b * N_MOD, ch = j >> 12, col = j & (DM - 1);
            float s = b_ada[j];
#pragma unroll 16
            for (int kc = 0; kc < KSPLIT; ++kc) s += MODP[(size_t)(kc * 4 + b) * N_MOD + j];
            MOD[(size_t)b * N_MOD + j] = s;
            const int slot = ch == 0 ? 1 : (ch == 1 ? 0 : (ch == 2 ? 2 : (ch == 3 ? 4 : (ch == 4 ? 3 : 5))));
            VEC[(slot * 4 + b) * DM + col] = ch == 1 ? norm1_g[col] * (1.f + s) : (ch == 4 ? norm2_g[col] * (1.f + s) : s); }
        { LAS float* scr = (LAS float*)(F.lds + RING_OFF + F.wave * 16384); constexpr int I_IN = (DM / 64) * (IN_TOTAL / 32);
          for (int it = gw; it < I_IN; it += NGW) p0_transpose_item_i8(w_in, DM, IN_TOTAL, WIN8, 6, CM1, scr, it, LANE());
          constexpr int I_OUT = (DM / 64) * (DM / 32);
          for (int it = gw; it < I_OUT; it += NGW) p0_transpose_item_i8(w_out, DM, DM, WOUT8, 0, CM3, scr, it, LANE());
          constexpr int I_G = (DM / 64) * (DFF / 32);
          for (int it = gw; it < 2 * I_G; it += NGW) { const int r = it < I_G ? it : it - I_G; if (((32 * (r % (DFF / 32))) >> 7) >= P11_T8) continue;
              if (it < I_G) p0_transpose_item_i8(w_gate, DM, DFF, WGU8, 3, CM2, scr, r, LANE()); else p0_transpose_item_i8(w_up, DM, DFF, WGU8, 4, CM2, scr, r, LANE()); } }
        }
        if (BOTH(1)) GRID_BAR();
    }
    if (IN(2)) { REP(2) {
        for (int m0 = gw; m0 < M * (1 + RPT(2)); m0 += NGW) { const int m = m0 & (M - 1), b = m >> 12; normmod_row(x + (size_t)m * DM, VEC + (0 * 4 + b) * DM, VEC + (1 * 4 + b) * DM, HB_OR_NULL(HB + (size_t)m * DM), LANE(), (unsigned*)(H8 + (size_t)m * DM), SA1 + m); }
        }
        if (BOTH(2)) GRID_BAR();
    }
    if (IN(3)) { REP(3) {
#ifdef SELFCHECK
        chk::chk_h(F.ctl, x, cvec, w_ada, b_ada, norm1_g, HB, VEC, gw, NGW, LANE());
#endif
        if constexpr (NBF > 0) { pg8::Gemm g{HB, WIN, M, NBF * 256, DM}; pg8::StaticOrder S; S.init(M, NBF * 256, F.G, (int)blockIdx.x);
          pg8::EpiZ E{ZQ, ZKV, QD, KD, VD, GA, GB, ZKR, COSF, SINF, 1};
          pg8::gemm_phase<pg8::EpiZ, pg8::StaticOrder, PG_ALIGN, PG_SP2>(F.lds + RING_OFF, g, S, E);
          if constexpr (RPT(3)) { pg8::gemm_phase<pg8::EpiZ, pg8::StaticOrder, PG_ALIGN, PG_SP2>(F.lds + RING_OFF, g, S, E); } }
        { pg8::Gemm g{(const pg8::bf16_t*)H8, (const pg8::bf16_t*)WIN8, M, (75 - NBF) * 256, DM, SA1, CM1}; pg8::StaticOrder S; S.init(M, (75 - NBF) * 256, F.G, (int)blockIdx.x);
          pg8::EpiZ E{ZQ, ZKV, QD, KD, VD, GA, GB, ZKR, COSF, SINF, 2};
          pg8::gemm_phase<pg8::EpiZ, pg8::StaticOrder, PG_ALIGN, PG_SP2, true, 121, true>(F.lds + RING_OFF, g, S, E);
          if constexpr (RPT(3)) { pg8::gemm_phase<pg8::EpiZ, pg8::StaticOrder, PG_ALIGN, PG_SP2, true, 121, true>(F.lds + RING_OFF, g, S, E); } }
        }
        if (BOTH(3)) GRID_BAR();
    }
    if (IN(4)) { REP(4) {
#ifdef SELFCHECK
        chk::chk_z(F.ctl, HB, w_in, positions, ZQ, ZKV, ZKR, QD, KD, VD, GA, GB, gw, NGW, LANE());
#endif
        for (int m = gw; m < M; m += NGW) {
            { const GAS v4u* zp = (const GAS v4u*)(ZQ + (size_t)m * QRANK); v4u a = zp[LANE()], b2 = zp[64 + LANE()];
              float f[16]; f[0] = pg8::bf_lo(a.x); f[1] = pg8::bf_hi(a.x); f[2] = pg8::bf_lo(a.y); f[3] = pg8::bf_hi(a.y); f[4] = pg8::bf_lo(a.z); f[5] = pg8::bf_hi(a.z); f[6] = pg8::bf_lo(a.w); f[7] = pg8::bf_hi(a.w);
              f[8] = pg8::bf_lo(b2.x); f[9] = pg8::bf_hi(b2.x); f[10] = pg8::bf_lo(b2.y); f[11] = pg8::bf_hi(b2.y); f[12] = pg8::bf_lo(b2.z); f[13] = pg8::bf_hi(b2.z); f[14] = pg8::bf_lo(b2.w); f[15] = pg8::bf_hi(b2.w);
              float s = 0.f;
#pragma unroll
              for (int i = 0; i < 16; ++i) s += f[i] * f[i];
              const float rstd = 1.f / sqrtf(wave_sum(s) * (1.f / QRANK) + NORM_EPS);
              const float* g0 = q_norm_g + 8 * LANE(); const float* g1 = q_norm_g + 512 + 8 * LANE();
              v4u o0, o1;
              o0.x = pk2(f[0] * rstd * g0[0], f[1] * rstd * g0[1]); o0.y = pk2(f[2] * rstd * g0[2], f[3] * rstd * g0[3]); o0.z = pk2(f[4] * rstd * g0[4], f[5] * rstd * g0[5]); o0.w = pk2(f[6] * rstd * g0[6], f[7] * rstd * g0[7]);
              o1.x = pk2(f[8] * rstd * g1[0], f[9] * rstd * g1[1]); o1.y = pk2(f[10] * rstd * g1[2], f[11] * rstd * g1[3]); o1.z = pk2(f[12] * rstd * g1[4], f[13] * rstd * g1[5]); o1.w = pk2(f[14] * rstd * g1[6], f[15] * rstd * g1[7]);
              GAS v4u* op = (GAS v4u*)(QN + (size_t)m * QRANK); op[LANE()] = o0; op[64 + LANE()] = o1; }
            { const GAS v4u* zp = (const GAS v4u*)(ZKV + (size_t)m * KVRANK); v4u a = zp[LANE()];
              float f[8]; f[0] = pg8::bf_lo(a.x); f[1] = pg8::bf_hi(a.x); f[2] = pg8::bf_lo(a.y); f[3] = pg8::bf_hi(a.y); f[4] = pg8::bf_lo(a.z); f[5] = pg8::bf_hi(a.z); f[6] = pg8::bf_lo(a.w); f[7] = pg8::bf_hi(a.w);
              float s = 0.f;
#pragma unroll
              for (int i = 0; i < 8; ++i) s += f[i] * f[i];
              const float rstd = 1.f / sqrtf(wave_sum(s) * (1.f / KVRANK) + NORM_EPS);
              const float* g0 = kv_norm_g + 8 * LANE(); v4u o0;
              o0.x = pk2(f[0] * rstd * g0[0], f[1] * rstd * g0[1]); o0.y = pk2(f[2] * rstd * g0[2], f[3] * rstd * g0[3]); o0.z = pk2(f[4] * rstd * g0[4], f[5] * rstd * g0[5]); o0.w = pk2(f[6] * rstd * g0[6], f[7] * rstd * g0[7]);
              ((GAS v4u*)(KVN + (size_t)m * KVRANK))[LANE()] = o0; }
            if (LANE() < 32) { const int i = LANE(); const float x1 = pg8::bf_lo((unsigned)ZKR[(size_t)m * 256 + i]), x2 = pg8::bf_lo((unsigned)ZKR[(size_t)m * 256 + 128 + i]);
              const float c = COSR[(size_t)m * 32 + i], s = SINR[(size_t)m * 32 + i];
              const unsigned w8 = (unsigned)__builtin_amdgcn_cvt_pk_fp8_f32(x1 * c - x2 * s, x2 * c + x1 * s, 0, false);
              KR8[(size_t)m * 64 + i] = (unsigned char)(w8 & 0xffu); KR8[(size_t)m * 64 + 32 + i] = (unsigned char)((w8 >> 8) & 0xffu); }
        }
        }
        if (BOTH(4)) GRID_BAR();
    }
    if (IN(5)) { REP(5) {
#ifdef SELFCHECK
        chk::chk_p4(F.ctl, ZQ, ZKV, ZKR, q_norm_g, kv_norm_g, positions, QN, KVN, KR8, gw, NGW, LANE());
#endif
        { pg8::Gemm g{QN, WUQ, M, 3072, QRANK}; pg8::StaticOrder S; S.init(M, 3072, F.G, (int)blockIdx.x);
          pg8::EpiQ E{Q8, COSR, SINR};
          pg8::gemm_phase<pg8::EpiQ, pg8::StaticOrder, PG_ALIGN, PG_SP2>(F.lds + RING_OFF, g, S, E); if constexpr (RPT(5)) { pg8::gemm_phase<pg8::EpiQ, pg8::StaticOrder, PG_ALIGN, PG_SP2>(F.lds + RING_OFF, g, S, E); } }
        { pg8::Gemm g{KVN, WUKV, M, 4096, KVRANK}; pg8::StaticOrder S; S.init(M, 4096, F.G, (int)blockIdx.x);
          pg8::EpiKV E{K8, V8T};
          pg8::gemm_phase<pg8::EpiKV, pg8::StaticOrder, PG_ALIGN, PG_SP2>(F.lds + RING_OFF, g, S, E); if constexpr (RPT(5)) { pg8::gemm_phase<pg8::EpiKV, pg8::StaticOrder, PG_ALIGN, PG_SP2>(F.lds + RING_OFF, g, S, E); } }
        }
        if (BOTH(5)) GRID_BAR();
    }
    if (IN(6)) { REP(6) {
#ifdef SELFCHECK
        chk::chk_p5(F.ctl, QN, KVN, w_uq, w_ukv, positions, Q8, K8, V8T, gw, NGW, LANE());
#endif
        char* albs = (char*)lds + RING_OFF;
#ifndef NO_MLA
        for (int i0 = 0; i0 < 4 * (1 + (RPT(6) | RPT(15))); ++i0) { const int i = i0 & 3; const int v = F.vcu; const int xcd = v >> 5, vl = v & 31; const int bh = xcd * 8 + i * 2 + (vl >> 4), qb = vl & 15;
            if (F.G != 256) break;
            const int b = bh >> 4, h = bh & 15; const long r0 = (long)b * SEQ;
            att::mla_unit(Q8 + ((long)bh * SEQ + qb * 256) * 192, K8 + (long)bh * SEQ * 128, V8T + (long)bh * SEQ * 128, KR8 + r0 * 64, YA + (r0 + qb * 256) * 3072 + h * 128, albs); }
#endif
#ifndef NO_DIL
        for (int i = 0; i < 6 * (1 + (RPT(6) | RPT(14))); ++i) { const int U = (int)blockIdx.x + F.G * (i % 6); if (U >= 1536) continue;
            const int bgh = U >> 4, sub = U & 15, b = bgh / 24, g = (bgh % 24) >> 3, h = bgh & 7;
            const int rho = (g == 0) ? 0 : (g == 1 ? (sub >> 2) : sub), blk = (g == 0) ? sub : (g == 1 ? (sub & 3) : 0);
            att::dil_unit(b, g, h, rho, blk, QD, KD, VD, PD, LSE, albs); }
#endif
        }
        if (BOTH(6)) GRID_BAR();
    }
    if (IN(7)) { REP(7) {
        for (int e = gt; e < M * 128; e += NGT) { const int tok = e >> 7, c8 = e & 127, h = c8 >> 4;
            const float l0 = LSE[((size_t)0 * M + tok) * 8 + h], l1 = LSE[((size_t)1 * M + tok) * 8 + h], l2 = LSE[((size_t)2 * M + tok) * 8 + h];
            const float mx = fmaxf(l0, fmaxf(l1, l2)); float w0 = __builtin_amdgcn_exp2f(l0 - mx), w1 = __builtin_amdgcn_exp2f(l1 - mx), w2 = __builtin_amdgcn_exp2f(l2 - mx);
            const float inv = 1.f / (w0 + w1 + w2); w0 *= inv; w1 *= inv; w2 *= inv;
            const v4u p0 = *(const GAS v4u*)(PD + ((size_t)0 * M + tok) * 1024 + c8 * 8), p1 = *(const GAS v4u*)(PD + ((size_t)1 * M + tok) * 1024 + c8 * 8), p2 = *(const GAS v4u*)(PD + ((size_t)2 * M + tok) * 1024 + c8 * 8);
            v4u o;
            o.x = pk2(w0 * pg8::bf_lo(p0.x) + w1 * pg8::bf_lo(p1.x) + w2 * pg8::bf_lo(p2.x), w0 * pg8::bf_hi(p0.x) + w1 * pg8::bf_hi(p1.x) + w2 * pg8::bf_hi(p2.x));
            o.y = pk2(w0 * pg8::bf_lo(p0.y) + w1 * pg8::bf_lo(p1.y) + w2 * pg8::bf_lo(p2.y), w0 * pg8::bf_hi(p0.y) + w1 * pg8::bf_hi(p1.y) + w2 * pg8::bf_hi(p2.y));
            o.z = pk2(w0 * pg8::bf_lo(p0.z) + w1 * pg8::bf_lo(p1.z) + w2 * pg8::bf_lo(p2.z), w0 * pg8::bf_hi(p0.z) + w1 * pg8::bf_hi(p1.z) + w2 * pg8::bf_hi(p2.z));
            o.w = pk2(w0 * pg8::bf_lo(p0.w) + w1 * pg8::bf_lo(p1.w) + w2 * pg8::bf_lo(p2.w), w0 * pg8::bf_hi(p0.w) + w1 * pg8::bf_hi(p1.w) + w2 * pg8::bf_hi(p2.w));
            *(GAS v4u*)(YA + (size_t)tok * 3072 + 2048 + c8 * 8) = o; }
        }
        if (BOTH(7)) GRID_BAR();
    }
    if (IN(8)) { REP(8) {
#ifdef SELFCHECK
        chk::chk_mla(F.ctl, Q8, K8, V8T, KR8, YA, (LAS float*)(F.lds + RING_OFF), (int)blockIdx.x, OPQ_TID()); chk::chk_dil(F.ctl, QD, KD, VD, YA, (LAS float*)(F.lds + RING_OFF), (int)blockIdx.x, OPQ_TID());
        chk::chk_mla(F.ctl, Q8, K8, V8T, KR8, YA, (LAS float*)(F.lds + RING_OFF), 256 + (int)blockIdx.x, OPQ_TID()); chk::chk_dil(F.ctl, QD, KD, VD, YA, (LAS float*)(F.lds + RING_OFF), 256 + (int)blockIdx.x, OPQ_TID());
        GRID_BAR();
#endif
        pg8::Gemm g{YA, WPA, M, DM, 3072}; pg8::StaticOrder S; S.init(M, DM, F.G, (int)blockIdx.x);
        pg8::EpiMix E{(const unsigned char*)GA, (const unsigned char*)GB, MIXED};
        pg8::gemm_phase<pg8::EpiMix, pg8::StaticOrder, PG_ALIGN, PG_SP2>(F.lds + RING_OFF, g, S, E);
        if constexpr (RPT(8)) { pg8::gemm_phase<pg8::EpiMix, pg8::StaticOrder, PG_ALIGN, PG_SP2>(F.lds + RING_OFF, g, S, E); }
        }
        if (BOTH(8)) GRID_BAR();
    }
    if (IN(9)) { REP(9) {
#ifdef SELFCHECK
        chk::chk_mix(F.ctl, YA, GA, GB, w_proj_a, w_proj_b, MIXED, gw, NGW, LANE());
#endif
        for (int m = gw; m < M; m += NGW) quant_row_b(MIXED + (size_t)m * DM, MIXQ + (size_t)m * DM, SA3 + m, LANE());
        GRID_BAR();
        pg8::Gemm g{(const pg8::bf16_t*)MIXQ, (const pg8::bf16_t*)WOUT8, M, DM, DM, SA3, CM3}; pg8::StaticOrder S; S.init(M, DM, F.G, (int)blockIdx.x);
        pg8::EpiRes<true> E{x, X1B, VEC + 2 * 4 * DM};
        pg8::gemm_phase<pg8::EpiRes<true>, pg8::StaticOrder, PG_ALIGN, PG_SP2, true, 127, true>(F.lds + RING_OFF, g, S, E);
        if constexpr (RPT(9)) { pg8::gemm_phase<pg8::EpiRes<true>, pg8::StaticOrder, PG_ALIGN, PG_SP2, true, 127, true>(F.lds + RING_OFF, g, S, E); }
        }
        if (BOTH(9)) GRID_BAR();
    }
    if (IN(10)) { REP(10) {
#ifdef SELFCHECK
        chk::chk_x1(F.ctl, x, MIXED, w_out, VEC, X1B, gw, NGW, LANE());
#endif
        for (int m0 = gw; m0 < M * (1 + RPT(10)); m0 += NGW) { const int m = m0 & (M - 1), b = m >> 12; normmod_row_b(X1B + (size_t)m * DM, VEC + (3 * 4 + b) * DM, VEC + (4 * 4 + b) * DM, H2 + (size_t)m * DM, H2Q + (size_t)m * DM, SA2 + m, LANE()); }
        }
        if (BOTH(10)) GRID_BAR();
    }
    if (IN(11)) { REP(11) {
        { pg8::Gemm g{(const pg8::bf16_t*)H2Q, (const pg8::bf16_t*)WGU8, M, P11_T8 * 256, DM, SA2, CM2}; pg8::StaticOrder S; S.init(M, P11_T8 * 256, F.G, (int)blockIdx.x);
          pg8::EpiGU E{AFF};
          pg8::gemm_phase<pg8::EpiGU, pg8::StaticOrder, PG_ALIGN, PG_SP2, true, 127, true>(F.lds + RING_OFF, g, S, E);
          if constexpr (RPT(11)) { pg8::gemm_phase<pg8::EpiGU, pg8::StaticOrder, PG_ALIGN, PG_SP2, true, 127, true>(F.lds + RING_OFF, g, S, E); } }
        { pg8::Gemm g{H2, WGU + (size_t)P11_T8 * 256 * DM, M, 2 * DFF - P11_T8 * 256, DM}; pg8::StaticOrder S; S.init(M, 2 * DFF - P11_T8 * 256, F.G, (int)blockIdx.x);
          pg8::EpiGU E{AFF + P11_T8 * pg8::HALF};
          pg8::gemm_phase<pg8::EpiGU, pg8::StaticOrder, PG_ALIGN, PG_SP2>(F.lds + RING_OFF, g, S, E);
          if constexpr (RPT(11)) { pg8::gemm_phase<pg8::EpiGU, pg8::StaticOrder, PG_ALIGN, PG_SP2>(F.lds + RING_OFF, g, S, E); } }
        { constexpr int NU = (M / 256) * ((2 * DFF - P11_T8 * 256) / 256), I_DN = (DFF / 64) * (DM / 32); const int nfull = NU / F.G, rem = NU - nfull * F.G;
          const int nidle = rem ? F.G - rem : F.G, me = rem ? (int)blockIdx.x - rem : (int)blockIdx.x;
          if (me >= 0) { LAS float* scr = (LAS float*)(F.lds + RING_OFF + F.wave * 16384);
              for (int it = me * NWAVES + F.wave; it < I_DN; it += nidle * NWAVES) p0_transpose_item(w_down, DFF, DM, WDN, 0, scr, it, LANE()); } }
        }
        if (BOTH(11)) GRID_BAR();
    }
    if (IN(12)) { REP(12) {
        pg8::Gemm g{AFF, WDN, M, DM, DFF}; pg8::StaticOrder S; S.init(M, DM, F.G, (int)blockIdx.x);
        pg8::EpiRes<false> E{X1B, X2B, VEC + 5 * 4 * DM};
        pg8::gemm_phase<pg8::EpiRes<false>, pg8::StaticOrder, PG_ALIGN, PG_SP2>(F.lds + RING_OFF, g, S, E);
        if constexpr (RPT(12)) { pg8::gemm_phase<pg8::EpiRes<false>, pg8::StaticOrder, PG_ALIGN, PG_SP2>(F.lds + RING_OFF, g, S, E); }
        }
        if (BOTH(12)) GRID_BAR();
    }
    if (IN(13)) {
        bool bad = (N_LAUNCHES == 1) && (__hip_atomic_load((gu32*)((unsigned*)(F.ctl + CW_BAR) + XB_TMO), RLX_AGENT) != 0u);
        bad = bad || (F.G != 256);
#ifdef SELFCHECK
        { const unsigned cw = __hip_atomic_load(F.ctl + chk::CW_CHK, RLX_AGENT); bad = bad || ((cw & (unsigned)(CHK_MASK)) != 0u);
#ifdef STAT_ZT
          { const float e2 = __uint_as_float(__hip_atomic_load(F.ctl + 8, RLX_AGENT)), r2 = __uint_as_float(__hip_atomic_load(F.ctl + 9, RLX_AGENT)); bad = bad || !(e2 <= (STAT_ZT) * (STAT_ZT) * r2); }
#endif
#ifdef STAT_BR
          { const float b2 = __uint_as_float(__hip_atomic_load(F.ctl + 10, RLX_AGENT)), n_ = __uint_as_float(__hip_atomic_load(F.ctl + 11, RLX_AGENT)); bad = bad || !(b2 <= (STAT_BR) * (STAT_BR) * n_); }
#endif
        }
#endif
        for (int m = gw; m < M; m += NGW) {
            const int ln = LANE(); const GAS v4u* xr = (const GAS v4u*)(X2B + (size_t)m * DM) + ln; f32x4 v[16]; float s = 0.f;
#pragma unroll
            for (int j = 0; j < 8; ++j) { const v4u w = xr[64 * j]; v[2 * j] = pg8::bf4_lo(w); v[2 * j + 1] = pg8::bf4_hi(w); }
#pragma unroll
            for (int j = 0; j < 16; ++j) s += (v[j].x * v[j].x + v[j].y * v[j].y) + (v[j].z * v[j].z + v[j].w * v[j].w);
            float rstd = 1.f / sqrtf(wave_sum(s) * (1.f / DM) + NORM_EPS); if (bad) rstd = __builtin_nanf("");
            GAS f32x4* orow = (GAS f32x4*)(out + (size_t)m * DM);
#pragma unroll
            for (int j = 0; j < 8; ++j) { const int c4 = 2 * (ln + 64 * j); const GAS f32x4* g4 = (const GAS f32x4*)final_g + c4;
                orow[c4] = v[2 * j] * rstd * g4[0]; orow[c4 + 1] = v[2 * j + 1] * rstd * g4[1]; }
        }
    }
#undef IN
#undef BOTH
#undef GRID_BAR
#undef gt
#undef LANE
#undef OPQ_TID
}

extern "C" void kernel_launch(void* const* d_in, const int* in_sizes, int n_in, void* d_out, int out_size, void* d_ws, size_t ws_size, hipStream_t stream) {
    static int grid = 0;
    if (grid == 0) {
        if (n_in != 19 || in_sizes[0] != M * DM || out_size != M * DM || ws_size < WS_END) { fprintf(stderr, "kernel_launch: shape mismatch: n_in %d in0 %d out %d ws %zu (need %zu); nothing launched\n", n_in, n_in > 0 ? in_sizes[0] : -1, out_size, ws_size, (size_t)WS_END); grid = -1; return; }
        int dev = 0, cus = 0, per_cu = 0;
        if (hipGetDevice(&dev) != hipSuccess || hipDeviceGetAttribute(&cus, hipDeviceAttributeMultiprocessorCount, dev) != hipSuccess) { fprintf(stderr, "kernel_launch: device query failed\n"); grid = -1; return; }
        if (hipFuncSetAttribute((const void*)mk_fwd, hipFuncAttributeMaxDynamicSharedMemorySize, LDS_BYTES) != hipSuccess) { fprintf(stderr, "kernel_launch: hipFuncSetAttribute failed\n"); grid = -1; return; }
        if (hipOccupancyMaxActiveBlocksPerMultiprocessor(&per_cu, (const void*)mk_fwd, NWAVES * 64, LDS_BYTES) != hipSuccess || per_cu < 1) fprintf(stderr, "kernel_launch: note: occupancy query reports %d workgroups per CU\n", per_cu);
        (void)hipGetLastError();
        grid = cus;
        if (grid != 256) fprintf(stderr, "kernel_launch: %d CUs; this kernel is laid out for 256\n", grid);
    }
    if (grid < 0) return;
    if (hipMemsetAsync((char*)d_ws + WS_CTL, 0, CTL_ZERO_BYTES, stream) != hipSuccess) { fprintf(stderr, "kernel_launch: hipMemsetAsync failed\n"); return; }
    Args a{};
    for (int i = 0; i < 19; ++i) a.in[i] = (const float*)d_in[i];
    a.out = (float*)d_out; a.ws = (unsigned char*)d_ws;
    for (int li = 0; li < N_LAUNCHES; ++li) {
        a.ph_lo = (N_LAUNCHES == PER_PHASE) ? li : 0; a.ph_hi = (N_LAUNCHES == PER_PHASE) ? li + 1 : PER_PHASE; a.li = li;
        hipLaunchKernelGGL(mk_fwd, dim3(grid), dim3(NWAVES * 64), LDS_BYTES, stream, a);
        const hipError_t le = hipPeekAtLastError();
        if (le != hipSuccess) { fprintf(stderr, "kernel_launch: launch %d failed: %s\n", li, hipGetErrorName(le)); break; }
    }
}
```

```cpp
#include <hip/hip_runtime.h>
#include <cstdio>
#include <cstdint>
namespace pg8 {
#define PG8_LAS __attribute__((address_space(3)))
typedef unsigned short bf16_t;
typedef short bf16x8 __attribute__((ext_vector_type(8)));
typedef float f32x4 __attribute__((ext_vector_type(4)));
typedef unsigned u32x4 __attribute__((ext_vector_type(4)));
typedef int i32x4_t __attribute__((ext_vector_type(4)));
typedef int i32x8_t __attribute__((ext_vector_type(8)));
constexpr int BM = 256, BK = 64, HALF = 128, HTB = HALF * BK * 2  , STAGE_BYTES = 8 * HTB, NXCD = 8, WGM = 8;

__host__ __device__ __forceinline__ int lds_byte(int r, int c) { const int st = (r >> 4) * 2 + (c >> 5), rr = r & 15, cc = c & 31, ob = rr * 64 + cc * 2; return st * 1024 + (ob ^ (((ob >> 9) & 1) << 5)); }
__host__ __device__ __forceinline__ void stage_rc(int b, int& R, int& C) { const int st = b / 1024, sb = b % 1024, swz = sb ^ (((sb >> 9) & 1) << 5); R = (st >> 1) * 16 + swz / 64; C = (st & 1) * 32 + (swz % 64) / 2; }
__host__ __device__ __forceinline__ int perm32(int rho) { const int n = rho >> 4, i = rho & 15; return 8 * (i >> 2) + 4 * n + (i & 3); }

struct Unit { int pm, pn; };
struct Gemm { const bf16_t* A; const bf16_t* Bt; int M, N, K; const float* sa = nullptr; const float* sw = nullptr; };

struct StaticOrder {
    int nM, nN, nwg, G, c;
    __host__ __device__ void init(int M, int N, int G_, int c_) { nM = M / BM; nN = N / BM; nwg = nM * nN; G = G_; c = c_; }
    __host__ __device__ bool next(int i, Unit& u) const {
        const long L = (long)i * G + c; if (L >= nwg) return false;
        int wgid = (int)L; { const int q = nwg / NXCD, r = nwg % NXCD, xcd = wgid % NXCD, off = wgid / NXCD; wgid = (xcd < r ? xcd * (q + 1) : r * (q + 1) + (xcd - r) * q) + off; }
        const int nig = WGM * nN, gid = wgid / nig, fm = gid * WGM, gsz = (nM - fm) < WGM ? (nM - fm) : WGM;
        u.pm = fm + ((wgid % nig) % gsz); u.pn = (wgid % nig) / gsz; return true;
    }
    __device__ __forceinline__ void a_ready(const Unit&) const {}
    __device__ __forceinline__ void done(const Unit&) const {}
};

__device__ __forceinline__ unsigned cvt_pk_bf16(float lo, float hi) { unsigned r; asm volatile("v_cvt_pk_bf16_f32 %0, %1, %2" : "=v"(r) : "v"(lo), "v"(hi)); return r; }
__device__ __forceinline__ float bf_lo(unsigned w) { return __uint_as_float(w << 16); }
__device__ __forceinline__ float bf_hi(unsigned w) { return __uint_as_float(w & 0xffff0000u); }
__device__ __forceinline__ float sigmoid_f(float x) { return __builtin_amdgcn_rcpf(1.0f + __builtin_amdgcn_exp2f(-1.4426950408889634f * x)); }
__device__ __forceinline__ f32x4 sigmoid4(f32x4 v) { return (f32x4){sigmoid_f(v[0]), sigmoid_f(v[1]), sigmoid_f(v[2]), sigmoid_f(v[3])}; }
__device__ __forceinline__ void st8(bf16_t* p, f32x4 v0, f32x4 v1) { u32x4 w; w.x = cvt_pk_bf16(v0[0], v0[1]); w.y = cvt_pk_bf16(v0[2], v0[3]); w.z = cvt_pk_bf16(v1[0], v1[1]); w.w = cvt_pk_bf16(v1[2], v1[3]); *(u32x4*)p = w; }
__device__ __forceinline__ void st8f(unsigned char* p, f32x4 v0, f32x4 v1) { int w0 = __builtin_amdgcn_cvt_pk_fp8_f32(v0[0], v0[1], 0, false); w0 = __builtin_amdgcn_cvt_pk_fp8_f32(v0[2], v0[3], w0, true); int w1 = __builtin_amdgcn_cvt_pk_fp8_f32(v1[0], v1[1], 0, false); w1 = __builtin_amdgcn_cvt_pk_fp8_f32(v1[2], v1[3], w1, true);
    *(unsigned long long*)p = (unsigned long long)(unsigned)w0 | ((unsigned long long)(unsigned)w1 << 32); }
__device__ __forceinline__ unsigned pk4_u8(f32x4 v) { unsigned w = __builtin_amdgcn_cvt_pk_u8_f32(v[0] * 255.f, 0, 0u); w = __builtin_amdgcn_cvt_pk_u8_f32(v[1] * 255.f, 1, w); w = __builtin_amdgcn_cvt_pk_u8_f32(v[2] * 255.f, 2, w); return __builtin_amdgcn_cvt_pk_u8_f32(v[3] * 255.f, 3, w); }
__device__ __forceinline__ f32x4 u8x4_f(unsigned w) { return (f32x4){(float)(w & 0xffu), (float)((w >> 8) & 0xffu), (float)((w >> 16) & 0xffu), (float)(w >> 24)}; }
__device__ __forceinline__ f32x4 bf4_lo(u32x4 g) { return (f32x4){bf_lo(g.x), bf_hi(g.x), bf_lo(g.y), bf_hi(g.y)}; }
__device__ __forceinline__ f32x4 bf4_hi(u32x4 g) { return (f32x4){bf_lo(g.z), bf_hi(g.z), bf_lo(g.w), bf_hi(g.w)}; }

constexpr int P3_NBF = 0;
struct EpiZ {
    static constexpr bool PERM = true, AFTER_DRAIN = false; static constexpr int MID_T = -1;
    bf16_t *ZQ, *ZKV, *QD, *KD, *VD, *GA, *GB, *ZKR; const float *cosF, *sinF; int remap;
    __device__ __forceinline__ void operator()(const f32x4 (&acc)[2][2][4][2], const Unit& u, int wr, int wc, int fr, int fq) const {
        const int pn = remap == 0 ? u.pn : (remap == 1 ? 6 + u.pn : (u.pn < 6 ? u.pn : P3_NBF + u.pn)), row0 = u.pm * BM + wr * 64 + fr, j0 = wc * 32 + 8 * fq;
        if (pn >= 6 && pn < 30) {
            const int t = (pn - 6) / 12, tt = (pn - 6) % 12, i0 = (wc & 1) * 32 + 8 * fq;
            bf16_t* base = (t ? KD : QD) + ((size_t)((u.pm >> 4) * 24 + 2 * tt + (wc >> 1)) * 4096) * 128 + i0;
#pragma unroll
            for (int ai = 0; ai < 2; ++ai) { f32x4 cs[4][4];
#pragma unroll
                for (int m = 0; m < 4; ++m) { const int row = row0 + ai * HALF + m * 16; const float* cp = cosF + (size_t)row * 64 + i0; const float* sp = sinF + (size_t)row * 64 + i0;
                    cs[m][0] = *(const f32x4*)cp; cs[m][1] = *(const f32x4*)(cp + 4); cs[m][2] = *(const f32x4*)sp; cs[m][3] = *(const f32x4*)(sp + 4); }
#pragma unroll
                for (int m = 0; m < 4; ++m) { const int row = row0 + ai * HALF + m * 16; const f32x4 c0 = cs[m][0], c1 = cs[m][1], s0 = cs[m][2], s1 = cs[m][3];
                    const f32x4 x10 = acc[ai][0][m][0], x11 = acc[ai][0][m][1], x20 = acc[ai][1][m][0], x21 = acc[ai][1][m][1];
                    bf16_t* rp = base + (size_t)(row & 4095) * 128;
                    st8(rp, x10 * c0 - x20 * s0, x11 * c1 - x21 * s1); st8(rp + 64, x20 * c0 + x10 * s0, x21 * c1 + x11 * s1); } }
        } else if (pn >= 30 && pn < 42) {
            bf16_t* base = VD + ((size_t)((u.pm >> 4) * 24 + 2 * (pn - 30)) * 4096) * 128 + j0;
#pragma unroll
            for (int ai = 0; ai < 2; ++ai)
#pragma unroll
                for (int m = 0; m < 4; ++m) { bf16_t* rp = base + (size_t)((row0 + ai * HALF + m * 16) & 4095) * 128;
#pragma unroll
                    for (int bj = 0; bj < 2; ++bj) st8(rp + (size_t)bj * 4096 * 128, acc[ai][bj][m][0], acc[ai][bj][m][1]); }
        } else {
            bf16_t* base; int ld; bool sig = false;
            if (pn < 4) { base = ZQ + pn * 256; ld = 1024; }
            else if (pn < 6) { base = ZKV + (pn - 4) * 256; ld = 512; }
            else if (pn < 74) { const int gi = pn - 42; base = (gi < 16 ? GA : GB) + ((gi & 15) * 256) / 2; ld = 4096 / 2; sig = true; }
            else { base = ZKR; ld = 256; }
            base += sig ? j0 / 2 : j0;
#pragma unroll
            for (int ai = 0; ai < 2; ++ai)
#pragma unroll
                for (int m = 0; m < 4; ++m) { bf16_t* rp = base + (size_t)(row0 + ai * HALF + m * 16) * ld;
#pragma unroll
                    for (int bj = 0; bj < 2; ++bj) { f32x4 v0 = acc[ai][bj][m][0], v1 = acc[ai][bj][m][1];
                        if (sig) { *(unsigned long long*)(rp + (bj * HALF) / 2) = (unsigned long long)pk4_u8(sigmoid4(v0)) | ((unsigned long long)pk4_u8(sigmoid4(v1)) << 32); }
                        else st8(rp + bj * HALF, v0, v1); } }
        }
    }
};
struct EpiQ {
    static constexpr bool PERM = true, AFTER_DRAIN = false; static constexpr int MID_T = -1;
    unsigned char* Q; const float *cosR, *sinR;
    __device__ __forceinline__ void operator()(const f32x4 (&acc)[2][2][4][2], const Unit& u, int wr, int wc, int fr, int fq) const {
        const int pn = u.pn, row0 = u.pm * BM + wr * 64 + fr;
        if (pn >= 8) {
            const int head = 4 * (pn - 8) + wc, i0 = 8 * fq;
            unsigned char* base = Q + ((size_t)((u.pm >> 4) * 16 + head) * 4096) * 192 + 128 + i0;
#pragma unroll
            for (int ai = 0; ai < 2; ++ai) { f32x4 cs[4][4];
#pragma unroll
                for (int m = 0; m < 4; ++m) { const int row = row0 + ai * HALF + m * 16; const float* cp = cosR + (size_t)row * 32 + i0; const float* sp = sinR + (size_t)row * 32 + i0;
                    cs[m][0] = *(const f32x4*)cp; cs[m][1] = *(const f32x4*)(cp + 4); cs[m][2] = *(const f32x4*)sp; cs[m][3] = *(const f32x4*)(sp + 4); }
#pragma unroll
                for (int m = 0; m < 4; ++m) { const int row = row0 + ai * HALF + m * 16; const f32x4 c0 = cs[m][0], c1 = cs[m][1], s0 = cs[m][2], s1 = cs[m][3];
                    const f32x4 x10 = acc[ai][0][m][0], x11 = acc[ai][0][m][1], x20 = acc[ai][1][m][0], x21 = acc[ai][1][m][1];
                    unsigned char* rp = base + (size_t)(row & 4095) * 192;
                    st8f(rp, x10 * c0 - x20 * s0, x11 * c1 - x21 * s1); st8f(rp + 32, x20 * c0 + x10 * s0, x21 * c1 + x11 * s1); } }
        } else {
            unsigned char* base = Q + ((size_t)((u.pm >> 4) * 16 + 2 * pn) * 4096) * 192 + wc * 32 + 8 * fq;
#pragma unroll
            for (int ai = 0; ai < 2; ++ai)
#pragma unroll
                for (int m = 0; m < 4; ++m) { unsigned char* rp = base + (size_t)((row0 + ai * HALF + m * 16) & 4095) * 192;
#pragma unroll
                    for (int bj = 0; bj < 2; ++bj) st8f(rp + (size_t)bj * 4096 * 192, acc[ai][bj][m][0], acc[ai][bj][m][1]); }
        }
    }
};
struct EpiKV {
    static constexpr bool PERM = true, AFTER_DRAIN = false; static constexpr int MID_T = -1;
    unsigned char* K8; unsigned char* V8T;
    __device__ __forceinline__ void operator()(const f32x4 (&acc)[2][2][4][2], const Unit& u, int wr, int wc, int fr, int fq) const {
        const int row0 = u.pm * BM + wr * 64 + fr, j0 = wc * 32 + 8 * fq; const size_t bh = (size_t)((u.pm >> 4) * 16 + u.pn);
#pragma unroll
        for (int ai = 0; ai < 2; ++ai)
#pragma unroll
            for (int m = 0; m < 4; ++m) { const int s_ = (row0 + ai * HALF + m * 16) & 4095, t = s_ & 63;
                st8f(K8 + (bh * 4096 + s_) * 128 + j0, acc[ai][0][m][0], acc[ai][0][m][1]);
                const int vp = 32 * ((t >> 2) & 1) + (t & 3) + 4 * ((t >> 3) & 3) + 16 * (t >> 5);
                unsigned char* vb = V8T + ((bh * 64 + (s_ >> 6)) * 128 + j0) * 64 + vp;
                const f32x4 v0 = acc[ai][1][m][0], v1 = acc[ai][1][m][1];
                const unsigned w0 = (unsigned)__builtin_amdgcn_cvt_pk_fp8_f32(v0[0], v0[1], 0, false), w1 = (unsigned)__builtin_amdgcn_cvt_pk_fp8_f32(v0[2], v0[3], 0, false), w2 = (unsigned)__builtin_amdgcn_cvt_pk_fp8_f32(v1[0], v1[1], 0, false), w3 = (unsigned)__builtin_amdgcn_cvt_pk_fp8_f32(v1[2], v1[3], 0, false);
                vb[0] = (unsigned char)w0; vb[64] = (unsigned char)(w0 >> 8); vb[128] = (unsigned char)w1; vb[192] = (unsigned char)(w1 >> 8); vb[256] = (unsigned char)w2; vb[320] = (unsigned char)(w2 >> 8); vb[384] = (unsigned char)w3; vb[448] = (unsigned char)(w3 >> 8); }
    }
};
struct EpiMix {
    static constexpr bool PERM = true, AFTER_DRAIN = false; static constexpr int MID_T = 32;
    const unsigned char* GA; const unsigned char* GB; bf16_t* O;
    __device__ __forceinline__ void mid(f32x4 (&acc)[2][2][4][2], const Unit& u, int wr, int wc, int fr_in, int fq_in) const {
        int fr = fr_in, fq = fq_in; asm volatile("" : "+v"(fr), "+v"(fq));
        const int row0 = u.pm * BM + wr * 64 + fr; const size_t c0 = (size_t)u.pn * BM + wc * 32 + 8 * fq;
#pragma unroll
        for (int ai = 0; ai < 2; ++ai)
#pragma unroll
            for (int m = 0; m < 4; ++m) { const size_t ro = (size_t)(row0 + ai * HALF + m * 16) * 4096 + c0;
#pragma unroll
                for (int bj = 0; bj < 2; ++bj) { const size_t p = ro + bj * HALF; const unsigned long long ga = *(const unsigned long long*)(GA + p), gb = *(const unsigned long long*)(GB + p);
                    const f32x4 a0 = u8x4_f((unsigned)ga), a1 = u8x4_f((unsigned)(ga >> 32)); f32x4 b0 = u8x4_f((unsigned)gb), b1 = u8x4_f((unsigned)(gb >> 32));
#pragma unroll
                    for (int i = 0; i < 4; ++i) { b0[i] = fmaxf(b0[i], 1.f); b1[i] = fmaxf(b1[i], 1.f); }
                    acc[ai][bj][m][0] *= (f32x4){a0[0] * __builtin_amdgcn_rcpf(b0[0]), a0[1] * __builtin_amdgcn_rcpf(b0[1]), a0[2] * __builtin_amdgcn_rcpf(b0[2]), a0[3] * __builtin_amdgcn_rcpf(b0[3])};
                    acc[ai][bj][m][1] *= (f32x4){a1[0] * __builtin_amdgcn_rcpf(b1[0]), a1[1] * __builtin_amdgcn_rcpf(b1[1]), a1[2] * __builtin_amdgcn_rcpf(b1[2]), a1[3] * __builtin_amdgcn_rcpf(b1[3])}; }
            }
    }
    __device__ __forceinline__ void operator()(const f32x4 (&acc)[2][2][4][2], const Unit& u, int wr, int wc, int fr, int fq) const {
        const int row0 = u.pm * BM + wr * 64 + fr; const size_t c0 = (size_t)u.pn * BM + wc * 32 + 8 * fq;
        unsigned long long gbv[2][4][2];
#pragma unroll
        for (int ai = 0; ai < 2; ++ai)
#pragma unroll
            for (int m = 0; m < 4; ++m)
#pragma unroll
                for (int bj = 0; bj < 2; ++bj) gbv[ai][m][bj] = *(const unsigned long long*)(GB + (size_t)(row0 + ai * HALF + m * 16) * 4096 + c0 + bj * HALF);
#pragma unroll
        for (int ai = 0; ai < 2; ++ai)
#pragma unroll
            for (int m = 0; m < 4; ++m)
#pragma unroll
                for (int bj = 0; bj < 2; ++bj) { const size_t p = (size_t)(row0 + ai * HALF + m * 16) * 4096 + c0 + bj * HALF; const unsigned long long gb = gbv[ai][m][bj];
                    f32x4 b0 = u8x4_f((unsigned)gb), b1 = u8x4_f((unsigned)(gb >> 32));
#pragma unroll
                    for (int i = 0; i < 4; ++i) { b0[i] = fmaxf(b0[i], 1.f) * (1.f / 255.f); b1[i] = fmaxf(b1[i], 1.f) * (1.f / 255.f); }
                    st8(O + p, acc[ai][bj][m][0] * b0, acc[ai][bj][m][1] * b1); }
    }
};
template <bool BASE_F32> struct EpiRes {
    static constexpr bool PERM = true, AFTER_DRAIN = false; static constexpr int MID_T = -1;
    const void* base; bf16_t* out; const float* gvec;
    __device__ __forceinline__ void operator()(const f32x4 (&acc)[2][2][4][2], const Unit& u, int wr, int wc, int fr, int fq) const {
        const int row0 = u.pm * BM + wr * 64 + fr, col0 = u.pn * BM + wc * 32 + 8 * fq; const float* gb = gvec + (size_t)(u.pm >> 4) * 4096 + col0;
        f32x4 gv[2][2];
#pragma unroll
        for (int bj = 0; bj < 2; ++bj)
#pragma unroll
            for (int n = 0; n < 2; ++n) gv[bj][n] = *(const f32x4*)(gb + bj * HALF + n * 4);
        if constexpr (BASE_F32) {
#pragma unroll
            for (int ai = 0; ai < 2; ++ai) { f32x4 pre[4][2][2];
#pragma unroll
                for (int m = 0; m < 4; ++m)
#pragma unroll
                    for (int bj = 0; bj < 2; ++bj) { const size_t p = (size_t)(row0 + ai * HALF + m * 16) * 4096 + col0 + bj * HALF; pre[m][bj][0] = *(const f32x4*)((const float*)base + p); pre[m][bj][1] = *(const f32x4*)((const float*)base + p + 4); }
#pragma unroll
                for (int m = 0; m < 4; ++m)
#pragma unroll
                    for (int bj = 0; bj < 2; ++bj) { const size_t p = (size_t)(row0 + ai * HALF + m * 16) * 4096 + col0 + bj * HALF; st8(out + p, pre[m][bj][0] + gv[bj][0] * acc[ai][bj][m][0], pre[m][bj][1] + gv[bj][1] * acc[ai][bj][m][1]); } }
        } else {
            u32x4 pre[2][4][2];
#pragma unroll
            for (int ai = 0; ai < 2; ++ai)
#pragma unroll
                for (int m = 0; m < 4; ++m)
#pragma unroll
                    for (int bj = 0; bj < 2; ++bj) pre[ai][m][bj] = *(const u32x4*)((const bf16_t*)base + (size_t)(row0 + ai * HALF + m * 16) * 4096 + col0 + bj * HALF);
#pragma unroll
            for (int ai = 0; ai < 2; ++ai)
#pragma unroll
                for (int m = 0; m < 4; ++m)
#pragma unroll
                    for (int bj = 0; bj < 2; ++bj) { const size_t p = (size_t)(row0 + ai * HALF + m * 16) * 4096 + col0 + bj * HALF; st8(out + p, bf4_lo(pre[ai][m][bj]) + gv[bj][0] * acc[ai][bj][m][0], bf4_hi(pre[ai][m][bj]) + gv[bj][1] * acc[ai][bj][m][1]); }
        }
    }
};
struct EpiGU {
    static constexpr bool PERM = true, AFTER_DRAIN = false; static constexpr int MID_T = -1;
    bf16_t* A;
    __device__ __forceinline__ void operator()(const f32x4 (&acc)[2][2][4][2], const Unit& u, int wr, int wc, int fr, int fq) const {
        const int row0 = u.pm * BM + wr * 64 + fr; bf16_t* base = A + u.pn * HALF + wc * 32 + 8 * fq;
#pragma unroll
        for (int ai = 0; ai < 2; ++ai)
#pragma unroll
            for (int m = 0; m < 4; ++m) { const f32x4 g0 = acc[ai][0][m][0], g1 = acc[ai][0][m][1], u0 = acc[ai][1][m][0], u1 = acc[ai][1][m][1];
                st8(base + (size_t)(row0 + ai * HALF + m * 16) * 11008, g0 * sigmoid4(g0) * u0, g1 * sigmoid4(g1) * u1); }
    }
};

template <class Epi, class Sched, bool ALIGN_EPI = false, bool SP2 = false, bool F8 = false, int SCALE_W = 127, bool I8 = false>
__device__ __forceinline__ void gemm_phase(PG8_LAS unsigned char* lds, const Gemm g, const Sched& S, const Epi& E) {
    int tid_ = threadIdx.x; asm volatile("" : "+v"(tid_));
    const int tid = tid_, wid = __builtin_amdgcn_readfirstlane(tid >> 6), lane = tid & 63, wr = wid >> 2, wc = wid & 3, fr = lane & 15, fq = lane >> 4;
    const int K = g.K, nt = F8 ? K / 128 : K / BK;
    unsigned voffA[2], voffB[2];
#pragma unroll
    for (int i = 0; i < 2; ++i) { int R, C; stage_rc(tid * 16 + i * 8192, R, C); const int Rb = Epi::PERM ? ((R & ~31) + perm32(R & 31)) : R;
        voffA[i] = F8 ? (unsigned)(R * K + 2 * C) : (unsigned)(R * K + C) * 2u; voffB[i] = F8 ? (unsigned)(Rb * K + 2 * C) : (unsigned)(Rb * K + C) * 2u; }
    const size_t kstep = (size_t)(BK * 2);
    const size_t hstep = (size_t)HALF * K * (F8 ? 1 : 2);
    const size_t tstep = 2 * hstep;
    const unsigned ldsw = (unsigned)wid * 1024u;
    const int fcol = F8 ? (fq >> 1) * 32 + (fq & 1) * 16 : fq * 8;
    const int aoff = lds_byte(wr * 64 + fr, fcol), boff = lds_byte(wc * 32 + fr, fcol);
    int scale_w = SCALE_W * 0x01010101, scale_a = 0x7f7f7f7f; asm volatile("" : "+v"(scale_w), "+v"(scale_a));
#define PG8_SA(b, h) (((b) * 2 + (h)) * HTB)
#define PG8_SB(b, h) ((4 + (b) * 2 + (h)) * HTB)
#define PG8_STAGE(bufoff, gbase, voff) do { _Pragma("unroll") for (int _i = 0; _i < 2; ++_i) \
        __builtin_amdgcn_global_load_lds((const unsigned*)((const char*)(gbase) + (voff)[_i]), (PG8_LAS unsigned*)(lds + (bufoff) + ldsw + _i * 8192), 16, 0, 0); } while (0)
#define PG8_RD16(off) (*(const PG8_LAS i32x4_t*)(lds + (off)))
#define PG8_LDA(dst, b, h) do { if constexpr (F8) { _Pragma("unroll") for (int m = 0; m < 4; ++m) dst##8[m] = PG8_CAT8(PG8_RD16(PG8_SA(b, h) + aoff + m * 2048), PG8_RD16(PG8_SA(b, h) + aoff + m * 2048 + 16)); } \
    else { _Pragma("unroll") for (int m = 0; m < 4; ++m) _Pragma("unroll") for (int k = 0; k < 2; ++k) dst[m][k] = *(const PG8_LAS bf16x8*)(lds + PG8_SA(b, h) + aoff + m * 2048 + k * 1024); } } while (0)
#define PG8_LDB(dst, b, h) do { if constexpr (F8) { _Pragma("unroll") for (int n = 0; n < 2; ++n) dst##8[n] = PG8_CAT8(PG8_RD16(PG8_SB(b, h) + boff + n * 2048), PG8_RD16(PG8_SB(b, h) + boff + n * 2048 + 16)); } \
    else { _Pragma("unroll") for (int n = 0; n < 2; ++n) _Pragma("unroll") for (int k = 0; k < 2; ++k) dst[n][k] = *(const PG8_LAS bf16x8*)(lds + PG8_SB(b, h) + boff + n * 2048 + k * 1024); } } while (0)
#define PG8_CAT8(lo, hi) __builtin_shufflevector(lo, hi, 0, 1, 2, 3, 4, 5, 6, 7)
#define PG8_LO4(x) __builtin_shufflevector(x, x, 0, 1, 2, 3)
#define PG8_HI4(x) __builtin_shufflevector(x, x, 4, 5, 6, 7)
#define PG8_MMA(ai, bj, At, Bt) do { __builtin_amdgcn_s_setprio(1); if constexpr (I8) { _Pragma("unroll") for (int m = 0; m < 4; ++m) _Pragma("unroll") for (int n = 0; n < 2; ++n) { \
        i32x4_t c_ = __builtin_bit_cast(i32x4_t, acc[ai][bj][m][n]); c_ = __builtin_amdgcn_mfma_i32_16x16x64_i8(PG8_LO4(Bt##8[n]), PG8_LO4(At##8[m]), c_, 0, 0, 0); \
        c_ = __builtin_amdgcn_mfma_i32_16x16x64_i8(PG8_HI4(Bt##8[n]), PG8_HI4(At##8[m]), c_, 0, 0, 0); acc[ai][bj][m][n] = __builtin_bit_cast(f32x4, c_); } } \
      else if constexpr (F8) { _Pragma("unroll") for (int m = 0; m < 4; ++m) _Pragma("unroll") for (int n = 0; n < 2; ++n) \
        asm volatile("v_mfma_scale_f32_16x16x128_f8f6f4 %0, %1, %2, %0, %3, %4 op_sel_hi:[0,0,0]" : "+v"(acc[ai][bj][m][n]) : "v"(Bt##8[n]), "v"(At##8[m]), "v"(scale_w), "v"(scale_a)); } \
      else { _Pragma("unroll") for (int m = 0; m < 4; ++m) _Pragma("unroll") for (int n = 0; n < 2; ++n) _Pragma("unroll") for (int k = 0; k < 2; ++k) \
        acc[ai][bj][m][n] = __builtin_amdgcn_mfma_f32_16x16x32_bf16(Bt[n][k], At[m][k], acc[ai][bj][m][n], 0, 0, 0); } __builtin_amdgcn_s_setprio(0); } while (0)
#define PG8_WAIT_V(n) asm volatile("s_waitcnt vmcnt(" #n ")" ::: "memory")
#define PG8_WAIT_L(n) asm volatile("s_waitcnt lgkmcnt(" #n ")" ::: "memory")
#define PG8_BAR __builtin_amdgcn_s_barrier()
#define PG8_SCHED __builtin_amdgcn_sched_barrier(0)
    Unit cur, nxt; int ui = 0;
    if (!S.next(0, cur)) return;
    f32x4 acc[2][2][4][2];
#pragma unroll
    for (int a = 0; a < 2; ++a)
#pragma unroll
        for (int b = 0; b < 2; ++b)
#pragma unroll
            for (int m = 0; m < 4; ++m)
#pragma unroll
                for (int n = 0; n < 2; ++n) acc[a][b][m][n] = (f32x4){0.f, 0.f, 0.f, 0.f};
    bf16x8 At[4][2], B0[2][2], B1[2][2]; i32x8_t At8[4], B08[2], B18[2];
    const char* cA = (const char*)g.A + (size_t)cur.pm * tstep; const char* cB = (const char*)g.Bt + (size_t)cur.pn * tstep;
    S.a_ready(cur);
    if constexpr (SP2) {
        PG8_STAGE(PG8_SB(0, 0), cB, voffB); PG8_STAGE(PG8_SB(0, 1), cB + hstep, voffB); PG8_STAGE(PG8_SA(0, 0), cA, voffA); PG8_STAGE(PG8_SA(0, 1), cA + hstep, voffA);
        if (wr == 1) PG8_BAR;
        PG8_WAIT_V(2); PG8_BAR;
        PG8_STAGE(PG8_SB(1, 0), cB + kstep, voffB); PG8_STAGE(PG8_SA(1, 0), cA + kstep, voffA); PG8_STAGE(PG8_SB(1, 1), cB + hstep + kstep, voffB);
        PG8_WAIT_V(6); PG8_BAR;
    } else {
        PG8_STAGE(PG8_SB(0, 0), cB, voffB); PG8_STAGE(PG8_SA(0, 0), cA, voffA); PG8_STAGE(PG8_SB(0, 1), cB + hstep, voffB); PG8_STAGE(PG8_SA(0, 1), cA + hstep, voffA);
        if (wr == 1) PG8_BAR;
        PG8_WAIT_V(4); PG8_BAR;
        PG8_STAGE(PG8_SB(1, 0), cB + kstep, voffB); PG8_STAGE(PG8_SA(1, 0), cA + kstep, voffA); PG8_STAGE(PG8_SB(1, 1), cB + hstep + kstep, voffB);
        PG8_WAIT_V(6); PG8_BAR;
    }
    for (;;) {
        const bool has_next = S.next(ui + 1, nxt);
        const char* nA = has_next ? (const char*)g.A + (size_t)nxt.pm * tstep : cA; const char* nB = has_next ? (const char*)g.Bt + (size_t)nxt.pn * tstep : cB;
        for (int t = 0; t < nt; t += 2) {
            if constexpr (Epi::MID_T >= 0) { if (t == Epi::MID_T) E.mid(acc, cur, wr, wc, fr, fq); }
            const bool last = (t == nt - 2);
            const char* a1 = cA + (size_t)(t + 1) * kstep;
            const char* a2 = last ? nA : cA + (size_t)(t + 2) * kstep; const char* b2 = last ? nB : cB + (size_t)(t + 2) * kstep;
            const char* a3 = a2 + kstep; const char* b3 = b2 + kstep;
            if (last && has_next) S.a_ready(nxt);
            if constexpr (SP2) {
            PG8_LDB(B0, 0, 0); PG8_LDB(B1, 0, 1); PG8_SCHED; PG8_LDA(At, 0, 0); PG8_STAGE(PG8_SA(1, 1), a1 + hstep, voffA);
            PG8_WAIT_V(8); PG8_WAIT_L(0); PG8_BAR; PG8_MMA(0, 0, At, B0); PG8_MMA(0, 1, At, B1); PG8_BAR; PG8_SCHED;
            PG8_LDA(At, 0, 1); PG8_STAGE(PG8_SB(0, 0), b2, voffB); PG8_STAGE(PG8_SB(0, 1), b2 + hstep, voffB); PG8_STAGE(PG8_SA(0, 0), a2, voffA);
            PG8_WAIT_V(8); PG8_WAIT_L(0); PG8_BAR; PG8_MMA(1, 0, At, B0); PG8_MMA(1, 1, At, B1); PG8_BAR; PG8_SCHED;
            PG8_LDB(B0, 1, 0); PG8_LDB(B1, 1, 1); PG8_SCHED; PG8_LDA(At, 1, 0); PG8_STAGE(PG8_SA(0, 1), a2 + hstep, voffA);
            PG8_WAIT_V(8); PG8_WAIT_L(0); PG8_BAR; PG8_MMA(0, 0, At, B0); PG8_MMA(0, 1, At, B1); PG8_BAR; PG8_SCHED;
            PG8_LDA(At, 1, 1); PG8_STAGE(PG8_SB(1, 0), b3, voffB); PG8_STAGE(PG8_SB(1, 1), b3 + hstep, voffB); PG8_STAGE(PG8_SA(1, 0), a3, voffA);
            PG8_WAIT_V(8); PG8_WAIT_L(0); PG8_BAR; PG8_MMA(1, 0, At, B0); PG8_MMA(1, 1, At, B1); PG8_BAR; PG8_SCHED;
            } else {
            PG8_LDB(B0, 0, 0); PG8_SCHED; PG8_LDA(At, 0, 0); PG8_STAGE(PG8_SA(1, 1), a1 + hstep, voffA);
            PG8_WAIT_L(8); PG8_BAR; PG8_WAIT_L(0); PG8_MMA(0, 0, At, B0); PG8_BAR; PG8_SCHED;
            PG8_LDB(B1, 0, 1); PG8_STAGE(PG8_SB(0, 0), b2, voffB);
            PG8_BAR; PG8_WAIT_L(0); PG8_MMA(0, 1, At, B1); PG8_BAR;
            PG8_LDA(At, 0, 1); PG8_STAGE(PG8_SA(0, 0), a2, voffA);
            PG8_BAR; PG8_WAIT_L(0); PG8_MMA(1, 0, At, B0); PG8_BAR; PG8_SCHED;
            PG8_STAGE(PG8_SB(0, 1), b2 + hstep, voffB);
            PG8_WAIT_V(6); PG8_BAR; PG8_MMA(1, 1, At, B1); PG8_BAR;
            PG8_LDB(B0, 1, 0); PG8_SCHED; PG8_LDA(At, 1, 0); PG8_STAGE(PG8_SA(0, 1), a2 + hstep, voffA);
            PG8_WAIT_L(8); PG8_BAR; PG8_WAIT_L(0); PG8_MMA(0, 0, At, B0); PG8_BAR; PG8_SCHED;
            PG8_LDB(B1, 1, 1); PG8_STAGE(PG8_SB(1, 0), b3, voffB);
            PG8_BAR; PG8_WAIT_L(0); PG8_MMA(0, 1, At, B1); PG8_BAR;
            PG8_LDA(At, 1, 1); PG8_STAGE(PG8_SA(1, 0), a3, voffA);
            PG8_BAR; PG8_WAIT_L(0); PG8_MMA(1, 0, At, B0); PG8_BAR; PG8_SCHED;
            PG8_STAGE(PG8_SB(1, 1), b3 + hstep, voffB);
            PG8_WAIT_V(6); PG8_BAR; PG8_MMA(1, 1, At, B1); PG8_BAR;
            }
        }
        if constexpr (F8) asm volatile("s_nop 15\n\ts_nop 15" ::: "memory");
        if constexpr (I8) {
            const int r0_ = cur.pm * BM + wr * 64 + fr, c0_ = cur.pn * BM + wc * 32 + 8 * fq;
#pragma unroll
            for (int a = 0; a < 2; ++a)
#pragma unroll
                for (int m = 0; m < 4; ++m) { const float sa_ = g.sa[r0_ + a * HALF + m * 16] * (1.f / 127.f);
#pragma unroll
                    for (int b = 0; b < 2; ++b)
#pragma unroll
                        for (int n = 0; n < 2; ++n) { const f32x4 sw_ = *(const f32x4*)(g.sw + c0_ + b * HALF + n * 4); const i32x4_t c_ = __builtin_bit_cast(i32x4_t, acc[a][b][m][n]);
                            acc[a][b][m][n] = (f32x4){(float)c_.x * sa_ * sw_.x, (float)c_.y * sa_ * sw_.y, (float)c_.z * sa_ * sw_.z, (float)c_.w * sa_ * sw_.w}; } } }
        if constexpr (ALIGN_EPI) { if (wr == 0) PG8_BAR; }
        if constexpr (!Epi::AFTER_DRAIN) { int fr_ = fr, fq_ = fq; asm volatile("" : "+v"(fr_), "+v"(fq_));
            E(acc, cur, wr, wc, fr_, fq_); S.done(cur); }
        if (!has_next) break;
#pragma unroll
        for (int a = 0; a < 2; ++a)
#pragma unroll
            for (int b = 0; b < 2; ++b)
#pragma unroll
                for (int m = 0; m < 4; ++m)
#pragma unroll
                    for (int n = 0; n < 2; ++n) acc[a][b][m][n] = (f32x4){0.f, 0.f, 0.f, 0.f};
        cur = nxt; cA = nA; cB = nB; ++ui;
        if constexpr (ALIGN_EPI) { if (wr == 1) PG8_BAR; }
    }
    PG8_WAIT_V(0);
    if constexpr (!ALIGN_EPI) { if (wr == 0) PG8_BAR; }
    PG8_BAR;
    if constexpr (Epi::AFTER_DRAIN) { E.fused(acc, cur, wr, wc, fr, fq, lds, wid, lane); S.done(cur); }
#undef PG8_SA
#undef PG8_SB
#undef PG8_STAGE
#undef PG8_LDA
#undef PG8_LDB
#undef PG8_MMA
#undef PG8_CAT8
#undef PG8_LO4
#undef PG8_HI4
#undef PG8_RD16
#undef PG8_WAIT_V
#undef PG8_WAIT_L
#undef PG8_BAR
#undef PG8_SCHED
}
}
namespace att {
typedef unsigned short bf16;
using bf16x8 = __attribute__((ext_vector_type(8))) short;
using s16x4  = __attribute__((ext_vector_type(4))) short;
using f32x16 = __attribute__((ext_vector_type(16))) float;
using u32x4  = __attribute__((ext_vector_type(4))) unsigned;
constexpr int SEQ = 4096, MTOK = 16384;
constexpr int NW = 8, QBLK = 32, KVBLK = 64;
constexpr float SCALE_MLA = 0.07216878364870323f;
constexpr float SCALE_DIL = 0.08838834764831845f;
constexpr float THR = 8.f;
constexpr float THR_MLA = 5.f;
constexpr int L_V = 0, L_KN = 32768, L_KR = 65536, L_WS = 81920, ATT_LDS_BYTES = 83968;
#define KSWZ(row, colB) ((row) * 256 + ((colB) ^ (((row) & 7) << 4)))
#define KRSWZ(row, c) ((row) * 128 + ((((c) ^ ((row) >> 1)) & 7) << 4))
#define SBAR() __builtin_amdgcn_sched_barrier(0)
__device__ __forceinline__ int crow(int r, int hi) { return (r & 3) + 8 * (r >> 2) + 4 * hi; }
__device__ __forceinline__ unsigned cvtpk(float lo, float hi) { unsigned r; asm volatile("v_cvt_pk_bf16_f32 %0, %1, %2" : "=v"(r) : "v"(lo), "v"(hi)); return r; }
__device__ __forceinline__ bf16x8 ld8(const bf16* p) { return *reinterpret_cast<const bf16x8*>(p); }

template <bool MLA> __device__ __forceinline__ void partialSM(f32x16& p0, f32x16& p1, float& m_reg, float& mn, float& alpha) {
  constexpr float SCALE = MLA ? SCALE_MLA : SCALE_DIL;
  constexpr float C = SCALE * 1.4426950408889634f;
  float pmax = p0[0];
#pragma unroll
  for (int r = 1; r < 16; ++r) pmax = fmaxf(pmax, p0[r]);
#pragma unroll
  for (int r = 0; r < 16; ++r) pmax = fmaxf(pmax, p1[r]);
  { auto rr = __builtin_amdgcn_permlane32_swap(__float_as_uint(pmax), __float_as_uint(pmax), false, false);
    pmax = fmaxf(__uint_as_float(rr[0]), __uint_as_float(rr[1])); }
  constexpr float THR_ = MLA ? THR_MLA : THR;
  if (__builtin_expect(__all(pmax - m_reg <= THR_ / SCALE), 1)) { mn = m_reg; alpha = 1.f; }
  else { mn = fmaxf(m_reg, pmax); alpha = __builtin_amdgcn_exp2f((m_reg - mn) * C); m_reg = mn; }
  float mnC = -mn * C;
#pragma unroll
  for (int r = 0; r < 16; ++r) p0[r] = fmaf(p0[r], C, mnC);
#pragma unroll
  for (int r = 0; r < 16; ++r) p1[r] = fmaf(p1[r], C, mnC);
#pragma unroll
  for (int r = 0; r < 16; ++r) p0[r] = __builtin_amdgcn_exp2f(p0[r]);
}
__device__ __forceinline__ void finishSM(f32x16& p0, f32x16& p1, float alpha, float& l_reg, bf16x8& pa0, bf16x8& pa1, bf16x8& pa2, bf16x8& pa3) {
#pragma unroll
  for (int r = 0; r < 16; ++r) p1[r] = __builtin_amdgcn_exp2f(p1[r]);
  float ps = 0;
#pragma unroll
  for (int r = 0; r < 16; ++r) ps += p0[r];
#pragma unroll
  for (int r = 0; r < 16; ++r) ps += p1[r];
  { auto rr = __builtin_amdgcn_permlane32_swap(__float_as_uint(ps), __float_as_uint(ps), false, false);
    ps = __uint_as_float(rr[0]) + __uint_as_float(rr[1]); }
  l_reg = l_reg * alpha + ps;
#define PK4(P, BASE, OUT) do { unsigned a0 = cvtpk(P[BASE + 0], P[BASE + 1]), a1 = cvtpk(P[BASE + 2], P[BASE + 3]);   \
    unsigned b0 = cvtpk(P[BASE + 4], P[BASE + 5]), b1 = cvtpk(P[BASE + 6], P[BASE + 7]);                              \
    auto r0 = __builtin_amdgcn_permlane32_swap(a0, b0, false, false); auto r1 = __builtin_amdgcn_permlane32_swap(a1, b1, false, false); \
    u32x4 w = {r0[0], r1[0], r0[1], r1[1]}; OUT = *reinterpret_cast<bf16x8*>(&w); } while (0)
  PK4(p0, 0, pa0); PK4(p0, 8, pa1); PK4(p1, 0, pa2); PK4(p1, 8, pa3);
#undef PK4
}
typedef int i32x8p __attribute__((ext_vector_type(8)));
__device__ __forceinline__ void finishSM_f8(f32x16& p0, f32x16& p1, float alpha, float& l_reg, i32x8p& pa) {
#pragma unroll
  for (int r = 0; r < 16; ++r) p1[r] = __builtin_amdgcn_exp2f(p1[r]);
  float ps = 0;
#pragma unroll
  for (int r = 0; r < 16; ++r) ps += p0[r];
#pragma unroll
  for (int r = 0; r < 16; ++r) ps += p1[r];
  { auto rr = __builtin_amdgcn_permlane32_swap(__float_as_uint(ps), __float_as_uint(ps), false, false);
    ps = __uint_as_float(rr[0]) + __uint_as_float(rr[1]); }
  l_reg = l_reg * alpha + ps;
#pragma unroll
  for (int k = 0; k < 4; ++k) { int w = __builtin_amdgcn_cvt_pk_fp8_f32(p0[4 * k], p0[4 * k + 1], 0, false); w = __builtin_amdgcn_cvt_pk_fp8_f32(p0[4 * k + 2], p0[4 * k + 3], w, true); pa[k] = w;
    int v = __builtin_amdgcn_cvt_pk_fp8_f32(p1[4 * k], p1[4 * k + 1], 0, false); v = __builtin_amdgcn_cvt_pk_fp8_f32(p1[4 * k + 2], p1[4 * k + 3], v, true); pa[4 + k] = v; }
}
__host__ __device__ __forceinline__ int vpos(int t) { return 32 * ((t >> 2) & 1) + (t & 3) + 4 * ((t >> 3) & 3) + 16 * (t >> 5); }
template <int NR> __device__ __forceinline__ void qkt(f32x16& p0, f32x16& p1, const char* Kn, const char* Kr, const bf16x8* qr, int r32, int hi) {
  p0 = f32x16{}; p1 = f32x16{};
#pragma unroll
  for (int d0 = 0; d0 < 8; ++d0) { int cb = (d0 * 16 + hi * 8) * 2;
    bf16x8 b0 = *reinterpret_cast<const bf16x8*>(Kn + KSWZ(r32, cb));
    bf16x8 b1 = *reinterpret_cast<const bf16x8*>(Kn + KSWZ(32 + r32, cb));
    p0 = __builtin_amdgcn_mfma_f32_32x32x16_bf16(b0, qr[d0], p0, 0, 0, 0);
    p1 = __builtin_amdgcn_mfma_f32_32x32x16_bf16(b1, qr[d0], p1, 0, 0, 0); }
#pragma unroll
  for (int d0 = 0; d0 < NR; ++d0) { int c = d0 * 2 + hi;
    bf16x8 b0 = *reinterpret_cast<const bf16x8*>(Kr + KRSWZ(r32, c));
    bf16x8 b1 = *reinterpret_cast<const bf16x8*>(Kr + KRSWZ(32 + r32, c));
    p0 = __builtin_amdgcn_mfma_f32_32x32x16_bf16(b0, qr[8 + d0], p0, 0, 0, 0);
    p1 = __builtin_amdgcn_mfma_f32_32x32x16_bf16(b1, qr[8 + d0], p1, 0, 0, 0); }
}
__device__ __forceinline__ int v_st(int k, int c) { const int kk = (k & ~0xC) | ((k & 4) << 1) | ((k & 8) >> 1); return ((kk >> 3) * 4 + (c >> 5)) * 512 + ((kk & 7) * 32 + (c & 31)) * 2; }
__device__ __forceinline__ int v_rd_base(int lane) { return ((lane & 3) << 3) | (((lane >> 2) & 3) << 6) | (((lane >> 4) & 1) << 5) | (((lane >> 5) & 1) << 8); }
constexpr int v_rd_off(int d0, int ks, int half) { return d0 * 512 + ks * 4096 + half * 2048; }
template <int OFF> __device__ __forceinline__ s16x4 tr_read(int vb) {
  s16x4 r; asm volatile("ds_read_b64_tr_b16 %0, %1 offset:%2" : "=&v"(r) : "v"(vb), "i"(OFF) : "memory"); return r;
}
template <int D0> __device__ __forceinline__ void pv_one(f32x16& od, int vb, bf16x8 pa0, bf16x8 pa1, bf16x8 pa2, bf16x8 pa3) {
  const s16x4 l0 = tr_read<v_rd_off(D0, 0, 0)>(vb), h0 = tr_read<v_rd_off(D0, 0, 1)>(vb), l1 = tr_read<v_rd_off(D0, 1, 0)>(vb), h1 = tr_read<v_rd_off(D0, 1, 1)>(vb);
  const s16x4 l2 = tr_read<v_rd_off(D0, 2, 0)>(vb), h2 = tr_read<v_rd_off(D0, 2, 1)>(vb), l3 = tr_read<v_rd_off(D0, 3, 0)>(vb), h3 = tr_read<v_rd_off(D0, 3, 1)>(vb);
  asm volatile("s_waitcnt lgkmcnt(0)" ::: "memory"); SBAR();
#define PK(L, H) (bf16x8){L[0], L[1], L[2], L[3], H[0], H[1], H[2], H[3]}
  od = __builtin_amdgcn_mfma_f32_32x32x16_bf16(pa0, PK(l0, h0), od, 0, 0, 0);
  od = __builtin_amdgcn_mfma_f32_32x32x16_bf16(pa1, PK(l1, h1), od, 0, 0, 0);
  od = __builtin_amdgcn_mfma_f32_32x32x16_bf16(pa2, PK(l2, h2), od, 0, 0, 0);
  od = __builtin_amdgcn_mfma_f32_32x32x16_bf16(pa3, PK(l3, h3), od, 0, 0, 0);
#undef PK
}
__device__ __forceinline__ void pv_d0(f32x16* o, int vb, bf16x8 pa0, bf16x8 pa1, bf16x8 pa2, bf16x8 pa3) {
  pv_one<0>(o[0], vb, pa0, pa1, pa2, pa3); pv_one<1>(o[1], vb, pa0, pa1, pa2, pa3); pv_one<2>(o[2], vb, pa0, pa1, pa2, pa3); pv_one<3>(o[3], vb, pa0, pa1, pa2, pa3);
}
__device__ __forceinline__ void store_o_bf16(const f32x16* o, float l_reg, float* wsf, char* stg, bf16* Ow, long rstride, int lane_in, int, int) {
  int lane = lane_in; asm volatile("" : "+v"(lane)); const int r32 = lane & 31, hi = lane >> 5;
  if (hi == 0) wsf[r32] = l_reg; asm volatile("s_waitcnt lgkmcnt(0)" ::: "memory");
  float rli[16];
#pragma unroll
  for (int r = 0; r < 16; ++r) rli[r] = __builtin_amdgcn_rcpf(wsf[crow(r, hi)]);
  unsigned short* st = (unsigned short*)stg;
#pragma unroll
  for (int r = 0; r < 16; ++r) { const int orow = crow(r, hi);
#pragma unroll
    for (int d0 = 0; d0 < 4; ++d0) { const float v = o[d0][r] * rli[r]; st[orow * 128 + d0 * 32 + r32] = (unsigned short)(cvtpk(v, v) & 0xffffu); } }
  asm volatile("s_waitcnt lgkmcnt(0)" ::: "memory");
#pragma unroll
  for (int i = 0; i < 8; ++i) { const int row = i * 4 + (lane >> 4), ch = lane & 15; const u32x4 v = *(const u32x4*)(stg + row * 256 + ch * 16); *(u32x4*)(Ow + (long)row * rstride + ch * 8) = v; }
}

typedef __attribute__((address_space(3))) char* lds_ptr;
typedef short v4i16_t __attribute__((ext_vector_type(4)));
__device__ __forceinline__ bf16x8 ldsf(lds_ptr p, int off) { return *(const __attribute__((address_space(3))) bf16x8*)(p + off); }
__device__ __forceinline__ s16x4 vtr(lds_ptr p, int off) { return __builtin_bit_cast(s16x4, __builtin_amdgcn_ds_read_tr16_b64_v4i16((__attribute__((address_space(3))) v4i16_t*)(p + off))); }
template <int S> __device__ __forceinline__ void kld(bf16x8& lo, bf16x8& hi_, lds_ptr Kn, lds_ptr Kr, int rown, int tn, int rowr, int tr) {
  if constexpr (S < 8) { const int off = rown + (((S & 3) * 32) ^ tn) + (S >> 2) * 128; lo = ldsf(Kn, off); hi_ = ldsf(Kn, off + 8192); }
  else { const int off = rowr + (((S - 8) * 32) ^ tr); lo = ldsf(Kr, off); hi_ = ldsf(Kr, off + 4096); }
}
template <int NS> __device__ __forceinline__ void qkt_ring(f32x16& p0, f32x16& p1, lds_ptr Kn, lds_ptr Kr, const bf16x8* qr, int r32, int hi) {
  const int rown = r32 * 256, tn = (hi * 16) ^ ((r32 & 7) << 4), rowr = r32 * 128, tr = (hi ^ ((r32 >> 1) & 7)) << 4;
  bf16x8 a0, a1, b0, b1, c0, c1;
  p0 = f32x16{}; p1 = f32x16{};
  kld<0>(a0, a1, Kn, Kr, rown, tn, rowr, tr); kld<1>(b0, b1, Kn, Kr, rown, tn, rowr, tr);
#define QSTEP(S, C0, C1, N0, N1) do { if constexpr ((S) < NS) { if constexpr ((S) + 2 < NS) kld<((S) + 2 < NS ? (S) + 2 : 0)>(N0, N1, Kn, Kr, rown, tn, rowr, tr); SBAR(); \
    p0 = __builtin_amdgcn_mfma_f32_32x32x16_bf16(C0, qr[(S) < NS ? (S) : 0], p0, 0, 0, 0); p1 = __builtin_amdgcn_mfma_f32_32x32x16_bf16(C1, qr[(S) < NS ? (S) : 0], p1, 0, 0, 0); SBAR(); } } while (0)
  QSTEP(0, a0, a1, c0, c1); QSTEP(1, b0, b1, a0, a1); QSTEP(2, c0, c1, b0, b1); QSTEP(3, a0, a1, c0, c1); QSTEP(4, b0, b1, a0, a1); QSTEP(5, c0, c1, b0, b1);
  QSTEP(6, a0, a1, c0, c1); QSTEP(7, b0, b1, a0, a1); QSTEP(8, c0, c1, b0, b1); QSTEP(9, a0, a1, c0, c1); QSTEP(10, b0, b1, a0, a1); QSTEP(11, c0, c1, b0, b1);
#undef QSTEP
}
#define VOFF(i, half) v_rd_off((i) >> 2, (i) & 3, half)
__device__ __forceinline__ void pv_ring_pre(lds_ptr vp, s16x4& la, s16x4& ha, s16x4& lb, s16x4& hb) { la = vtr(vp, VOFF(0, 0)); ha = vtr(vp, VOFF(0, 1)); lb = vtr(vp, VOFF(1, 0)); hb = vtr(vp, VOFF(1, 1)); }
__device__ __forceinline__ void pv_ring(f32x16* o, lds_ptr vp, s16x4 la, s16x4 ha, s16x4 lb, s16x4 hb, bf16x8 pa0, bf16x8 pa1, bf16x8 pa2, bf16x8 pa3) {
  s16x4 lc, hc;
#define PKV(L, H) (bf16x8){L[0], L[1], L[2], L[3], H[0], H[1], H[2], H[3]}
#define PSTEP(I, PA, CL, CH, NL, NH) do { if constexpr ((I) + 2 < 16) { NL = vtr(vp, VOFF(((I) + 2) & 15, 0)); NH = vtr(vp, VOFF(((I) + 2) & 15, 1)); } SBAR(); \
    o[(I) >> 2] = __builtin_amdgcn_mfma_f32_32x32x16_bf16(PA, PKV(CL, CH), o[(I) >> 2], 0, 0, 0); SBAR(); } while (0)
  PSTEP(0, pa0, la, ha, lc, hc);  PSTEP(1, pa1, lb, hb, la, ha);  PSTEP(2, pa2, lc, hc, lb, hb);  PSTEP(3, pa3, la, ha, lc, hc);
  PSTEP(4, pa0, lb, hb, la, ha);  PSTEP(5, pa1, lc, hc, lb, hb);  PSTEP(6, pa2, la, ha, lc, hc);  PSTEP(7, pa3, lb, hb, la, ha);
  PSTEP(8, pa0, lc, hc, lb, hb);  PSTEP(9, pa1, la, ha, lc, hc);  PSTEP(10, pa2, lb, hb, la, ha); PSTEP(11, pa3, lc, hc, lb, hb);
  PSTEP(12, pa0, la, ha, lc, hc); PSTEP(13, pa1, lb, hb, la, ha); PSTEP(14, pa2, lc, hc, lb, hb); PSTEP(15, pa3, la, ha, lc, hc);
#undef PSTEP
#undef PKV
}
constexpr int M_V = 0, M_KN = 24576, M_KR = 49152, M_WS = 65536, MLA_LDS_BYTES = 67584;
typedef int i32x4_t __attribute__((ext_vector_type(4)));
typedef int i32x8_t __attribute__((ext_vector_type(8)));
__device__ __forceinline__ void glds16(const void* gsrc, unsigned lds_dst) { unsigned keep;
  asm volatile("s_mov_b32 %0, m0\n\ts_mov_b32 m0, %2\n\ts_nop 0\n\tglobal_load_lds_dwordx4 %1, off\n\ts_mov_b32 m0, %0" : "=&s"(keep) : "v"(gsrc), "s"(lds_dst) : "memory"); }
#define WAIT_BAR(N) asm volatile("s_waitcnt vmcnt(" #N ") lgkmcnt(0)\n\ts_barrier" ::: "memory")
__device__ __forceinline__ i32x4_t ldsq(lds_ptr p, int off) { return *(const __attribute__((address_space(3))) i32x4_t*)(p + off); }
#define CAT8(lo, hi) __builtin_shufflevector(lo, hi, 0, 1, 2, 3, 4, 5, 6, 7)
__device__ __forceinline__ void qkt_f8(f32x16& p0, f32x16& p1, lds_ptr Kn, lds_ptr Kr, const i32x8_t* q8, int r32, int hi, int sc) {
  const int swn = (r32 >> 1) & 7, swr = (r32 >> 2) & 3, rown = r32 * 128, rowr = r32 * 64;
  i32x8_t kf[6];
#pragma unroll
  for (int kb = 0; kb < 2; ++kb) {
#pragma unroll
    for (int c = 0; c < 2; ++c) { const int ci = c * 4 + 2 * hi; kf[kb * 3 + c] = CAT8(ldsq(Kn, kb * 4096 + rown + ((ci ^ swn) << 4)), ldsq(Kn, kb * 4096 + rown + (((ci + 1) ^ swn) << 4))); }
    { const int ci = 2 * hi; kf[kb * 3 + 2] = CAT8(ldsq(Kr, kb * 2048 + rowr + ((ci ^ swr) << 4)), ldsq(Kr, kb * 2048 + rowr + (((ci + 1) ^ swr) << 4))); }
  }
#define MF0(P, A, B) asm volatile("v_mfma_scale_f32_32x32x64_f8f6f4 %0, %1, %2, 0, %3, %3 op_sel_hi:[0,0,0]" : "=&v"(P) : "v"(A), "v"(B), "v"(sc))
#define MF1(P, A, B) asm volatile("v_mfma_scale_f32_32x32x64_f8f6f4 %0, %1, %2, %0, %3, %3 op_sel_hi:[0,0,0]" : "+v"(P) : "v"(A), "v"(B), "v"(sc))
  MF0(p0, kf[0], q8[0]); MF0(p1, kf[3], q8[0]); MF1(p0, kf[1], q8[1]); MF1(p1, kf[4], q8[1]); MF1(p0, kf[2], q8[2]); MF1(p1, kf[5], q8[2]);
  asm volatile("s_nop 15\n\ts_nop 7" : "+v"(p0), "+v"(p1));
#undef MF0
#undef MF1
}
__device__ __forceinline__ void pv_f8(f32x16* o, lds_ptr Vt, i32x8_t pa, int r32, int hi, int sc) {
  i32x8_t vf[4];
#pragma unroll
  for (int d0 = 0; d0 < 4; ++d0) { const int d = 32 * d0 + r32, sw = (d >> 2) & 3, ci = 2 * hi; vf[d0] = CAT8(ldsq(Vt, d * 64 + ((ci ^ sw) << 4)), ldsq(Vt, d * 64 + (((ci + 1) ^ sw) << 4))); }
#pragma unroll
  for (int d0 = 0; d0 < 4; ++d0) asm volatile("v_mfma_scale_f32_32x32x64_f8f6f4 %0, %1, %2, %0, %3, %3 op_sel_hi:[0,0,0]" : "+v"(o[d0]) : "v"(pa), "v"(vf[d0]), "v"(sc));
}
__device__ __forceinline__ void mla_unit(const unsigned char* __restrict__ Q8b, const unsigned char* __restrict__ K8h, const unsigned char* __restrict__ Vth, const unsigned char* __restrict__ KR8h, bf16* __restrict__ Ob, char* lds) {
  constexpr int LDQ = 192, LDK = 128, LDR = 64, LDO = 3072, SHM_V = 8192, SHM_K = 8192, SHM_R = 4096;
  const int tid = threadIdx.x, wid = __builtin_amdgcn_readfirstlane(tid >> 6), lane = tid & 63, r32 = lane & 31, hi = lane >> 5;
  const lds_ptr l3 = (lds_ptr)lds; const unsigned lds0 = (unsigned)(uintptr_t)lds;
  float* ws = (float*)(lds + M_WS) + wid * 64; float* al_l = ws + 32;
  float m_reg = -1e30f, l_reg = 0; f32x16 o[4] = {}; i32x8_t q8[3];
  int sc = 0x7f7f7f7f; asm volatile("" : "+v"(sc));
  const unsigned char *pk, *pr, *pv;
  { const int rk = 8 * wid + (lane >> 3); pk = K8h + (long)rk * LDK + (((lane & 7) ^ ((rk >> 1) & 7)) << 4);
    const int rr = 8 * wid + ((lane & 31) >> 2); pr = KR8h + (long)rr * LDR + (((lane & 3) ^ ((rr >> 2) & 3)) << 4);
    const int dv_ = 16 * wid + (lane >> 2); pv = Vth + (long)dv_ * 64 + (((lane & 3) ^ ((dv_ >> 2) & 3)) << 4); }
#define DMA_K(slot) do { const unsigned dk = (unsigned)__builtin_amdgcn_readfirstlane((int)(lds0 + M_KN + (slot) * SHM_K + wid * 1024)), dr = (unsigned)__builtin_amdgcn_readfirstlane((int)(lds0 + M_KR + (slot) * SHM_R + wid * 512)); \
    glds16(pk, dk); if (lane < 32) glds16(pr, dr); pk += KVBLK * LDK; pr += KVBLK * LDR; } while (0)
#define DMA_V(slot) do { const unsigned dv = (unsigned)__builtin_amdgcn_readfirstlane((int)(lds0 + M_V + (slot) * SHM_V + wid * 1024)); glds16(pv, dv); pv += 8192; } while (0)
  DMA_V(0); DMA_K(0); DMA_K(1);
  { const unsigned char* Qw = Q8b + (long)(wid * QBLK + r32) * LDQ + 32 * hi;
#pragma unroll
    for (int c = 0; c < 3; ++c) q8[c] = CAT8(*(const i32x4_t*)(Qw + c * 64), *(const i32x4_t*)(Qw + c * 64 + 16)); }
#define RESC(a) do { if (__any((a) < 1.f)) { if (hi == 0) al_l[r32] = (a); asm volatile("s_waitcnt lgkmcnt(0)" ::: "memory"); \
    _Pragma("unroll") for (int d = 0; d < 4; ++d) _Pragma("unroll") for (int r = 0; r < 16; ++r) o[d][r] *= al_l[crow(r, hi)]; } } while (0)
  f32x16 p0, p1; float mn, al; i32x8_t pa8 = {}; constexpr int NT = SEQ / KVBLK;
  WAIT_BAR(2);
  const bool late = wid >= 4;
  int s_cur = 0, s_nx1 = 1, s_nx2 = 2, s_prev = 2;
#pragma clang loop unroll(disable)
  for (int j = 0; j < NT; ++j) {
    const bool more2 = (j + 2 < NT);
    if (j + 1 < NT) DMA_V(s_nx1);
    if (more2) DMA_K(s_nx2);
    SBAR();
    if (late) { if (j > 0) pv_f8(o, l3 + M_V + s_prev * SHM_V, pa8, r32, hi, sc); }
    SBAR();
    qkt_f8(p0, p1, l3 + M_KN + s_cur * SHM_K, l3 + M_KR + s_cur * SHM_R, q8, r32, hi, sc);
    partialSM<true>(p0, p1, m_reg, mn, al); RESC(al);
    finishSM_f8(p0, p1, al, l_reg, pa8); SBAR();
    if (!late) pv_f8(o, l3 + M_V + s_cur * SHM_V, pa8, r32, hi, sc);
    SBAR();
    if (more2) WAIT_BAR(2); else WAIT_BAR(0);
    s_prev = s_cur; s_cur = s_nx1; s_nx1 = s_nx2; s_nx2 = (s_nx2 == 2) ? 0 : s_nx2 + 1;
  }
  if (late) pv_f8(o, l3 + M_V + s_prev * SHM_V, pa8, r32, hi, sc);
  asm volatile("s_nop 15\n\ts_nop 7" : "+v"(o[0]), "+v"(o[1]), "+v"(o[2]), "+v"(o[3]));
  WAIT_BAR(0);
  store_o_bf16(o, l_reg, ws, lds + wid * 8192, Ob + (long)(wid * QBLK) * LDO, LDO, lane, r32, hi);
  __syncthreads();
#undef DMA_K
#undef DMA_V
}
#undef CAT8
#undef WAIT_BAR

__device__ __forceinline__ void dil_unit(int b, int g, int h, int rho, int blk, const bf16* __restrict__ QD, const bf16* __restrict__ KD, const bf16* __restrict__ VD, bf16* __restrict__ PD, float* __restrict__ LSE, char* lds) {
  constexpr float C = SCALE_DIL * 1.4426950408889634f;
  const int d = (g == 0) ? 1 : (g == 1 ? 4 : 16), L = SEQ / d, t0 = blk * 256;
  const int tid = threadIdx.x, wid = __builtin_amdgcn_readfirstlane(tid >> 6), lane = tid & 63, r32 = lane & 31, hi = lane >> 5;
  const lds_ptr l3 = (lds_ptr)lds; char* V_lds = lds + L_V; char* K_lds = lds + L_KN;
  float* ws = (float*)(lds + L_WS) + wid * 64; float* al_l = ws + 32;
  const long tokbase = (long)b * SEQ; const long hbase = ((long)(b * 24 + g * 8 + h) * SEQ) * 128;
  float m_reg = -1e30f, l_reg = 0; f32x16 o[4] = {}; bf16x8 qr[8];
  const int tauq = t0 + wid * QBLK + r32;
  { const bf16* Qw = QD + hbase + (rho + (long)d * tauq) * 128 + hi * 8;
#pragma unroll
    for (int d0 = 0; d0 < 8; ++d0) qr[d0] = ld8(Qw + d0 * 16); }
  const int kt0 = (t0 == 0) ? 1 : 0, kt1 = ((L - t0) >> 6) < 5 ? ((L - t0) >> 6) : 5;
  bf16x8 s_ka, s_kb, s_va, s_vb;
#define DLOAD(kt_) do { int t_ = tid; asm volatile("" : "+v"(t_)); const int sr = t_ >> 4, sc = (t_ & 15) * 8, kb_ = t0 - 64 + 64 * (kt_); int ta = kb_ + sr, tb = ta + 32; \
    ta = ta < 0 ? 0 : (ta >= L ? L - 1 : ta); tb = tb < 0 ? 0 : (tb >= L ? L - 1 : tb); \
    const long oa = hbase + (rho + (long)d * ta) * 128 + sc, ob = hbase + (rho + (long)d * tb) * 128 + sc; s_ka = ld8(KD + oa); s_kb = ld8(KD + ob); s_va = ld8(VD + oa); s_vb = ld8(VD + ob); } while (0)
#define DWRITE(buf) do { int t_ = tid; asm volatile("" : "+v"(t_)); const int sr = t_ >> 4, sc = (t_ & 15) * 8, vst0 = v_st(sr, sc), kc = sc * 2; \
    *(bf16x8*)(V_lds + (buf) * 16384 + vst0) = s_va; *(bf16x8*)(V_lds + (buf) * 16384 + vst0 + 8192) = s_vb; *(bf16x8*)(K_lds + (buf) * 16384 + KSWZ(sr, kc)) = s_ka; *(bf16x8*)(K_lds + (buf) * 16384 + KSWZ(sr, kc) + 8192) = s_kb; } while (0)
  DLOAD(kt0); DWRITE(0); __syncthreads();
  int buf = 0;
  for (int kt = kt0; kt <= kt1; ++kt) {
    const bool more = kt < kt1;
    if (more) DLOAD(kt + 1);
    SBAR();
    if (kt >= (wid >> 1) && kt <= (wid >> 1) + 2) {
      f32x16 p0, p1; float mn, al; bf16x8 pa0, pa1, pa2, pa3; const int kbase = t0 - 64 + 64 * kt;
      qkt_ring<8>(p0, p1, l3 + L_KN + buf * 16384, l3 + L_KN, qr, r32, hi);
      s16x4 vla, vha, vlb, vhb; const lds_ptr vp_ = l3 + L_V + buf * 16384 + v_rd_base(lane); pv_ring_pre(vp_, vla, vha, vlb, vhb);
      const int dl0 = kbase - tauq;
#pragma unroll
      for (int r = 0; r < 16; ++r) { const int kk = crow(r, hi); const int dl = dl0 + kk, tp = kbase + kk;
        if (!(dl >= -64 && dl <= 64 && tp >= 0 && tp < L)) p0[r] = -1e30f;
        if (!(dl + 32 >= -64 && dl + 32 <= 64 && tp + 32 >= 0 && tp + 32 < L)) p1[r] = -1e30f; }
      partialSM<false>(p0, p1, m_reg, mn, al);
      RESC(al);
      finishSM(p0, p1, al, l_reg, pa0, pa1, pa2, pa3); SBAR();
      pv_ring(o, vp_, vla, vha, vlb, vhb, pa0, pa1, pa2, pa3);
    }
    if (more) DWRITE(buf ^ 1);
    __syncthreads();
    buf ^= 1;
  }
  if (hi == 0) LSE[((long)g * MTOK + tokbase + rho + (long)d * tauq) * 8 + h] = m_reg * C + __builtin_amdgcn_logf(l_reg);
  store_o_bf16(o, l_reg, ws, lds + wid * 8192, PD + ((long)g * MTOK + tokbase + rho + (long)d * (t0 + wid * QBLK)) * 1024 + h * 128, (long)d * 1024, lane, r32, hi);
  __syncthreads();
#undef DLOAD
#undef DWRITE
#undef RESC
}
#undef SBAR
}

#define GAS __attribute__((address_space(1)))
#define LAS __attribute__((address_space(3)))
typedef unsigned short bf16;
typedef unsigned v4u __attribute__((ext_vector_type(4)));
typedef float f32x4 __attribute__((ext_vector_type(4)));
typedef short bf16x8 __attribute__((ext_vector_type(8)));
typedef GAS unsigned gu32;
typedef GAS unsigned long long gu64;
#define RLX_AGENT __ATOMIC_RELAXED, __HIP_MEMORY_SCOPE_AGENT
#define LDS_WAIT() asm volatile("s_waitcnt lgkmcnt(0)" ::: "memory")
#define VM_WAIT() asm volatile("s_waitcnt vmcnt(0)" ::: "memory")
__device__ __forceinline__ unsigned long long rt() { return __builtin_amdgcn_s_memrealtime(); }
__device__ __forceinline__ unsigned f2bf(float f) { unsigned u = __builtin_bit_cast(unsigned, f); return (u + 0x7fffu + ((u >> 16) & 1u)) >> 16; }
__device__ __forceinline__ unsigned pk2(float lo, float hi) { return f2bf(lo) | (f2bf(hi) << 16); }

#define XB_TMO      128
#define XB_XCNT(j)  (256  + 64 * (j))
#define XB_XSUB(j)  (1280 + 64 * (j))
#define XB_XGEN(j)  (2304 + 64 * (j))
#define XB_TOP      3328
#define XB_TOPGEN   3392
#define XCD_BAR_WORDS 3456
#define XB_SPIN_CAP (1u << 18)

__device__ __forceinline__ unsigned xb_ld(unsigned* p)              { return __hip_atomic_load(p, __ATOMIC_RELAXED, __HIP_MEMORY_SCOPE_AGENT); }
__device__ __forceinline__ unsigned xb_add(unsigned* p, unsigned v) { return __hip_atomic_fetch_add(p, v, __ATOMIC_RELAXED, __HIP_MEMORY_SCOPE_AGENT); }
__device__ __forceinline__ unsigned xb_xcc_id() { return (unsigned)__builtin_amdgcn_s_getreg((3 << 11) | 20) & 0xFu; }
#define XB_SPIN(cond, bar) do { unsigned _sp = 0; while (cond) { __builtin_amdgcn_s_sleep(1); \
    if ((++_sp & 255u) == 0u) { if (xb_ld(&(bar)[XB_TMO])) break; if (_sp > XB_SPIN_CAP) { atomicAdd(&(bar)[XB_TMO], 1u); break; } } } } while (0)

struct XcdBarrier {
    unsigned* bar; unsigned x;
    volatile LAS unsigned* st;
};

__device__ __forceinline__ XcdBarrier xcd_barrier_post(unsigned* bar, volatile LAS unsigned* st) {
    XcdBarrier b; b.bar = bar; b.x = xb_xcc_id(); b.st = st;
    if (threadIdx.x == 0) (void)xb_add(&bar[XB_XCNT(b.x)], 1u);
    return b;
}
__device__ __forceinline__ void xcd_barrier_complete(unsigned* bar, unsigned x, unsigned& nloc, unsigned& nx) {
    const unsigned G = gridDim.x * gridDim.y * gridDim.z;
    unsigned sum, cnt, mine, sp = 0u;
    for (;;) {
        sum = 0u; cnt = 0u; mine = 0u;
#pragma unroll
        for (unsigned j = 0; j < 16; ++j) { const unsigned c = xb_ld(&bar[XB_XCNT(j)]); sum += c; cnt += (c > 0u) ? 1u : 0u; mine = (j == x) ? c : mine; }
        if (sum == G) break;
        __builtin_amdgcn_s_sleep(1);
        if ((++sp & 255u) == 0u) { if (xb_ld(&bar[XB_TMO])) break; if (sp > XB_SPIN_CAP) { atomicAdd(&bar[XB_TMO], 1u); break; } }
    }
    nloc = mine > 0u ? mine : 1u; nx = cnt > 0u ? cnt : 1u;
}

__device__ __forceinline__ void xcd_barrier(const XcdBarrier& b) {
    asm volatile("s_waitcnt vmcnt(0)" ::: "memory");
    __syncthreads();
    if (threadIdx.x == 0) {
        unsigned* bar = b.bar;
        __builtin_amdgcn_s_waitcnt(0);
        unsigned nloc = b.st[0], nx = b.st[1];
        if (nloc == 0u) { xcd_barrier_complete(bar, b.x, nloc, nx); b.st[0] = nloc; b.st[1] = nx; }
        const unsigned old = xb_add(&bar[XB_XSUB(b.x)], 1u);
        const unsigned gen = old / nloc;
        if (old + 1u == (gen + 1u) * nloc) {
            __builtin_amdgcn_fence(__ATOMIC_RELEASE, "agent");
            asm volatile("s_waitcnt vmcnt(0)" ::: "memory");
            const unsigned og = xb_add(&bar[XB_TOP], 1u);
            const unsigned tg = og / nx;
            if (og + 1u == (tg + 1u) * nx) xb_add(&bar[XB_TOPGEN], 1u);
            else XB_SPIN(xb_ld(&bar[XB_TOPGEN]) == tg, bar);
            __builtin_amdgcn_fence(__ATOMIC_ACQUIRE, "agent");
            xb_add(&bar[XB_XGEN(b.x)], 1u);
            asm volatile("s_waitcnt vmcnt(0)" ::: "memory");
        } else {
            XB_SPIN(xb_ld(&bar[XB_XGEN(b.x)]) == gen, bar);
            __builtin_amdgcn_fence(__ATOMIC_ACQUIRE, "agent");
            asm volatile("s_waitcnt vmcnt(0)" ::: "memory");
        }
    }
    __syncthreads();
}

constexpr int NWAVES = 8;
constexpr int BATCH = 4, SEQ = 4096, DM = 4096, M = BATCH * SEQ;
constexpr int QRANK = 1024, KVRANK = 512, DFF = 11008, IN_TOTAL = 19008, N_IN = 19200  , N_MOD = 6 * DM;
constexpr float NORM_EPS = 1e-6f;
#ifndef PG_ALIGN
#define PG_ALIGN true
#endif
#ifndef PG_SP2
#define PG_SP2 true
#endif
#ifdef SELFCHECK
#define HB_OR_NULL(p) (p)
#else
#define HB_OR_NULL(p) (pg8::P3_NBF > 0 ? (p) : nullptr)
#endif
#ifndef CHK_MASK
#define CHK_MASK 0xffffffff
#endif
#ifndef MK_N_LAUNCHES
#define MK_N_LAUNCHES 1
#endif
constexpr int PER_PHASE = 14;
constexpr int N_LAUNCHES = MK_N_LAUNCHES;
static_assert(N_LAUNCHES == 1 || N_LAUNCHES == PER_PHASE, "MK_N_LAUNCHES is 1 or 14");

constexpr size_t MiB = 1u << 20;
constexpr size_t WS_CTL = 0, CTL_ZERO_BYTES = 1 * MiB;
constexpr size_t WS_MOD = 1 * MiB;
constexpr size_t WS_VEC = WS_MOD + 4 * N_MOD * 4;
constexpr size_t WS_COSF = 2 * MiB, WS_SINF = 6 * MiB;
constexpr size_t WS_COSR = 10 * MiB, WS_SINR = 12 * MiB;
constexpr size_t WS_KROPE = 14 * MiB;
constexpr size_t WS_LSE = 16 * MiB;
constexpr size_t WS_MODP = 18 * MiB;
constexpr int KSPLIT = 64;
constexpr size_t WS_WIN = 48 * MiB, WS_WUQ = 198 * MiB, WS_WUKV = 204 * MiB, WS_WPA = 208 * MiB, WS_WPB = 224 * MiB, WS_WOUT = 232 * MiB, WS_WGU = 264 * MiB, WS_WDN = 436 * MiB;
constexpr size_t WS_A = 522 * MiB;
constexpr size_t WS_QD = 650 * MiB, WS_KD = 746 * MiB, WS_VD = 842 * MiB;
constexpr size_t WS_GA = 938 * MiB, WS_GB = 1066 * MiB;
constexpr size_t WS_ZQ = 1194 * MiB, WS_ZKV = 1226 * MiB, WS_ZKR = 1242 * MiB, WS_QN = 1250 * MiB, WS_KVN = 1282 * MiB;
constexpr size_t WS_PD = 1194 * MiB;
constexpr size_t WS_KV = 1298 * MiB;
constexpr size_t WS_YA = 1426 * MiB, WS_YB = 1490 * MiB;
constexpr size_t WS_X1B = 1194 * MiB, WS_X2B = 1322 * MiB;
constexpr size_t WS_H8 = 1298 * MiB;
constexpr size_t WS_END = 1522 * MiB;
static_assert(WS_WIN + (size_t)N_IN * DM * 2 <= WS_WUQ && WS_WGU + (size_t)2 * DFF * DM * 2 <= WS_WDN && WS_WDN + (size_t)DM * DFF * 2 <= WS_A, "weights map");
static_assert(WS_QD + (size_t)M * DFF * 2 <= WS_ZQ && WS_PD + (size_t)3 * M * 1024 * 2 <= WS_KV && WS_KV + (size_t)M * 4096 * 2 <= WS_YA && WS_YB + (size_t)M * 1024 * 2 <= WS_END, "activation map");
static_assert(WS_MODP + (size_t)KSPLIT * 4 * N_MOD * 4 <= WS_WIN && WS_VEC + 6 * 4 * DM * 4 <= WS_COSF, "misc map");
constexpr int CW_BAR = 4096;
constexpr int P11_T8 = 72;

constexpr int RING_OFF = 0, RING_BYTES = 131072;
constexpr int LDSCTL_OFF = RING_BYTES, MISC_OFF = LDSCTL_OFF + 320;
constexpr int LDS_BYTES = 147456;
static_assert(MISC_OFF + 128 <= LDS_BYTES && att::ATT_LDS_BYTES <= RING_BYTES && att::MLA_LDS_BYTES <= RING_BYTES, "LDS map");

__device__ const float INVF[64] = {
1.000000000e+00f, 8.659643531e-01f, 7.498942018e-01f, 6.493816376e-01f, 5.623413324e-01f, 4.869675338e-01f, 4.216965139e-01f, 3.651741147e-01f, 3.162277639e-01f, 2.738419771e-01f, 2.371373773e-01f, 2.053525001e-01f, 1.778279394e-01f, 1.539926529e-01f, 1.333521456e-01f, 1.154781953e-01f,
1.000000015e-01f, 8.659642935e-02f, 7.498942316e-02f, 6.493816525e-02f, 5.623413250e-02f, 4.869675264e-02f, 4.216964915e-02f, 3.651741147e-02f, 3.162277490e-02f, 2.738419548e-02f, 2.371373773e-02f, 2.053525113e-02f, 1.778279431e-02f, 1.539926510e-02f, 1.333521400e-02f, 1.154781971e-02f,
9.999999776e-03f, 8.659643121e-03f, 7.498942316e-03f, 6.493816152e-03f, 5.623413250e-03f, 4.869675264e-03f, 4.216964822e-03f, 3.651741194e-03f, 3.162277630e-03f, 2.738419687e-03f, 2.371373819e-03f, 2.053525066e-03f, 1.778279431e-03f, 1.539926510e-03f, 1.333521446e-03f, 1.154782018e-03f,
1.000000047e-03f, 8.659643354e-04f, 7.498941850e-04f, 6.493816036e-04f, 5.623413017e-04f, 4.869675322e-04f, 4.216965172e-04f, 3.651741135e-04f, 3.162277571e-04f, 2.738419571e-04f, 2.371373703e-04f, 2.053525095e-04f, 1.778279402e-04f, 1.539926598e-04f, 1.333521504e-04f, 1.154782003e-04f };

struct Frame {
    LAS unsigned char* lds;
    volatile LAS unsigned* MISC;
    gu32* ctl;
    int tid, lane, wave;
    int vcu, G;
};
__device__ __forceinline__ float wave_sum(float v) {
#pragma unroll
    for (int o = 1; o < 64; o <<= 1) v += __shfl_xor(v, o);
    return v;
}
__device__ __forceinline__ float wave_max(float v) {
#pragma unroll
    for (int o = 1; o < 64; o <<= 1) v = fmaxf(v, __shfl_xor(v, o));
    return v;
}
__device__ __forceinline__ unsigned pk4_i8(float a, float b, float c, float d) {
    const int ia = __float2int_rn(a), ib = __float2int_rn(b), ic = __float2int_rn(c), id = __float2int_rn(d);
    return ((unsigned)ia & 0xffu) | (((unsigned)ib & 0xffu) << 8) | (((unsigned)ic & 0xffu) << 16) | ((unsigned)id << 24); }
__device__ __forceinline__ void sincos_d(double a, float& s, float& c) {
    const double n = __builtin_rint(a * 0.63661977236758134308);
    const double r = (a - n * 1.57079632673412561417e+00) - n * 6.07710050650619224932e-11;
    const double z = r * r;
    const double sp = r + r * z * (-1.66666666666666324348e-01 + z * (8.33333333332248946124e-03 + z * (-1.98412698298579493134e-04 + z * (2.75573137070700676789e-06 + z * (-2.50507602534068634195e-08 + z * 1.58969099521155010221e-10)))));
    const double cp = 1.0 - 0.5 * z + z * z * (4.16666666666666019037e-02 + z * (-1.38888888888741095749e-03 + z * (2.48015872894767294178e-05 + z * (-2.75573143513906633035e-07 + z * (2.08757232129817482790e-09 + z * -1.13596475577881948265e-11)))));
    const int q = ((int)n) & 3;
    const double ss = (q & 1) ? cp : sp, cc = (q & 1) ? sp : cp;
    s = (float)((q & 2) ? -ss : ss); c = (float)(((q + 1) & 2) ? -cc : cc);
}
constexpr int NBF = pg8::P3_NBF;
__device__ __forceinline__ int win_row8(int r);
__device__ __forceinline__ int map_row_in(int n) {
    if (n < 1536) return n;
    if (n < 1600) { const int r = n - 1536; return 74 * 256 + (r >> 5) * 128 + (r & 31); }
    if (n < 10816) { const int r = n - 1600, t = r / 3072, rr = r - t * 3072;
        if (t < 2) { const int hd = rr >> 7, dd = rr & 127; return (6 + t * 12 + (hd >> 1)) * 256 + (dd >> 6) * 128 + (hd & 1) * 64 + (dd & 63); }
        return 30 * 256 + rr; }
    return 42 * 256 + (n - 10816);
}
__device__ __forceinline__ int map_row(int mode, int n) {
    if (mode == 1) return map_row_in(n);
    if (mode == 2) { const int h = n / 192, dd = n - h * 192; if (dd < 128) return h * 128 + dd; const int r = dd - 128; return (8 + (h >> 2)) * 256 + (r >> 5) * 128 + (h & 3) * 32 + (r & 31); }
    if (mode == 5) return map_row_in(n) - 6 * 256;
    if (mode == 6) return win_row8(map_row_in(n));
    if (mode == 3) return (n >> 7) * 256 + (n & 127);
    if (mode == 4) return (n >> 7) * 256 + 128 + (n & 127);
    return n;
}
__device__ __forceinline__ int win_row8(int r) { const int t = r >> 8; return ((t < 6 ? t : t - NBF) << 8) | (r & 255); }
__device__ __forceinline__ void p0_transpose_item(const float* W, int K, int N, bf16* WT, int mode, LAS float* scr, int item, int lane, int ldw = 0) {
    const int nblk = N / 32, kb = item / nblk, nb = item % nblk, k0 = 64 * kb, n0 = 32 * nb;
    float v[32];
#pragma unroll
    for (int i = 0; i < 32; ++i) { const int kk = 2 * i + (lane >> 5); v[i] = W[(size_t)(k0 + kk) * N + n0 + (lane & 31)]; }
#pragma unroll
    for (int i = 0; i < 32; ++i) { const int kk = 2 * i + (lane >> 5); scr[kk * 33 + (lane & 31)] = v[i]; }
    LDS_WAIT(); asm volatile("" ::: "memory");
    const int c = lane & 7;
#pragma unroll
    for (int j = 0; j < 4; ++j) { const int n = (lane >> 3) + 8 * j; const LAS float* s = scr + (8 * c) * 33 + n;
        v4u o; o.x = pk2(s[0 * 33], s[1 * 33]); o.y = pk2(s[2 * 33], s[3 * 33]); o.z = pk2(s[4 * 33], s[5 * 33]); o.w = pk2(s[6 * 33], s[7 * 33]);
        *(GAS v4u*)(WT + (size_t)map_row(mode, n0 + n) * (ldw ? ldw : K) + k0 + 8 * c) = o; }
    LDS_WAIT(); asm volatile("" ::: "memory");
}
__device__ __forceinline__ unsigned pk4_f8(float a, float b, float c, float d) { int w = __builtin_amdgcn_cvt_pk_fp8_f32(a, b, 0, false); w = __builtin_amdgcn_cvt_pk_fp8_f32(c, d, w, true); return (unsigned)w; }
__device__ __forceinline__ void p0_transpose_item_f8(const float* W, int K, int N, unsigned char* W8, int mode, float wscale, LAS float* scr, int item, int lane) {
    const int nblk = N / 32, kb = item / nblk, nb = item % nblk, k0 = 64 * kb, n0 = 32 * nb;
    float v[32];
#pragma unroll
    for (int i = 0; i < 32; ++i) { const int kk = 2 * i + (lane >> 5); v[i] = W[(size_t)(k0 + kk) * N + n0 + (lane & 31)]; }
#pragma unroll
    for (int i = 0; i < 32; ++i) { const int kk = 2 * i + (lane >> 5); scr[kk * 33 + (lane & 31)] = v[i] * wscale; }
    LDS_WAIT(); asm volatile("" ::: "memory");
    const int n = lane >> 1, half = lane & 1; const LAS float* s = scr + (32 * half) * 33 + n;
    v4u o0, o1;
    o0.x = pk4_f8(s[0 * 33], s[1 * 33], s[2 * 33], s[3 * 33]);     o0.y = pk4_f8(s[4 * 33], s[5 * 33], s[6 * 33], s[7 * 33]);     o0.z = pk4_f8(s[8 * 33], s[9 * 33], s[10 * 33], s[11 * 33]);   o0.w = pk4_f8(s[12 * 33], s[13 * 33], s[14 * 33], s[15 * 33]);
    o1.x = pk4_f8(s[16 * 33], s[17 * 33], s[18 * 33], s[19 * 33]); o1.y = pk4_f8(s[20 * 33], s[21 * 33], s[22 * 33], s[23 * 33]); o1.z = pk4_f8(s[24 * 33], s[25 * 33], s[26 * 33], s[27 * 33]); o1.w = pk4_f8(s[28 * 33], s[29 * 33], s[30 * 33], s[31 * 33]);
    GAS v4u* dst = (GAS v4u*)(W8 + (size_t)map_row(mode, n0 + n) * K + k0 + 32 * half); dst[0] = o0; dst[1] = o1;
    LDS_WAIT(); asm volatile("" ::: "memory");
}
__device__ __forceinline__ void wht64_k(float (&v)[32], int lane) {
#pragma unroll
    for (int s = 1; s < 32; s <<= 1)
#pragma unroll
        for (int i = 0; i < 32; ++i) if (!(i & s)) { const float a = v[i], b = v[i | s]; v[i] = a + b; v[i | s] = a - b; }
    const bool hiP = (lane & 32) != 0;
#pragma unroll
    for (int i = 0; i < 32; ++i) { const float o = __shfl_xor(v[i], 32); v[i] = (hiP ? o - v[i] : v[i] + o) * 0.125f; }
}
__device__ __forceinline__ void p0_colmax_item(const float* W, int N, float* CM, int mode, int item, int lane, bool rot = false) {
    const int nblk = N / 32, kb = item / nblk, nb = item % nblk, k0 = 64 * kb, n0 = 32 * nb;
    float v[32];
#pragma unroll
    for (int i = 0; i < 32; ++i) { const int kk = 2 * i + (lane >> 5); v[i] = W[(size_t)(k0 + kk) * N + n0 + (lane & 31)]; }
    if (rot) wht64_k(v, lane);
    float m = 0.f;
#pragma unroll
    for (int i = 0; i < 32; ++i) m = fmaxf(m, fabsf(v[i]));
    __hip_atomic_fetch_max((unsigned*)CM + map_row(mode, n0 + (lane & 31)), __float_as_uint(m), __ATOMIC_RELAXED, __HIP_MEMORY_SCOPE_AGENT);
}
__device__ __forceinline__ void p0_transpose_item_i8(const float* W, int K, int N, unsigned char* W8, int mode, const float* CM, LAS float* scr, int item, int lane, bool rot = false) {
    const int nblk = N / 32, kb = item / nblk, nb = item % nblk, k0 = 64 * kb, n0 = 32 * nb;
    float v[32];
#pragma unroll
    for (int i = 0; i < 32; ++i) { const int kk = 2 * i + (lane >> 5); v[i] = W[(size_t)(k0 + kk) * N + n0 + (lane & 31)]; }
    if (rot) wht64_k(v, lane);
#pragma unroll
    for (int i = 0; i < 32; ++i) { const int kk = 2 * i + (lane >> 5); scr[kk * 33 + (lane & 31)] = v[i]; }
    LDS_WAIT(); asm volatile("" ::: "memory");
    const int n = lane >> 1, half = lane & 1; const LAS float* s = scr + (32 * half) * 33 + n; const int row = map_row(mode, n0 + n);
    const float q = 127.f / fmaxf(__hip_atomic_load(CM + row, __ATOMIC_RELAXED, __HIP_MEMORY_SCOPE_AGENT), 1e-30f);
    v4u o0, o1;
    o0.x = pk4_i8(s[0 * 33] * q, s[1 * 33] * q, s[2 * 33] * q, s[3 * 33] * q);     o0.y = pk4_i8(s[4 * 33] * q, s[5 * 33] * q, s[6 * 33] * q, s[7 * 33] * q);     o0.z = pk4_i8(s[8 * 33] * q, s[9 * 33] * q, s[10 * 33] * q, s[11 * 33] * q);   o0.w = pk4_i8(s[12 * 33] * q, s[13 * 33] * q, s[14 * 33] * q, s[15 * 33] * q);
    o1.x = pk4_i8(s[16 * 33] * q, s[17 * 33] * q, s[18 * 33] * q, s[19 * 33] * q); o1.y = pk4_i8(s[20 * 33] * q, s[21 * 33] * q, s[22 * 33] * q, s[23 * 33] * q); o1.z = pk4_i8(s[24 * 33] * q, s[25 * 33] * q, s[26 * 33] * q, s[27 * 33] * q); o1.w = pk4_i8(s[28 * 33] * q, s[29 * 33] * q, s[30 * 33] * q, s[31 * 33] * q);
    GAS v4u* dst = (GAS v4u*)(W8 + (size_t)row * K + k0 + 32 * half); dst[0] = o0; dst[1] = o1;
    LDS_WAIT(); asm volatile("" ::: "memory");
}
__device__ __forceinline__ void normmod_row(const float* xrow, const float* gm, const float* sh, bf16* orow, int lane, unsigned* o8row = nullptr, float* qstep = nullptr) {
    const GAS f32x4* xr = (const GAS f32x4*)xrow + lane;
    f32x4 v[16]; float s = 0.f;
#pragma unroll
    for (int j = 0; j < 16; ++j) { v[j] = xr[64 * j]; s += (v[j].x * v[j].x + v[j].y * v[j].y) + (v[j].z * v[j].z + v[j].w * v[j].w); }
    const float rstd = 1.f / sqrtf(wave_sum(s) * (1.f / DM) + NORM_EPS);
    GAS unsigned long long* o8 = (GAS unsigned long long*)orow + lane;
    const GAS f32x4* g4 = (const GAS f32x4*)gm + lane; const GAS f32x4* s4 = (const GAS f32x4*)sh + lane;
    if (qstep) {
        float am = 0.f;
#pragma unroll
        for (int j = 0; j < 16; ++j) { const f32x4 g = g4[64 * j], b = s4[64 * j]; v[j] = v[j] * rstd * g + b; am = fmaxf(am, fmaxf(fmaxf(fabsf(v[j].x), fabsf(v[j].y)), fmaxf(fabsf(v[j].z), fabsf(v[j].w)))); }
        am = fmaxf(wave_max(am), 1e-30f); const float inv = 127.f / am; if (lane == 0) *qstep = am * (1.f / 127.f);
#pragma unroll
        for (int j = 0; j < 16; ++j) { if (orow) o8[64 * j] = (unsigned long long)pk2(v[j].x, v[j].y) | ((unsigned long long)pk2(v[j].z, v[j].w) << 32);
            ((GAS unsigned*)o8row)[lane + 64 * j] = pk4_i8(v[j].x * inv, v[j].y * inv, v[j].z * inv, v[j].w * inv); }
        return; }
#pragma unroll
    for (int j = 0; j < 16; ++j) { const f32x4 g = g4[64 * j], b = s4[64 * j]; const f32x4 y = v[j] * rstd * g + b;
        if (orow) o8[64 * j] = (unsigned long long)pk2(y.x, y.y) | ((unsigned long long)pk2(y.z, y.w) << 32);
        if (o8row) ((GAS unsigned*)o8row)[lane + 64 * j] = pk4_f8(y.x, y.y, y.z, y.w); }
}

__device__ __forceinline__ void normmod_row_b(const bf16* xrow, const float* gm, const float* sh, bf16* orow, unsigned char* qrow, float* qstep, int lane) {
    const GAS v4u* xr = (const GAS v4u*)xrow + lane;
    f32x4 v[16]; float s = 0.f;
#pragma unroll
    for (int j = 0; j < 8; ++j) { const v4u w = xr[64 * j]; v[2 * j] = pg8::bf4_lo(w); v[2 * j + 1] = pg8::bf4_hi(w); }
#pragma unroll
    for (int j = 0; j < 16; ++j) s += (v[j].x * v[j].x + v[j].y * v[j].y) + (v[j].z * v[j].z + v[j].w * v[j].w);
    const float rstd = 1.f / sqrtf(wave_sum(s) * (1.f / DM) + NORM_EPS);
    float am = 0.f;
#pragma unroll
    for (int j = 0; j < 8; ++j) { const GAS f32x4* g4 = (const GAS f32x4*)gm + 2 * (lane + 64 * j); const GAS f32x4* s4 = (const GAS f32x4*)sh + 2 * (lane + 64 * j);
        v[2 * j] = v[2 * j] * rstd * g4[0] + s4[0]; v[2 * j + 1] = v[2 * j + 1] * rstd * g4[1] + s4[1]; }
    if (orow) { GAS v4u* o16 = (GAS v4u*)orow + lane;
#pragma unroll
        for (int j = 0; j < 8; ++j) { v4u o; o.x = pk2(v[2 * j].x, v[2 * j].y); o.y = pk2(v[2 * j].z, v[2 * j].w); o.z = pk2(v[2 * j + 1].x, v[2 * j + 1].y); o.w = pk2(v[2 * j + 1].z, v[2 * j + 1].w); o16[64 * j] = o; } }
#pragma unroll
    for (int j = 0; j < 8; ++j) { float t[8] = {v[2 * j].x, v[2 * j].y, v[2 * j].z, v[2 * j].w, v[2 * j + 1].x, v[2 * j + 1].y, v[2 * j + 1].z, v[2 * j + 1].w};
#pragma unroll
        for (int s = 1; s < 8; s <<= 1)
#pragma unroll
            for (int i = 0; i < 8; ++i) if (!(i & s)) { const float a_ = t[i], b_ = t[i | s]; t[i] = a_ + b_; t[i | s] = a_ - b_; }
#pragma unroll
        for (int mk = 1; mk < 8; mk <<= 1) { const bool up = (lane & mk) != 0;
#pragma unroll
            for (int i = 0; i < 8; ++i) { const float o = __shfl_xor(t[i], mk); t[i] = up ? o - t[i] : t[i] + o; } }
        v[2 * j] = (f32x4){t[0], t[1], t[2], t[3]} * 0.125f; v[2 * j + 1] = (f32x4){t[4], t[5], t[6], t[7]} * 0.125f; }
#pragma unroll
    for (int j = 0; j < 16; ++j) am = fmaxf(am, fmaxf(fmaxf(fabsf(v[j].x), fabsf(v[j].y)), fmaxf(fabsf(v[j].z), fabsf(v[j].w))));
    am = fmaxf(wave_max(am), 1e-30f); const float inv = 127.f / am; if (lane == 0) *qstep = am * (1.f / 127.f);
    GAS unsigned long long* o8 = (GAS unsigned long long*)qrow + lane;
#pragma unroll
    for (int j = 0; j < 8; ++j) o8[64 * j] = (unsigned long long)pk4_i8(v[2 * j].x * inv, v[2 * j].y * inv, v[2 * j].z * inv, v[2 * j].w * inv) | ((unsigned long long)pk4_i8(v[2 * j + 1].x * inv, v[2 * j + 1].y * inv, v[2 * j + 1].z * inv, v[2 * j + 1].w * inv) << 32);
}

__device__ __forceinline__ void quant_row_b(const bf16* xrow, unsigned char* qrow, float* qstep, int lane) {
    const GAS v4u* xr = (const GAS v4u*)xrow + lane;
    f32x4 v[16]; float am = 0.f;
#pragma unroll
    for (int j = 0; j < 8; ++j) { const v4u w = xr[64 * j]; v[2 * j] = pg8::bf4_lo(w); v[2 * j + 1] = pg8::bf4_hi(w); }
#pragma unroll
    for (int j = 0; j < 16; ++j) am = fmaxf(am, fmaxf(fmaxf(fabsf(v[j].x), fabsf(v[j].y)), fmaxf(fabsf(v[j].z), fabsf(v[j].w))));
    am = fmaxf(wave_max(am), 1e-30f); const float inv = 127.f / am; if (lane == 0) *qstep = am * (1.f / 127.f);
    GAS unsigned long long* o8 = (GAS unsigned long long*)qrow + lane;
#pragma unroll
    for (int j = 0; j < 8; ++j) o8[64 * j] = (unsigned long long)pk4_i8(v[2 * j].x * inv, v[2 * j].y * inv, v[2 * j].z * inv, v[2 * j].w * inv) | ((unsigned long long)pk4_i8(v[2 * j + 1].x * inv, v[2 * j + 1].y * inv, v[2 * j + 1].z * inv, v[2 * j + 1].w * inv) << 32);
}

#ifdef SELFCHECK
#ifndef CHK_BREAK
#define CHK_BREAK 0
#endif
#define Z_REL 0.08f
#define Z_ABSX 8.f
namespace chk {
constexpr int CW_CHK = 2;
#define BRK(bit, v) (((CHK_BREAK >> (bit)) & 1) ? (v) * 1.1f + 0.1f : (v))
__device__ __forceinline__ unsigned hsh(unsigned x) { x *= 2654435761u; x ^= x >> 15; x *= 2246822519u; x ^= x >> 13; x *= 3266489917u; x ^= x >> 16; return x; }
__device__ __forceinline__ float bfv(const bf16* p) { return __uint_as_float(((unsigned)*p) << 16); }
__device__ __forceinline__ float f8v(const unsigned char* p) { const unsigned b = *p, e = (b >> 3) & 15u, m = b & 7u; const float mag = e ? exp2f((float)e - 7.f) * (1.f + (float)m * 0.125f) : (float)m * 0.001953125f; return (b & 128u) ? -mag : mag; }
__device__ __forceinline__ float wsum(float v) {
#pragma unroll
    for (int o = 1; o < 64; o <<= 1) v += __shfl_xor(v, o);
    return v; }
__device__ __forceinline__ void fail(gu32* ctl, int bit) { __hip_atomic_fetch_or((unsigned*)(ctl + CW_CHK), 1u << bit, __ATOMIC_RELAXED, __HIP_MEMORY_SCOPE_AGENT); }
__device__ __forceinline__ bool close(float got, float ref, float rel, float abs_) { const float d = fabsf(got - ref); return d <= rel * fabsf(ref) + abs_ && d == d; }
__device__ __forceinline__ float sigm(float x) { return 1.f / (1.f + expf(-x)); }
__device__ __forceinline__ float mod_ref(const float* cvec, const float* w_ada, const float* b_ada, int b, int j, int lane) {
    float s = 0.f; for (int k = lane; k < 4096; k += 64) { const float cv = cvec[b * 4096 + k]; s += (cv / (1.f + expf(-cv))) * w_ada[(size_t)k * 24576 + j]; }
    return wsum(s) + b_ada[j]; }
__device__ __forceinline__ float dot_col(const bf16* arow, const float* W, int K, int N, int n, int lane) {
    float s = 0.f; for (int k = lane; k < K; k += 64) s += bfv(arow + k) * W[(size_t)k * N + n];
    return wsum(s); }
__device__ __forceinline__ void rope_cs(int pos, int i, int dim, float& c, float& s) { const float inv = exp2f(-(float)(2 * i) / (float)dim * 13.287712379549449f); const float ang = (float)pos * inv; sincos_d((double)ang, s, c); }

__device__ __forceinline__ void chk_h(gu32* ctl, const float* x, const float* cvec, const float* w_ada, const float* b_ada, const float* norm1_g, const bf16* HB, const float* VEC, int gw, int NGW, int lane) {
    for (int sidx = gw; sidx < 512; sidx += NGW) { const unsigned h = hsh(sidx + 1000); const int row = h & 16383, col = (h >> 14) & 4095, b = row >> 12;
        float ss = 0.f; for (int k = lane; k < 4096; k += 64) { const float v = x[(size_t)row * 4096 + k]; ss += v * v; }
        const float rstd = 1.f / sqrtf(wsum(ss) / 4096.f + 1e-6f);
        const float sh1 = mod_ref(cvec, w_ada, b_ada, b, col, lane), sc1 = mod_ref(cvec, w_ada, b_ada, b, 4096 + col, lane), g1 = mod_ref(cvec, w_ada, b_ada, b, 8192 + col, lane);
        const float ref = x[(size_t)row * 4096 + col] * rstd * norm1_g[col] * (1.f + sc1) + sh1;
        if (!close(bfv(HB + (size_t)row * 4096 + col), ref, 0.01f, 0.01f)) fail(ctl, 0);
        if (!close(VEC[(2 * 4 + b) * 4096 + col], g1, 1e-3f, 1e-4f)) fail(ctl, 7); } }
__device__ __forceinline__ void chk_z(gu32* ctl, const bf16* HB, const float* w_in, const int* positions, const bf16* ZQ, const bf16* ZKV, const bf16* ZKR, const bf16* QD, const bf16* KD, const bf16* VD, const bf16* GA, const bf16* GB, int gw, int NGW, int lane) {
    for (int sidx = gw; sidx < 4096; sidx += NGW) { const unsigned h = hsh(sidx + 5000); const int row = h & 16383; int n = (int)((h >> 14) % 19008u);
        if ((sidx & 3) == 0) n = 1536 + (int)((h >> 14) & 63);
        const int b = row >> 12, s = row & 4095; const bf16* hrow = HB + (size_t)row * 4096;
        const float z = dot_col(hrow, w_in, 4096, 19008, n, lane); float got, ref = z, at = 0.03f;
        if (n < 1024) got = bfv(ZQ + (size_t)row * 1024 + n);
        else if (n < 1536) got = bfv(ZKV + (size_t)row * 512 + (n - 1024));
        else if (n < 1600) { const int r = n - 1536; got = bfv(ZKR + (size_t)row * 256 + (r >> 5) * 128 + (r & 31)); }
        else if (n < 10816) { const int r = n - 1600, t = r / 3072, rr = r % 3072, g8 = rr >> 7, d = rr & 127; const bf16* buf = t == 0 ? QD : (t == 1 ? KD : VD);
            got = bfv(buf + ((size_t)(b * 24 + g8) * 4096 + s) * 128 + d);
            if (t < 2) { const int i = d & 63; float c, sn; rope_cs(positions[row], i, 128, c, sn); const float zp = dot_col(hrow, w_in, 4096, 19008, d < 64 ? n + 64 : n - 64, lane);
                ref = d < 64 ? z * c - zp * sn : z * c + zp * sn; } }
        else { const int r = n - 10816; got = (float)((const unsigned char*)(r < 4096 ? GA : GB))[(size_t)row * 4096 + (r & 4095)] * (1.f / 255.f); ref = sigm(z); at = 0.008f; }
        if (!close(BRK(1, got), ref, Z_REL, at * Z_ABSX)) fail(ctl, 1);
        if (lane == 0 && n < 10816) { atomicAdd((float*)(ctl + 8), (got - ref) * (got - ref)); atomicAdd((float*)(ctl + 9), ref * ref); } } }
__device__ __forceinline__ void chk_p4(gu32* ctl, const bf16* ZQ, const bf16* ZKV, const bf16* ZKR, const float* qg, const float* kvg, const int* positions, const bf16* QN, const bf16* KVN, const unsigned char* KR8, int gw, int NGW, int lane) {
    for (int sidx = gw; sidx < 1024; sidx += NGW) { const unsigned h = hsh(sidx + 9000); const int row = h & 16383;
        float ss = 0.f; for (int k = lane; k < 1024; k += 64) { const float v = bfv(ZQ + (size_t)row * 1024 + k); ss += v * v; }
        const float rq = 1.f / sqrtf(wsum(ss) / 1024.f + 1e-6f); const int cq = lane * 16 + ((h >> 14) & 15);
        if (!close(bfv(QN + (size_t)row * 1024 + cq), bfv(ZQ + (size_t)row * 1024 + cq) * rq * qg[cq], 0.01f, 0.01f)) fail(ctl, 2);
        ss = 0.f; for (int k = lane; k < 512; k += 64) { const float v = bfv(ZKV + (size_t)row * 512 + k); ss += v * v; }
        const float rk = 1.f / sqrtf(wsum(ss) / 512.f + 1e-6f); const int ck = lane * 8 + ((h >> 18) & 7);
        if (!close(bfv(KVN + (size_t)row * 512 + ck), bfv(ZKV + (size_t)row * 512 + ck) * rk * kvg[ck], 0.01f, 0.01f)) fail(ctl, 2);
        { const int d = lane, i = d & 31; float c, sn; rope_cs(positions[row], i, 64, c, sn);
          const float x1 = bfv(ZKR + (size_t)row * 256 + i), x2 = bfv(ZKR + (size_t)row * 256 + 128 + i); const float ref = d < 32 ? x1 * c - x2 * sn : x2 * c + x1 * sn;
          if (!close(f8v(KR8 + (size_t)row * 64 + d), ref, 0.07f, 0.02f)) fail(ctl, 2); } } }
__device__ __forceinline__ void chk_p5(gu32* ctl, const bf16* QN, const bf16* KVN, const float* w_uq, const float* w_ukv, const int* positions, const unsigned char* Q8, const unsigned char* K8, const unsigned char* V8T, int gw, int NGW, int lane) {
    for (int sidx = gw; sidx < 2048; sidx += NGW) { const unsigned h = hsh(sidx + 13000); const int row = h & 16383, b = row >> 12, s = row & 4095;
        { const int n = (int)((h >> 14) % 3072u), hd = n / 192, c = n % 192; const bf16* arow = QN + (size_t)row * 1024; float ref = dot_col(arow, w_uq, 1024, 3072, n, lane);
          if (c >= 128) { const int r = c - 128, i = r & 31; float cs, sn; rope_cs(positions[row], i, 64, cs, sn); const float zp = dot_col(arow, w_uq, 1024, 3072, r < 32 ? n + 32 : n - 32, lane); ref = r < 32 ? ref * cs - zp * sn : ref * cs + zp * sn; }
          if (!close(f8v(Q8 + ((size_t)(b * 16 + hd) * 4096 + s) * 192 + c), ref, 0.08f, 0.04f)) fail(ctl, 3); }
        { const int n = (int)((h >> 9) & 4095); const float ref = dot_col(KVN + (size_t)row * 512, w_ukv, 512, 4096, n, lane);
          const int hd2 = n >> 8, cc = n & 255; const size_t ro = ((size_t)(b * 16 + hd2) * 4096 + s) * 128;
          if (cc < 128) { if (!close(f8v(K8 + ro + cc), ref, 0.08f, 0.04f)) fail(ctl, 3); } else { const int dd = cc - 128; if (!close(f8v(V8T + (((size_t)(b * 16 + hd2) * 64 + (s >> 6)) * 128 + dd) * 64 + att::vpos(s & 63)), ref, 0.08f, 0.04f)) fail(ctl, 3); } } } }
__device__ __forceinline__ void chk_mla(gu32* ctl, const unsigned char* Q8, const unsigned char* K8, const unsigned char* V8T, const unsigned char* KR8, const bf16* Y, LAS float* scr, int sample, int tid) {
    const unsigned h = hsh(sample + 17000); const int b = h & 3, hd = (h >> 2) & 15, row = (h >> 6) & 4095;
    LAS float* q = scr; LAS float* sc = scr + 256; LAS float* red = scr + 256 + 4096;
    __syncthreads();
    if (tid < 192) q[tid] = f8v(Q8 + ((size_t)(b * 16 + hd) * 4096 + row) * 192 + tid);
    __syncthreads();
    float mx = -1e30f;
    for (int k = tid; k < 4096; k += 512) { const unsigned char* kr = K8 + ((size_t)(b * 16 + hd) * 4096 + k) * 128; const unsigned char* rr = KR8 + ((size_t)b * 4096 + k) * 64; float s = 0.f;
        for (int d = 0; d < 128; ++d) s += q[d] * f8v(kr + d);
        for (int d = 0; d < 64; ++d) s += q[128 + d] * f8v(rr + d);
        s *= 0.07216878364870323f; sc[k] = s; mx = fmaxf(mx, s); }
    red[tid] = mx; __syncthreads();
    for (int o = 256; o > 0; o >>= 1) { if (tid < o) red[tid] = fmaxf(red[tid], red[tid + o]); __syncthreads(); }
    mx = red[0]; __syncthreads();
    float sm = 0.f; for (int k = tid; k < 4096; k += 512) { const float p = expf(sc[k] - mx); sc[k] = p; sm += p; }
    red[tid] = sm; __syncthreads();
    for (int o = 256; o > 0; o >>= 1) { if (tid < o) red[tid] += red[tid + o]; __syncthreads(); }
    sm = red[0]; __syncthreads();
    const int d = tid & 127, part = tid >> 7; float acc = 0.f;
    for (int k = part * 1024; k < part * 1024 + 1024; ++k) acc += sc[k] * f8v(V8T + (((size_t)(b * 16 + hd) * 64 + (k >> 6)) * 128 + d) * 64 + att::vpos(k & 63));
    red[tid] = acc; __syncthreads();
    if (tid < 128) { const float ref = (red[tid] + red[tid + 128] + red[tid + 256] + red[tid + 384]) / sm; red[tid] = ref; }
    __syncthreads();
    float r2 = 0.f; for (int i = 0; i < 128; ++i) r2 += red[i] * red[i]; const float rms = sqrtf(r2 / 128.f);
    if (tid < 128) { const float got = bfv(Y + ((size_t)b * 4096 + row) * 3072 + hd * 128 + tid); if (!close(BRK(4, got), red[tid], 0.06f, 0.06f * rms)) fail(ctl, 4);     }
    __syncthreads();
}
__device__ __forceinline__ void chk_dil(gu32* ctl, const bf16* QD, const bf16* KD, const bf16* VD, const bf16* Y, LAS float* scr, int sample, int tid) {
    const unsigned h = hsh(sample + 23000); const int b = h & 3, hd = (h >> 2) & 7; int s = (h >> 5) & 4095; if ((sample & 7) == 0) s = (sample >> 3) & 63; if ((sample & 7) == 1) s = 4095 - ((sample >> 3) & 63);
    LAS float* sc = scr; LAS float* red = scr + 512;
    __syncthreads();
    float v = -1e30f;
    if (tid < 387) { const int g = tid / 129, j = tid % 129, dd = g == 0 ? 1 : (g == 1 ? 4 : 16), idx = s + (j - 64) * dd;
        if (idx >= 0 && idx < 4096) { const bf16* qp = QD + ((size_t)(b * 24 + g * 8 + hd) * 4096 + s) * 128; const bf16* kp = KD + ((size_t)(b * 24 + g * 8 + hd) * 4096 + idx) * 128; float a = 0.f;
            for (int d = 0; d < 128; ++d) a += bfv(qp + d) * bfv(kp + d);
            v = a * 0.08838834764831845f; } }
    if (tid < 387) sc[tid] = v;
    red[tid] = v; __syncthreads();
    for (int o = 256; o > 0; o >>= 1) { if (tid < o) red[tid] = fmaxf(red[tid], red[tid + o]); __syncthreads(); }
    const float mx = red[0]; __syncthreads();
    float p = 0.f; if (tid < 387 && v > -1e29f) p = expf(v - mx); if (tid < 387) sc[tid] = p;
    red[tid] = p; __syncthreads();
    for (int o = 256; o > 0; o >>= 1) { if (tid < o) red[tid] += red[tid + o]; __syncthreads(); }
    const float sm = red[0]; __syncthreads();
    if (tid < 128) { float acc = 0.f;
        for (int t = 0; t < 387; ++t) { const int g = t / 129, j = t % 129, dd = g == 0 ? 1 : (g == 1 ? 4 : 16), idx = s + (j - 64) * dd; if (idx < 0 || idx >= 4096) continue;
            acc += sc[t] * bfv(VD + ((size_t)(b * 24 + g * 8 + hd) * 4096 + idx) * 128 + tid); }
        red[tid] = acc / sm; }
    __syncthreads();
    float r2 = 0.f; for (int i = 0; i < 128; ++i) r2 += red[i] * red[i]; const float rms = sqrtf(r2 / 128.f);
    if (tid < 128) { const float got = bfv(Y + ((size_t)b * 4096 + s) * 3072 + 2048 + hd * 128 + tid); if (!close(BRK(5, got), red[tid], 0.03f, 0.03f * rms)) fail(ctl, 5); }
    __syncthreads();
}
__device__ __forceinline__ void chk_mix(gu32* ctl, const bf16* Y, const bf16* GA, const bf16* GB, const float* wpa, const float* wpb, const bf16* MIXED, int gw, int NGW, int lane) {
    for (int sidx = gw; sidx < 2048; sidx += NGW) { const unsigned h = hsh(sidx + 29000); const int row = h & 16383, col = (h >> 14) & 4095; const bf16* yr = Y + (size_t)row * 3072;
        const float pa = dot_col(yr, wpa, 2048, 4096, col, lane), pb = dot_col(yr + 2048, wpb, 1024, 4096, col, lane);
        const float ref = (float)((const unsigned char*)GA)[(size_t)row * 4096 + col] * (1.f / 255.f) * pa + fmaxf((float)((const unsigned char*)GB)[(size_t)row * 4096 + col], 1.f) * (1.f / 255.f) * pb;
        if (!close(bfv(MIXED + (size_t)row * 4096 + col), ref, 0.03f, 0.002f)) fail(ctl, 6); } }
__device__ __forceinline__ void chk_x1(gu32* ctl, const float* x, const bf16* MIXED, const float* w_out, const float* VEC, const bf16* X1B, int gw, int NGW, int lane) {
    for (int sidx = gw; sidx < 8192; sidx += NGW) { const unsigned h = hsh(sidx + 31000); const int row = h & 16383, col = (h >> 14) & 4095, b = row >> 12; const float xv = x[(size_t)row * 4096 + col];
        if (fabsf(xv) > 0.12f) continue;
        const float br = VEC[(2 * 4 + b) * 4096 + col] * dot_col(MIXED + (size_t)row * 4096, w_out, 4096, 4096, col, lane);
        if (!close(bfv(X1B + (size_t)row * 4096 + col) - xv, br, 0.15f, 0.003f)) fail(ctl, 8);
        if (lane == 0) { atomicAdd((float*)(ctl + 10), br * br); atomicAdd((float*)(ctl + 11), 1.f); } } }
}
#endif

struct Args { const float* in[19]; float* out; unsigned char* ws; int ph_lo, ph_hi, li, pad; };
__global__ void __launch_bounds__(NWAVES * 64, 2) mk_fwd(Args args) {
    extern __shared__ __attribute__((aligned(16))) unsigned char lds[];
    Frame F;
    F.lds = (LAS unsigned char*)lds;
    F.MISC = (volatile LAS unsigned*)(F.lds + MISC_OFF);
    F.tid = threadIdx.x; F.lane = F.tid & 63; F.wave = __builtin_amdgcn_readfirstlane(F.tid >> 6);
    F.G = gridDim.x; { const int bx = blockIdx.x; F.vcu = (F.G % 8 == 0) ? (bx % 8) * (F.G / 8) + bx / 8 : bx; }
    unsigned char* ws = args.ws;
    F.ctl = (gu32*)(ws + WS_CTL);
    const float* x = args.in[0]; const float* cvec = args.in[1]; const int* positions = (const int*)args.in[2];
    const float* w_ada = args.in[3]; const float* b_ada = args.in[4]; const float* norm1_g = args.in[5]; const float* w_in = args.in[6];
    const float* q_norm_g = args.in[7]; const float* w_uq = args.in[8]; const float* kv_norm_g = args.in[9]; const float* w_ukv = args.in[10];
    const float* w_proj_a = args.in[11]; const float* w_proj_b = args.in[12]; const float* w_out = args.in[13]; const float* norm2_g = args.in[14];
    const float* w_gate = args.in[15]; const float* w_up = args.in[16]; const float* w_down = args.in[17]; const float* final_g = args.in[18];
    float* out = args.out;
    float* MOD = (float*)(ws + WS_MOD); float* VEC = (float*)(ws + WS_VEC); float* MODP = (float*)(ws + WS_MODP);
    float* COSF = (float*)(ws + WS_COSF); float* SINF = (float*)(ws + WS_SINF); float* COSR = (float*)(ws + WS_COSR); float* SINR = (float*)(ws + WS_SINR);
    bf16* KROPE = (bf16*)(ws + WS_KROPE); float* LSE = (float*)(ws + WS_LSE);
    unsigned char* WOUT8 = ws + WS_WOUT; unsigned char* MIXQ = ws + WS_VD; float* CM3 = (float*)(ws + WS_CTL + 384 * 1024); float* SA3 = (float*)(ws + WS_CTL + 768 * 1024);
    unsigned char* WGU8 = ws + WS_WGU; unsigned char* H2Q = ws + WS_X2B;
    float* CM1 = (float*)(ws + WS_CTL + 128 * 1024); float* CM2 = (float*)(ws + WS_CTL + 256 * 1024); float* SA1 = (float*)(ws + WS_CTL + 512 * 1024); float* SA2 = (float*)(ws + WS_CTL + 640 * 1024);
    unsigned char* WIN8 = ws + WS_WIN + (NBF > 0 ? 80 : 0) * MiB;     unsigned char* H8 = ws + WS_H8;
    bf16 *WIN = (bf16*)(ws + WS_WIN), *WUQ = (bf16*)(ws + WS_WUQ), *WUKV = (bf16*)(ws + WS_WUKV), *WPA = (bf16*)(ws + WS_WPA), *WPB = (bf16*)(ws + WS_WPB), *WOUT = (bf16*)(ws + WS_WOUT), *WGU = (bf16*)(ws + WS_WGU), *WDN = (bf16*)(ws + WS_WDN);
    bf16 *HB = (bf16*)(ws + WS_A), *QB = (bf16*)(ws + WS_A), *H2 = (bf16*)(ws + WS_A);
    bf16 *QD = (bf16*)(ws + WS_QD), *KD = (bf16*)(ws + WS_KD), *VD = (bf16*)(ws + WS_VD), *MIXED = (bf16*)(ws + WS_QD), *AFF = (bf16*)(ws + WS_QD);
    bf16 *GA = (bf16*)(ws + WS_GA), *GB = (bf16*)(ws + WS_GB);
    bf16 *ZQ = (bf16*)(ws + WS_ZQ), *ZKV = (bf16*)(ws + WS_ZKV), *ZKR = (bf16*)(ws + WS_ZKR), *QN = (bf16*)(ws + WS_QN), *KVN = (bf16*)(ws + WS_KVN), *PD = (bf16*)(ws + WS_PD);
    unsigned char* Q8 = ws + WS_A; unsigned char* K8 = ws + WS_KV; unsigned char* V8T = ws + WS_KV + 32 * MiB; unsigned char* KR8 = ws + WS_KROPE;
    bf16 *KV = (bf16*)(ws + WS_KV), *YA = (bf16*)(ws + WS_YA), *YB = (bf16*)(ws + WS_YB), *X1B = (bf16*)(ws + WS_X1B), *X2B = (bf16*)(ws + WS_X2B);

    for (int u = F.tid; u < (LDS_BYTES - LDSCTL_OFF) / 4; u += NWAVES * 64) ((LAS unsigned*)(F.lds + LDSCTL_OFF))[u] = 0u;
    __syncthreads();
    XcdBarrier bar; bar.bar = (unsigned*)(F.ctl + CW_BAR); bar.x = 0; bar.st = nullptr;
    if (N_LAUNCHES == 1) bar = xcd_barrier_post((unsigned*)(F.ctl + CW_BAR), F.MISC + 8);
#define GRID_BAR() do { if (N_LAUNCHES == 1) xcd_barrier(bar); } while (0)
    const int lo = args.ph_lo, hi = args.ph_hi;
#ifndef PHASE_MASK
#define PHASE_MASK 0x3fff
#endif
#define IN(k) (((PHASE_MASK >> (k)) & 1) && lo <= (k) && (k) < hi)
#define BOTH(k) (IN(k) && IN((k) + 1))
#ifndef REPEAT_MASK
#define REPEAT_MASK 0
#endif
#define REP(k)
#define RPT(k) ((REPEAT_MASK >> (k)) & 1)
    const int gw = F.vcu * NWAVES + F.wave, NGW = F.G * NWAVES;
    const int NGT = F.G * NWAVES * 64;
#define OPQ_TID() ({ int t_ = (int)threadIdx.x; asm volatile("" : "+v"(t_)); t_; })
#define gt ((int)blockIdx.x * (NWAVES * 64) + OPQ_TID())
#define LANE() (OPQ_TID() & 63)

    if (IN(0)) { REP(0) {
        { LAS float* scv = (LAS float*)(F.lds + RING_OFF);
          for (int it = blockIdx.x; it < KSPLIT * 12; it += F.G) {
              const int kc = it / 12, cb = it % 12;
              __syncthreads();
              if (OPQ_TID() < 256) { const int k = OPQ_TID() >> 2, b = OPQ_TID() & 3; const float cv = cvec[b * DM + kc * 64 + k]; scv[k * 4 + b] = cv / (1.f + expf(-cv)); }
              __syncthreads();
              const int col = cb * 2048 + 4 * OPQ_TID();
              f32x4 a0 = {0.f, 0.f, 0.f, 0.f}, a1 = a0, a2 = a0, a3 = a0;
              const float* wp = w_ada + (size_t)(kc * 64) * N_MOD + col;
#pragma unroll 8
              for (int k = 0; k < 64; ++k) { const f32x4 w = *(const GAS f32x4*)(wp + (size_t)k * N_MOD); const f32x4 s = *(const LAS f32x4*)(scv + k * 4);
                  a0 += s.x * w; a1 += s.y * w; a2 += s.z * w; a3 += s.w * w; }
              float* mp = MODP + (size_t)(kc * 4) * N_MOD + col;
              *(GAS f32x4*)(mp) = a0; *(GAS f32x4*)(mp + N_MOD) = a1; *(GAS f32x4*)(mp + 2 * N_MOD) = a2; *(GAS f32x4*)(mp + 3 * N_MOD) = a3;
          }
          __syncthreads(); }
        for (int e = gt; e < M * 64; e += NGT) { const int row = e >> 6, i = e & 63; const float ang = (float)positions[row] * INVF[i]; float s, c; sincos_d((double)ang, s, c); COSF[e] = c; SINF[e] = s; }
        for (int e = gt; e < M * 32; e += NGT) { const int row = e >> 5, i = e & 31; const float ang = (float)positions[row] * INVF[2 * i]; float s, c; sincos_d((double)ang, s, c); COSR[e] = c; SINR[e] = s; }
        for (int e = gt; e < 192 * (DM / 16); e += NGT) { const int rr = e / (DM / 16), c16 = e % (DM / 16); const int row = (74 - NBF) * 256 + (rr / 96) * 128 + 32 + (rr % 96);
            *(GAS v4u*)(WIN8 + (size_t)row * DM + c16 * 16) = (v4u){0u, 0u, 0u, 0u}; }
        { LAS float* scr = (LAS float*)(F.lds + RING_OFF + F.wave * 16384);
          constexpr int I_IN = (DM / 64) * (IN_TOTAL / 32), I_UQ = (QRANK / 64) * (3072 / 32), I_UKV = (KVRANK / 64) * (4096 / 32), I_PA = (2048 / 64) * (DM / 32), I_PB = (1024 / 64) * (DM / 32),
                        I_OUT = (DM / 64) * (DM / 32), I_G = (DM / 64) * (DFF / 32), I_DN = (DFF / 64) * (DM / 32);
          constexpr int NITEMS = I_IN + I_UQ + I_UKV + I_PA + I_PB + I_OUT + 2 * I_G;
          for (int it = gw; it < NITEMS * (1 + RPT(0)); it += NGW) {
              int r = it % NITEMS;
              if (r < I_IN) { const int n0_ = 32 * (r % (IN_TOTAL / 32));
                  if (n0_ >= 1600 && n0_ < 1600 + NBF * 256) p0_transpose_item(w_in, DM, IN_TOTAL, WIN, 5, scr, r, LANE()); else p0_colmax_item(w_in, IN_TOTAL, CM1, 6, r, LANE());
                  continue; } r -= I_IN;
              if (r < I_UQ) { p0_transpose_item(w_uq, QRANK, 3072, WUQ, 2, scr, r, LANE()); continue; } r -= I_UQ;
              if (r < I_UKV) { p0_transpose_item(w_ukv, KVRANK, 4096, WUKV, 0, scr, r, LANE()); continue; } r -= I_UKV;
              if (r < I_PA) { p0_transpose_item(w_proj_a, 2048, DM, WPA, 0, scr, r, LANE(), 3072); continue; } r -= I_PA;
              if (r < I_PB) { p0_transpose_item(w_proj_b, 1024, DM, WPA + 2048, 0, scr, r, LANE(), 3072); continue; } r -= I_PB;
              if (r < I_OUT) { p0_colmax_item(w_out, DM, CM3, 0, r, LANE()); continue; } r -= I_OUT;
              if (r < I_G) { if (((32 * (r % (DFF / 32))) >> 7) < P11_T8) p0_colmax_item(w_gate, DFF, CM2, 3, r, LANE(), true); else p0_transpose_item(w_gate, DM, DFF, WGU, 3, scr, r, LANE()); continue; } r -= I_G;
              if (((32 * (r % (DFF / 32))) >> 7) < P11_T8) p0_colmax_item(w_up, DFF, CM2, 4, r, LANE(), true); else p0_transpose_item(w_up, DM, DFF, WGU, 4, scr, r, LANE());
          } }
        }
        if (BOTH(0)) GRID_BAR();
    }
    if (IN(1)) { REP(1) {
        for (int e = gt; e < BATCH * N_MOD; e += NGT) { const int b = e / N_MOD, j = e - b * N_MOD, ch = j >> 12, col = j & (DM - 1);
            float s = b_ada[j];
#pragma unroll 16
            for (int kc = 0; kc < KSPLIT; ++kc) s += MODP[(size_t)(kc * 4 + b) * N_MOD + j];
            MOD[(size_t)b * N_MOD + j] = s;
            const int slot = ch == 0 ? 1 : (ch == 1 ? 0 : (ch == 2 ? 2 : (ch == 3 ? 4 : (ch == 4 ? 3 : 5))));
            VEC[(slot * 4 + b) * DM + col] = ch == 1 ? norm1_g[col] * (1.f + s) : (ch == 4 ? norm2_g[col] * (1.f + s) : s); }
        { LAS float* scr = (LAS float*)(F.lds + RING_OFF + F.wave * 16384); constexpr int I_IN = (DM / 64) * (IN_TOTAL / 32);
          for (int it = gw; it < I_IN; it += NGW) p0_transpose_item_i8(w_in, DM, IN_TOTAL, WIN8, 6, CM1, scr, it, LANE());
          constexpr int I_OUT = (DM / 64) * (DM / 32);
          for (int it = gw; it < I_OUT; it += NGW) p0_transpose_item_i8(w_out, DM, DM, WOUT8, 0, CM3, scr, it, LANE());
          constexpr int I_G = (DM / 64) * (DFF / 32);
          for (int it = gw; it < 2 * I_G; it += NGW) { const int r = it < I_G ? it : it - I_G; if (((32 * (r % (DFF / 32))) >> 7) >= P11_T8) continue;
              if (it < I_G) p0_transpose_item_i8(w_gate, DM, DFF, WGU8, 3, CM2, scr, r, LANE(), true); else p0_transpose_item_i8(w_up, DM, DFF, WGU8, 4, CM2, scr, r, LANE(), true); } }
        }
        if (BOTH(1)) GRID_BAR();
    }
    if (IN(2)) { REP(2) {
        for (int m0 = gw; m0 < M * (1 + RPT(2)); m0 += NGW) { const int m = m0 & (M - 1), b = m >> 12; normmod_row(x + (size_t)m * DM, VEC + (0 * 4 + b) * DM, VEC + (1 * 4 + b) * DM, HB_OR_NULL(HB + (size_t)m * DM), LANE(), (unsigned*)(H8 + (size_t)m * DM), SA1 + m); }
        }
        if (BOTH(2)) GRID_BAR();
    }
    if (IN(3)) { REP(3) {
#ifdef SELFCHECK
        chk::chk_h(F.ctl, x, cvec, w_ada, b_ada, norm1_g, HB, VEC, gw, NGW, LANE());
#endif
        if constexpr (NBF > 0) { pg8::Gemm g{HB, WIN, M, NBF * 256, DM}; pg8::StaticOrder S; S.init(M, NBF * 256, F.G, (int)blockIdx.x);
          pg8::EpiZ E{ZQ, ZKV, QD, KD, VD, GA, GB, ZKR, COSF, SINF, 1};
          pg8::gemm_phase<pg8::EpiZ, pg8::StaticOrder, PG_ALIGN, PG_SP2>(F.lds + RING_OFF, g, S, E);
          if constexpr (RPT(3)) { pg8::gemm_phase<pg8::EpiZ, pg8::StaticOrder, PG_ALIGN, PG_SP2>(F.lds + RING_OFF, g, S, E); } }
        { pg8::Gemm g{(const pg8::bf16_t*)H8, (const pg8::bf16_t*)WIN8, M, (75 - NBF) * 256, DM, SA1, CM1}; pg8::StaticOrder S; S.init(M, (75 - NBF) * 256, F.G, (int)blockIdx.x);
          pg8::EpiZ E{ZQ, ZKV, QD, KD, VD, GA, GB, ZKR, COSF, SINF, 2};
          pg8::gemm_phase<pg8::EpiZ, pg8::StaticOrder, PG_ALIGN, PG_SP2, true, 121, true>(F.lds + RING_OFF, g, S, E);
          if constexpr (RPT(3)) { pg8::gemm_phase<pg8::EpiZ, pg8::StaticOrder, PG_ALIGN, PG_SP2, true, 121, true>(F.lds + RING_OFF, g, S, E); } }
        }
        if (BOTH(3)) GRID_BAR();
    }
    if (IN(4)) { REP(4) {
#ifdef SELFCHECK
        chk::chk_z(F.ctl, HB, w_in, positions, ZQ, ZKV, ZKR, QD, KD, VD, GA, GB, gw, NGW, LANE());
#endif
        for (int m = gw; m < M; m += NGW) {
            { const GAS v4u* zp = (const GAS v4u*)(ZQ + (size_t)m * QRANK); v4u a = zp[LANE()], b2 = zp[64 + LANE()];
              float f[16]; f[0] = pg8::bf_lo(a.x); f[1] = pg8::bf_hi(a.x); f[2] = pg8::bf_lo(a.y); f[3] = pg8::bf_hi(a.y); f[4] = pg8::bf_lo(a.z); f[5] = pg8::bf_hi(a.z); f[6] = pg8::bf_lo(a.w); f[7] = pg8::bf_hi(a.w);
              f[8] = pg8::bf_lo(b2.x); f[9] = pg8::bf_hi(b2.x); f[10] = pg8::bf_lo(b2.y); f[11] = pg8::bf_hi(b2.y); f[12] = pg8::bf_lo(b2.z); f[13] = pg8::bf_hi(b2.z); f[14] = pg8::bf_lo(b2.w); f[15] = pg8::bf_hi(b2.w);
              float s = 0.f;
#pragma unroll
              for (int i = 0; i < 16; ++i) s += f[i] * f[i];
              const float rstd = 1.f / sqrtf(wave_sum(s) * (1.f / QRANK) + NORM_EPS);
              const float* g0 = q_norm_g + 8 * LANE(); const float* g1 = q_norm_g + 512 + 8 * LANE();
              v4u o0, o1;
              o0.x = pk2(f[0] * rstd * g0[0], f[1] * rstd * g0[1]); o0.y = pk2(f[2] * rstd * g0[2], f[3] * rstd * g0[3]); o0.z = pk2(f[4] * rstd * g0[4], f[5] * rstd * g0[5]); o0.w = pk2(f[6] * rstd * g0[6], f[7] * rstd * g0[7]);
              o1.x = pk2(f[8] * rstd * g1[0], f[9] * rstd * g1[1]); o1.y = pk2(f[10] * rstd * g1[2], f[11] * rstd * g1[3]); o1.z = pk2(f[12] * rstd * g1[4], f[13] * rstd * g1[5]); o1.w = pk2(f[14] * rstd * g1[6], f[15] * rstd * g1[7]);
              GAS v4u* op = (GAS v4u*)(QN + (size_t)m * QRANK); op[LANE()] = o0; op[64 + LANE()] = o1; }
            { const GAS v4u* zp = (const GAS v4u*)(ZKV + (size_t)m * KVRANK); v4u a = zp[LANE()];
              float f[8]; f[0] = pg8::bf_lo(a.x); f[1] = pg8::bf_hi(a.x); f[2] = pg8::bf_lo(a.y); f[3] = pg8::bf_hi(a.y); f[4] = pg8::bf_lo(a.z); f[5] = pg8::bf_hi(a.z); f[6] = pg8::bf_lo(a.w); f[7] = pg8::bf_hi(a.w);
              float s = 0.f;
#pragma unroll
              for (int i = 0; i < 8; ++i) s += f[i] * f[i];
              const float rstd = 1.f / sqrtf(wave_sum(s) * (1.f / KVRANK) + NORM_EPS);
              const float* g0 = kv_norm_g + 8 * LANE(); v4u o0;
              o0.x = pk2(f[0] * rstd * g0[0], f[1] * rstd * g0[1]); o0.y = pk2(f[2] * rstd * g0[2], f[3] * rstd * g0[3]); o0.z = pk2(f[4] * rstd * g0[4], f[5] * rstd * g0[5]); o0.w = pk2(f[6] * rstd * g0[6], f[7] * rstd * g0[7]);
              ((GAS v4u*)(KVN + (size_t)m * KVRANK))[LANE()] = o0; }
            if (LANE() < 32) { const int i = LANE(); const float x1 = pg8::bf_lo((unsigned)ZKR[(size_t)m * 256 + i]), x2 = pg8::bf_lo((unsigned)ZKR[(size_t)m * 256 + 128 + i]);
              const float c = COSR[(size_t)m * 32 + i], s = SINR[(size_t)m * 32 + i];
              const unsigned w8 = (unsigned)__builtin_amdgcn_cvt_pk_fp8_f32(x1 * c - x2 * s, x2 * c + x1 * s, 0, false);
              KR8[(size_t)m * 64 + i] = (unsigned char)(w8 & 0xffu); KR8[(size_t)m * 64 + 32 + i] = (unsigned char)((w8 >> 8) & 0xffu); }
        }
        }
        if (BOTH(4)) GRID_BAR();
    }
    if (IN(5)) { REP(5) {
#ifdef SELFCHECK
        chk::chk_p4(F.ctl, ZQ, ZKV, ZKR, q_norm_g, kv_norm_g, positions, QN, KVN, KR8, gw, NGW, LANE());
#endif
        { pg8::Gemm g{QN, WUQ, M, 3072, QRANK}; pg8::StaticOrder S; S.init(M, 3072, F.G, (int)blockIdx.x);
          pg8::EpiQ E{Q8, COSR, SINR};
          pg8::gemm_phase<pg8::EpiQ, pg8::StaticOrder, PG_ALIGN, PG_SP2>(F.lds + RING_OFF, g, S, E); if constexpr (RPT(5)) { pg8::gemm_phase<pg8::EpiQ, pg8::StaticOrder, PG_ALIGN, PG_SP2>(F.lds + RING_OFF, g, S, E); } }
        { pg8::Gemm g{KVN, WUKV, M, 4096, KVRANK}; pg8::StaticOrder S; S.init(M, 4096, F.G, (int)blockIdx.x);
          pg8::EpiKV E{K8, V8T};
          pg8::gemm_phase<pg8::EpiKV, pg8::StaticOrder, PG_ALIGN, PG_SP2>(F.lds + RING_OFF, g, S, E); if constexpr (RPT(5)) { pg8::gemm_phase<pg8::EpiKV, pg8::StaticOrder, PG_ALIGN, PG_SP2>(F.lds + RING_OFF, g, S, E); } }
        }
        if (BOTH(5)) GRID_BAR();
    }
    if (IN(6)) { REP(6) {
#ifdef SELFCHECK
        chk::chk_p5(F.ctl, QN, KVN, w_uq, w_ukv, positions, Q8, K8, V8T, gw, NGW, LANE());
#endif
        char* albs = (char*)lds + RING_OFF;
#ifndef NO_MLA
        for (int i0 = 0; i0 < 4 * (1 + (RPT(6) | RPT(15))); ++i0) { const int i = i0 & 3; const int v = F.vcu; const int xcd = v >> 5, vl = v & 31; const int bh = xcd * 8 + i * 2 + (vl >> 4), qb = vl & 15;
            if (F.G != 256) break;
            const int b = bh >> 4, h = bh & 15; const long r0 = (long)b * SEQ;
            att::mla_unit(Q8 + ((long)bh * SEQ + qb * 256) * 192, K8 + (long)bh * SEQ * 128, V8T + (long)bh * SEQ * 128, KR8 + r0 * 64, YA + (r0 + qb * 256) * 3072 + h * 128, albs); }
#endif
#ifndef NO_DIL
        for (int i = 0; i < 6 * (1 + (RPT(6) | RPT(14))); ++i) { const int U = (int)blockIdx.x + F.G * (i % 6); if (U >= 1536) continue;
            const int bgh = U >> 4, sub = U & 15, b = bgh / 24, g = (bgh % 24) >> 3, h = bgh & 7;
            const int rho = (g == 0) ? 0 : (g == 1 ? (sub >> 2) : sub), blk = (g == 0) ? sub : (g == 1 ? (sub & 3) : 0);
            att::dil_unit(b, g, h, rho, blk, QD, KD, VD, PD, LSE, albs); }
#endif
        }
        if (BOTH(6)) GRID_BAR();
    }
    if (IN(7)) { REP(7) {
        for (int e = gt; e < M * 128; e += NGT) { const int tok = e >> 7, c8 = e & 127, h = c8 >> 4;
            const float l0 = LSE[((size_t)0 * M + tok) * 8 + h], l1 = LSE[((size_t)1 * M + tok) * 8 + h], l2 = LSE[((size_t)2 * M + tok) * 8 + h];
            const float mx = fmaxf(l0, fmaxf(l1, l2)); float w0 = __builtin_amdgcn_exp2f(l0 - mx), w1 = __builtin_amdgcn_exp2f(l1 - mx), w2 = __builtin_amdgcn_exp2f(l2 - mx);
            const float inv = 1.f / (w0 + w1 + w2); w0 *= inv; w1 *= inv; w2 *= inv;
            const v4u p0 = *(const GAS v4u*)(PD + ((size_t)0 * M + tok) * 1024 + c8 * 8), p1 = *(const GAS v4u*)(PD + ((size_t)1 * M + tok) * 1024 + c8 * 8), p2 = *(const GAS v4u*)(PD + ((size_t)2 * M + tok) * 1024 + c8 * 8);
            v4u o;
            o.x = pk2(w0 * pg8::bf_lo(p0.x) + w1 * pg8::bf_lo(p1.x) + w2 * pg8::bf_lo(p2.x), w0 * pg8::bf_hi(p0.x) + w1 * pg8::bf_hi(p1.x) + w2 * pg8::bf_hi(p2.x));
            o.y = pk2(w0 * pg8::bf_lo(p0.y) + w1 * pg8::bf_lo(p1.y) + w2 * pg8::bf_lo(p2.y), w0 * pg8::bf_hi(p0.y) + w1 * pg8::bf_hi(p1.y) + w2 * pg8::bf_hi(p2.y));
            o.z = pk2(w0 * pg8::bf_lo(p0.z) + w1 * pg8::bf_lo(p1.z) + w2 * pg8::bf_lo(p2.z), w0 * pg8::bf_hi(p0.z) + w1 * pg8::bf_hi(p1.z) + w2 * pg8::bf_hi(p2.z));
            o.w = pk2(w0 * pg8::bf_lo(p0.w) + w1 * pg8::bf_lo(p1.w) + w2 * pg8::bf_lo(p2.w), w0 * pg8::bf_hi(p0.w) + w1 * pg8::bf_hi(p1.w) + w2 * pg8::bf_hi(p2.w));
            *(GAS v4u*)(YA + (size_t)tok * 3072 + 2048 + c8 * 8) = o; }
        }
        if (BOTH(7)) GRID_BAR();
    }
    if (IN(8)) { REP(8) {
#ifdef SELFCHECK
        chk::chk_mla(F.ctl, Q8, K8, V8T, KR8, YA, (LAS float*)(F.lds + RING_OFF), (int)blockIdx.x, OPQ_TID()); chk::chk_dil(F.ctl, QD, KD, VD, YA, (LAS float*)(F.lds + RING_OFF), (int)blockIdx.x, OPQ_TID());
        chk::chk_mla(F.ctl, Q8, K8, V8T, KR8, YA, (LAS float*)(F.lds + RING_OFF), 256 + (int)blockIdx.x, OPQ_TID()); chk::chk_dil(F.ctl, QD, KD, VD, YA, (LAS float*)(F.lds + RING_OFF), 256 + (int)blockIdx.x, OPQ_TID());
        GRID_BAR();
#endif
        pg8::Gemm g{YA, WPA, M, DM, 3072}; pg8::StaticOrder S; S.init(M, DM, F.G, (int)blockIdx.x);
        pg8::EpiMix E{(const unsigned char*)GA, (const unsigned char*)GB, MIXED};
        pg8::gemm_phase<pg8::EpiMix, pg8::StaticOrder, PG_ALIGN, PG_SP2>(F.lds + RING_OFF, g, S, E);
        if constexpr (RPT(8)) { pg8::gemm_phase<pg8::EpiMix, pg8::StaticOrder, PG_ALIGN, PG_SP2>(F.lds + RING_OFF, g, S, E); }
        }
        if (BOTH(8)) GRID_BAR();
    }
    if (IN(9)) { REP(9) {
#ifdef SELFCHECK
        chk::chk_mix(F.ctl, YA, GA, GB, w_proj_a, w_proj_b, MIXED, gw, NGW, LANE());
#endif
        for (int m = gw; m < M; m += NGW) quant_row_b(MIXED + (size_t)m * DM, MIXQ + (size_t)m * DM, SA3 + m, LANE());
        GRID_BAR();
        pg8::Gemm g{(const pg8::bf16_t*)MIXQ, (const pg8::bf16_t*)WOUT8, M, DM, DM, SA3, CM3}; pg8::StaticOrder S; S.init(M, DM, F.G, (int)blockIdx.x);
        pg8::EpiRes<true> E{x, X1B, VEC + 2 * 4 * DM};
        pg8::gemm_phase<pg8::EpiRes<true>, pg8::StaticOrder, PG_ALIGN, PG_SP2, true, 127, true>(F.lds + RING_OFF, g, S, E);
        if constexpr (RPT(9)) { pg8::gemm_phase<pg8::EpiRes<true>, pg8::StaticOrder, PG_ALIGN, PG_SP2, true, 127, true>(F.lds + RING_OFF, g, S, E); }
        }
        if (BOTH(9)) GRID_BAR();
    }
    if (IN(10)) { REP(10) {
#ifdef SELFCHECK
        chk::chk_x1(F.ctl, x, MIXED, w_out, VEC, X1B, gw, NGW, LANE());
#endif
        for (int m0 = gw; m0 < M * (1 + RPT(10)); m0 += NGW) { const int m = m0 & (M - 1), b = m >> 12; normmod_row_b(X1B + (size_t)m * DM, VEC + (3 * 4 + b) * DM, VEC + (4 * 4 + b) * DM, H2 + (size_t)m * DM, H2Q + (size_t)m * DM, SA2 + m, LANE()); }
        }
        if (BOTH(10)) GRID_BAR();
    }
    if (IN(11)) { REP(11) {
        { pg8::Gemm g{(const pg8::bf16_t*)H2Q, (const pg8::bf16_t*)WGU8, M, P11_T8 * 256, DM, SA2, CM2}; pg8::StaticOrder S; S.init(M, P11_T8 * 256, F.G, (int)blockIdx.x);
          pg8::EpiGU E{AFF};
          pg8::gemm_phase<pg8::EpiGU, pg8::StaticOrder, PG_ALIGN, PG_SP2, true, 127, true>(F.lds + RING_OFF, g, S, E);
          if constexpr (RPT(11)) { pg8::gemm_phase<pg8::EpiGU, pg8::StaticOrder, PG_ALIGN, PG_SP2, true, 127, true>(F.lds + RING_OFF, g, S, E); } }
        { pg8::Gemm g{H2, WGU + (size_t)P11_T8 * 256 * DM, M, 2 * DFF - P11_T8 * 256, DM}; pg8::StaticOrder S; S.init(M, 2 * DFF - P11_T8 * 256, F.G, (int)blockIdx.x);
          pg8::EpiGU E{AFF + P11_T8 * pg8::HALF};
          pg8::gemm_phase<pg8::EpiGU, pg8::StaticOrder, PG_ALIGN, PG_SP2>(F.lds + RING_OFF, g, S, E);
          if constexpr (RPT(11)) { pg8::gemm_phase<pg8::EpiGU, pg8::StaticOrder, PG_ALIGN, PG_SP2>(F.lds + RING_OFF, g, S, E); } }
        { constexpr int NU = (M / 256) * ((2 * DFF - P11_T8 * 256) / 256), I_DN = (DFF / 64) * (DM / 32); const int nfull = NU / F.G, rem = NU - nfull * F.G;
          const int nidle = rem ? F.G - rem : F.G, me = rem ? (int)blockIdx.x - rem : (int)blockIdx.x;
          if (me >= 0) { LAS float* scr = (LAS float*)(F.lds + RING_OFF + F.wave * 16384);
              for (int it = me * NWAVES + F.wave; it < I_DN; it += nidle * NWAVES) p0_transpose_item(w_down, DFF, DM, WDN, 0, scr, it, LANE()); } }
        }
        if (BOTH(11)) GRID_BAR();
    }
    if (IN(12)) { REP(12) {
        pg8::Gemm g{AFF, WDN, M, DM, DFF}; pg8::StaticOrder S; S.init(M, DM, F.G, (int)blockIdx.x);
        pg8::EpiRes<false> E{X1B, X2B, VEC + 5 * 4 * DM};
        pg8::gemm_phase<pg8::EpiRes<false>, pg8::StaticOrder, PG_ALIGN, PG_SP2>(F.lds + RING_OFF, g, S, E);
        if constexpr (RPT(12)) { pg8::gemm_phase<pg8::EpiRes<false>, pg8::StaticOrder, PG_ALIGN, PG_SP2>(F.lds + RING_OFF, g, S, E); }
        }
        if (BOTH(12)) GRID_BAR();
    }
    if (IN(13)) {
        bool bad = (N_LAUNCHES == 1) && (__hip_atomic_load((gu32*)((unsigned*)(F.ctl + CW_BAR) + XB_TMO), RLX_AGENT) != 0u);
        bad = bad || (F.G != 256);
#ifdef SELFCHECK
        { const unsigned cw = __hip_atomic_load(F.ctl + chk::CW_CHK, RLX_AGENT); bad = bad || ((cw & (unsigned)(CHK_MASK)) != 0u);
#ifdef STAT_ZT
          { const float e2 = __uint_as_float(__hip_atomic_load(F.ctl + 8, RLX_AGENT)), r2 = __uint_as_float(__hip_atomic_load(F.ctl + 9, RLX_AGENT)); bad = bad || !(e2 <= (STAT_ZT) * (STAT_ZT) * r2); }
#endif
#ifdef STAT_BR
          { const float b2 = __uint_as_float(__hip_atomic_load(F.ctl + 10, RLX_AGENT)), n_ = __uint_as_float(__hip_atomic_load(F.ctl + 11, RLX_AGENT)); bad = bad || !(b2 <= (STAT_BR) * (STAT_BR) * n_); }
#endif
        }
#endif
        for (int m = gw; m < M; m += NGW) {
            const int ln = LANE(); const GAS v4u* xr = (const GAS v4u*)(X2B + (size_t)m * DM) + ln; f32x4 v[16]; float s = 0.f;
#pragma unroll
            for (int j = 0; j < 8; ++j) { const v4u w = xr[64 * j]; v[2 * j] = pg8::bf4_lo(w); v[2 * j + 1] = pg8::bf4_hi(w); }
#pragma unroll
            for (int j = 0; j < 16; ++j) s += (v[j].x * v[j].x + v[j].y * v[j].y) + (v[j].z * v[j].z + v[j].w * v[j].w);
            float rstd = 1.f / sqrtf(wave_sum(s) * (1.f / DM) + NORM_EPS); if (bad) rstd = __builtin_nanf("");
            GAS f32x4* orow = (GAS f32x4*)(out + (size_t)m * DM);
#pragma unroll
            for (int j = 0; j < 8; ++j) { const int c4 = 2 * (ln + 64 * j); const GAS f32x4* g4 = (const GAS f32x4*)final_g + c4;
                orow[c4] = v[2 * j] * rstd * g4[0]; orow[c4 + 1] = v[2 * j + 1] * rstd * g4[1]; }
        }
    }
#undef IN
#undef BOTH
#undef GRID_BAR
#undef gt
#undef LANE
#undef OPQ_TID
}

extern "C" void kernel_launch(void* const* d_in, const int* in_sizes, int n_in, void* d_out, int out_size, void* d_ws, size_t ws_size, hipStream_t stream) {
    static int grid = 0;
    if (grid == 0) {
        if (n_in != 19 || in_sizes[0] != M * DM || out_size != M * DM || ws_size < WS_END) { fprintf(stderr, "kernel_launch: shape mismatch: n_in %d in0 %d out %d ws %zu (need %zu); nothing launched\n", n_in, n_in > 0 ? in_sizes[0] : -1, out_size, ws_size, (size_t)WS_END); grid = -1; return; }
        int dev = 0, cus = 0, per_cu = 0;
        if (hipGetDevice(&dev) != hipSuccess || hipDeviceGetAttribute(&cus, hipDeviceAttributeMultiprocessorCount, dev) != hipSuccess) { fprintf(stderr, "kernel_launch: device query failed\n"); grid = -1; return; }
        if (hipFuncSetAttribute((const void*)mk_fwd, hipFuncAttributeMaxDynamicSharedMemorySize, LDS_BYTES) != hipSuccess) { fprintf(stderr, "kernel_launch: hipFuncSetAttribute failed\n"); grid = -1; return; }
        if (hipOccupancyMaxActiveBlocksPerMultiprocessor(&per_cu, (const void*)mk_fwd, NWAVES * 64, LDS_BYTES) != hipSuccess || per_cu < 1) fprintf(stderr, "kernel_launch: note: occupancy query reports %d workgroups per CU\n", per_cu);
        (void)hipGetLastError();
        grid = cus;
        if (grid != 256) fprintf(stderr, "kernel_launch: %d CUs; this kernel is laid out for 256\n", grid);
    }
    if (grid < 0) return;
    if (hipMemsetAsync((char*)d_ws + WS_CTL, 0, CTL_ZERO_BYTES, stream) != hipSuccess) { fprintf(stderr, "kernel_launch: hipMemsetAsync failed\n"); return; }
    Args a{};
    for (int i = 0; i < 19; ++i) a.in[i] = (const float*)d_in[i];
    a.out = (float*)d_out; a.ws = (unsigned char*)d_ws;
    for (int li = 0; li < N_LAUNCHES; ++li) {
        a.ph_lo = (N_LAUNCHES == PER_PHASE) ? li : 0; a.ph_hi = (N_LAUNCHES == PER_PHASE) ? li + 1 : PER_PHASE; a.li = li;
        hipLaunchKernelGGL(mk_fwd, dim3(grid), dim3(NWAVES * 64), LDS_BYTES, stream, a);
        const hipError_t le = hipPeekAtLastError();
        if (le != hipSuccess) { fprintf(stderr, "kernel_launch: launch %d failed: %s\n", li, hipGetErrorName(le)); break; }
    }
}
```

```cpp
#include <hip/hip_runtime.h>
#include <cstdio>
#include <cstdint>
namespace pg8 {
#define PG8_LAS __attribute__((address_space(3)))
typedef unsigned short bf16_t;
typedef short bf16x8 __attribute__((ext_vector_type(8)));
typedef float f32x4 __attribute__((ext_vector_type(4)));
typedef unsigned u32x4 __attribute__((ext_vector_type(4)));
typedef int i32x4_t __attribute__((ext_vector_type(4)));
typedef int i32x8_t __attribute__((ext_vector_type(8)));
constexpr int BM = 256, BK = 64, HALF = 128, HTB = HALF * BK * 2  , STAGE_BYTES = 8 * HTB, NXCD = 8, WGM = 8;

__host__ __device__ __forceinline__ int lds_byte(int r, int c) { const int st = (r >> 4) * 2 + (c >> 5), rr = r & 15, cc = c & 31, ob = rr * 64 + cc * 2; return st * 1024 + (ob ^ (((ob >> 9) & 1) << 5)); }
__host__ __device__ __forceinline__ void stage_rc(int b, int& R, int& C) { const int st = b / 1024, sb = b % 1024, swz = sb ^ (((sb >> 9) & 1) << 5); R = (st >> 1) * 16 + swz / 64; C = (st & 1) * 32 + (swz % 64) / 2; }
__host__ __device__ __forceinline__ int perm32(int rho) { const int n = rho >> 4, i = rho & 15; return 8 * (i >> 2) + 4 * n + (i & 3); }

struct Unit { int pm, pn; };
struct Gemm { const bf16_t* A; const bf16_t* Bt; int M, N, K; const float* sa = nullptr; const float* sw = nullptr; };

struct StaticOrder {
    int nM, nN, nwg, G, c;
    __host__ __device__ void init(int M, int N, int G_, int c_) { nM = M / BM; nN = N / BM; nwg = nM * nN; G = G_; c = c_; }
    __host__ __device__ bool next(int i, Unit& u) const {
        const long L = (long)i * G + c; if (L >= nwg) return false;
        int wgid = (int)L; { const int q = nwg / NXCD, r = nwg % NXCD, xcd = wgid % NXCD, off = wgid / NXCD; wgid = (xcd < r ? xcd * (q + 1) : r * (q + 1) + (xcd - r) * q) + off; }
        const int nig = WGM * nN, gid = wgid / nig, fm = gid * WGM, gsz = (nM - fm) < WGM ? (nM - fm) : WGM;
        u.pm = fm + ((wgid % nig) % gsz); u.pn = (wgid % nig) / gsz; return true;
    }
    __device__ __forceinline__ void a_ready(const Unit&) const {}
    __device__ __forceinline__ void done(const Unit&) const {}
};

__device__ __forceinline__ unsigned cvt_pk_bf16(float lo, float hi) { unsigned r; asm volatile("v_cvt_pk_bf16_f32 %0, %1, %2" : "=v"(r) : "v"(lo), "v"(hi)); return r; }
__device__ __forceinline__ float bf_lo(unsigned w) { return __uint_as_float(w << 16); }
__device__ __forceinline__ float bf_hi(unsigned w) { return __uint_as_float(w & 0xffff0000u); }
__device__ __forceinline__ float sigmoid_f(float x) { return __builtin_amdgcn_rcpf(1.0f + __builtin_amdgcn_exp2f(-1.4426950408889634f * x)); }
__device__ __forceinline__ f32x4 sigmoid4(f32x4 v) { return (f32x4){sigmoid_f(v[0]), sigmoid_f(v[1]), sigmoid_f(v[2]), sigmoid_f(v[3])}; }
__device__ __forceinline__ void st8(bf16_t* p, f32x4 v0, f32x4 v1) { u32x4 w; w.x = cvt_pk_bf16(v0[0], v0[1]); w.y = cvt_pk_bf16(v0[2], v0[3]); w.z = cvt_pk_bf16(v1[0], v1[1]); w.w = cvt_pk_bf16(v1[2], v1[3]); *(u32x4*)p = w; }
__device__ __forceinline__ void st8f(unsigned char* p, f32x4 v0, f32x4 v1) { int w0 = __builtin_amdgcn_cvt_pk_fp8_f32(v0[0], v0[1], 0, false); w0 = __builtin_amdgcn_cvt_pk_fp8_f32(v0[2], v0[3], w0, true); int w1 = __builtin_amdgcn_cvt_pk_fp8_f32(v1[0], v1[1], 0, false); w1 = __builtin_amdgcn_cvt_pk_fp8_f32(v1[2], v1[3], w1, true);
    *(unsigned long long*)p = (unsigned long long)(unsigned)w0 | ((unsigned long long)(unsigned)w1 << 32); }
__device__ __forceinline__ unsigned pk4_u8(f32x4 v) { unsigned w = __builtin_amdgcn_cvt_pk_u8_f32(v[0] * 255.f, 0, 0u); w = __builtin_amdgcn_cvt_pk_u8_f32(v[1] * 255.f, 1, w); w = __builtin_amdgcn_cvt_pk_u8_f32(v[2] * 255.f, 2, w); return __builtin_amdgcn_cvt_pk_u8_f32(v[3] * 255.f, 3, w); }
__device__ __forceinline__ f32x4 u8x4_f(unsigned w) { return (f32x4){(float)(w & 0xffu), (float)((w >> 8) & 0xffu), (float)((w >> 16) & 0xffu), (float)(w >> 24)}; }
__device__ __forceinline__ f32x4 bf4_lo(u32x4 g) { return (f32x4){bf_lo(g.x), bf_hi(g.x), bf_lo(g.y), bf_hi(g.y)}; }
__device__ __forceinline__ f32x4 bf4_hi(u32x4 g) { return (f32x4){bf_lo(g.z), bf_hi(g.z), bf_lo(g.w), bf_hi(g.w)}; }

constexpr int P3_NBF = 0;
struct EpiZ {
    static constexpr bool PERM = true, AFTER_DRAIN = false; static constexpr int MID_T = -1;
    bf16_t *ZQ, *ZKV, *QD, *KD, *VD, *GA, *GB, *ZKR; const float *cosF, *sinF; int remap;
    __device__ __forceinline__ void operator()(const f32x4 (&acc)[2][2][4][2], const Unit& u, int wr, int wc, int fr, int fq) const {
        const int pn = remap == 0 ? u.pn : (remap == 1 ? 6 + u.pn : (u.pn < 6 ? u.pn : P3_NBF + u.pn)), row0 = u.pm * BM + wr * 64 + fr, j0 = wc * 32 + 8 * fq;
        if (pn >= 6 && pn < 30) {
            const int t = (pn - 6) / 12, tt = (pn - 6) % 12, i0 = (wc & 1) * 32 + 8 * fq;
            bf16_t* base = (t ? KD : QD) + ((size_t)((u.pm >> 4) * 24 + 2 * tt + (wc >> 1)) * 4096) * 128 + i0;
#pragma unroll
            for (int ai = 0; ai < 2; ++ai) { f32x4 cs[4][4];
#pragma unroll
                for (int m = 0; m < 4; ++m) { const int row = row0 + ai * HALF + m * 16; const float* cp = cosF + (size_t)row * 64 + i0; const float* sp = sinF + (size_t)row * 64 + i0;
                    cs[m][0] = *(const f32x4*)cp; cs[m][1] = *(const f32x4*)(cp + 4); cs[m][2] = *(const f32x4*)sp; cs[m][3] = *(const f32x4*)(sp + 4); }
#pragma unroll
                for (int m = 0; m < 4; ++m) { const int row = row0 + ai * HALF + m * 16; const f32x4 c0 = cs[m][0], c1 = cs[m][1], s0 = cs[m][2], s1 = cs[m][3];
                    const f32x4 x10 = acc[ai][0][m][0], x11 = acc[ai][0][m][1], x20 = acc[ai][1][m][0], x21 = acc[ai][1][m][1];
                    bf16_t* rp = base + (size_t)(row & 4095) * 128;
                    st8(rp, x10 * c0 - x20 * s0, x11 * c1 - x21 * s1); st8(rp + 64, x20 * c0 + x10 * s0, x21 * c1 + x11 * s1); } }
        } else if (pn >= 30 && pn < 42) {
            bf16_t* base = VD + ((size_t)((u.pm >> 4) * 24 + 2 * (pn - 30)) * 4096) * 128 + j0;
#pragma unroll
            for (int ai = 0; ai < 2; ++ai)
#pragma unroll
                for (int m = 0; m < 4; ++m) { bf16_t* rp = base + (size_t)((row0 + ai * HALF + m * 16) & 4095) * 128;
#pragma unroll
                    for (int bj = 0; bj < 2; ++bj) st8(rp + (size_t)bj * 4096 * 128, acc[ai][bj][m][0], acc[ai][bj][m][1]); }
        } else {
            bf16_t* base; int ld; bool sig = false;
            if (pn < 4) { base = ZQ + pn * 256; ld = 1024; }
            else if (pn < 6) { base = ZKV + (pn - 4) * 256; ld = 512; }
            else if (pn < 74) { const int gi = pn - 42; base = (gi < 16 ? GA : GB) + ((gi & 15) * 256) / 2; ld = 4096 / 2; sig = true; }
            else { base = ZKR; ld = 256; }
            base += sig ? j0 / 2 : j0;
#pragma unroll
            for (int ai = 0; ai < 2; ++ai)
#pragma unroll
                for (int m = 0; m < 4; ++m) { bf16_t* rp = base + (size_t)(row0 + ai * HALF + m * 16) * ld;
#pragma unroll
                    for (int bj = 0; bj < 2; ++bj) { f32x4 v0 = acc[ai][bj][m][0], v1 = acc[ai][bj][m][1];
                        if (sig) { *(unsigned long long*)(rp + (bj * HALF) / 2) = (unsigned long long)pk4_u8(sigmoid4(v0)) | ((unsigned long long)pk4_u8(sigmoid4(v1)) << 32); }
                        else st8(rp + bj * HALF, v0, v1); } }
        }
    }
};
struct EpiQ {
    static constexpr bool PERM = true, AFTER_DRAIN = false; static constexpr int MID_T = -1;
    unsigned char* Q; const float *cosR, *sinR;
    __device__ __forceinline__ void operator()(const f32x4 (&acc)[2][2][4][2], const Unit& u, int wr, int wc, int fr, int fq) const {
        const int pn = u.pn, row0 = u.pm * BM + wr * 64 + fr;
        if (pn >= 8) {
            const int head = 4 * (pn - 8) + wc, i0 = 8 * fq;
            unsigned char* base = Q + ((size_t)((u.pm >> 4) * 16 + head) * 4096) * 192 + 128 + i0;
#pragma unroll
            for (int ai = 0; ai < 2; ++ai) { f32x4 cs[4][4];
#pragma unroll
                for (int m = 0; m < 4; ++m) { const int row = row0 + ai * HALF + m * 16; const float* cp = cosR + (size_t)row * 32 + i0; const float* sp = sinR + (size_t)row * 32 + i0;
                    cs[m][0] = *(const f32x4*)cp; cs[m][1] = *(const f32x4*)(cp + 4); cs[m][2] = *(const f32x4*)sp; cs[m][3] = *(const f32x4*)(sp + 4); }
#pragma unroll
                for (int m = 0; m < 4; ++m) { const int row = row0 + ai * HALF + m * 16; const f32x4 c0 = cs[m][0], c1 = cs[m][1], s0 = cs[m][2], s1 = cs[m][3];
                    const f32x4 x10 = acc[ai][0][m][0], x11 = acc[ai][0][m][1], x20 = acc[ai][1][m][0], x21 = acc[ai][1][m][1];
                    unsigned char* rp = base + (size_t)(row & 4095) * 192;
                    st8f(rp, x10 * c0 - x20 * s0, x11 * c1 - x21 * s1); st8f(rp + 32, x20 * c0 + x10 * s0, x21 * c1 + x11 * s1); } }
        } else {
            unsigned char* base = Q + ((size_t)((u.pm >> 4) * 16 + 2 * pn) * 4096) * 192 + wc * 32 + 8 * fq;
#pragma unroll
            for (int ai = 0; ai < 2; ++ai)
#pragma unroll
                for (int m = 0; m < 4; ++m) { unsigned char* rp = base + (size_t)((row0 + ai * HALF + m * 16) & 4095) * 192;
#pragma unroll
                    for (int bj = 0; bj < 2; ++bj) st8f(rp + (size_t)bj * 4096 * 192, acc[ai][bj][m][0], acc[ai][bj][m][1]); }
        }
    }
};
struct EpiKV {
    static constexpr bool PERM = true, AFTER_DRAIN = false; static constexpr int MID_T = -1;
    unsigned char* K8; unsigned char* V8T;
    __device__ __forceinline__ void operator()(const f32x4 (&acc)[2][2][4][2], const Unit& u, int wr, int wc, int fr, int fq) const {
        const int row0 = u.pm * BM + wr * 64 + fr, j0 = wc * 32 + 8 * fq; const size_t bh = (size_t)((u.pm >> 4) * 16 + u.pn);
#pragma unroll
        for (int ai = 0; ai < 2; ++ai)
#pragma unroll
            for (int m = 0; m < 4; ++m) { const int s_ = (row0 + ai * HALF + m * 16) & 4095, t = s_ & 63;
                st8f(K8 + (bh * 4096 + s_) * 128 + j0, acc[ai][0][m][0], acc[ai][0][m][1]);
                const int vp = 32 * ((t >> 2) & 1) + (t & 3) + 4 * ((t >> 3) & 3) + 16 * (t >> 5);
                unsigned char* vb = V8T + ((bh * 64 + (s_ >> 6)) * 128 + j0) * 64 + vp;
                const f32x4 v0 = acc[ai][1][m][0], v1 = acc[ai][1][m][1];
                const unsigned w0 = (unsigned)__builtin_amdgcn_cvt_pk_fp8_f32(v0[0], v0[1], 0, false), w1 = (unsigned)__builtin_amdgcn_cvt_pk_fp8_f32(v0[2], v0[3], 0, false), w2 = (unsigned)__builtin_amdgcn_cvt_pk_fp8_f32(v1[0], v1[1], 0, false), w3 = (unsigned)__builtin_amdgcn_cvt_pk_fp8_f32(v1[2], v1[3], 0, false);
                vb[0] = (unsigned char)w0; vb[64] = (unsigned char)(w0 >> 8); vb[128] = (unsigned char)w1; vb[192] = (unsigned char)(w1 >> 8); vb[256] = (unsigned char)w2; vb[320] = (unsigned char)(w2 >> 8); vb[384] = (unsigned char)w3; vb[448] = (unsigned char)(w3 >> 8); }
    }
};
struct EpiMix {
    static constexpr bool PERM = true, AFTER_DRAIN = false; static constexpr int MID_T = 32;
    const unsigned char* GA; const unsigned char* GB; bf16_t* O;
    __device__ __forceinline__ void mid(f32x4 (&acc)[2][2][4][2], const Unit& u, int wr, int wc, int fr_in, int fq_in) const {
        int fr = fr_in, fq = fq_in; asm volatile("" : "+v"(fr), "+v"(fq));
        const int row0 = u.pm * BM + wr * 64 + fr; const size_t c0 = (size_t)u.pn * BM + wc * 32 + 8 * fq;
#pragma unroll
        for (int ai = 0; ai < 2; ++ai)
#pragma unroll
            for (int m = 0; m < 4; ++m) { const size_t ro = (size_t)(row0 + ai * HALF + m * 16) * 4096 + c0;
#pragma unroll
                for (int bj = 0; bj < 2; ++bj) { const size_t p = ro + bj * HALF; const unsigned long long ga = *(const unsigned long long*)(GA + p), gb = *(const unsigned long long*)(GB + p);
                    const f32x4 a0 = u8x4_f((unsigned)ga), a1 = u8x4_f((unsigned)(ga >> 32)); f32x4 b0 = u8x4_f((unsigned)gb), b1 = u8x4_f((unsigned)(gb >> 32));
#pragma unroll
                    for (int i = 0; i < 4; ++i) { b0[i] = fmaxf(b0[i], 1.f); b1[i] = fmaxf(b1[i], 1.f); }
                    acc[ai][bj][m][0] *= (f32x4){a0[0] * __builtin_amdgcn_rcpf(b0[0]), a0[1] * __builtin_amdgcn_rcpf(b0[1]), a0[2] * __builtin_amdgcn_rcpf(b0[2]), a0[3] * __builtin_amdgcn_rcpf(b0[3])};
                    acc[ai][bj][m][1] *= (f32x4){a1[0] * __builtin_amdgcn_rcpf(b1[0]), a1[1] * __builtin_amdgcn_rcpf(b1[1]), a1[2] * __builtin_amdgcn_rcpf(b1[2]), a1[3] * __builtin_amdgcn_rcpf(b1[3])}; }
            }
    }
    __device__ __forceinline__ void operator()(const f32x4 (&acc)[2][2][4][2], const Unit& u, int wr, int wc, int fr, int fq) const {
        const int row0 = u.pm * BM + wr * 64 + fr; const size_t c0 = (size_t)u.pn * BM + wc * 32 + 8 * fq;
        unsigned long long gbv[2][4][2];
#pragma unroll
        for (int ai = 0; ai < 2; ++ai)
#pragma unroll
            for (int m = 0; m < 4; ++m)
#pragma unroll
                for (int bj = 0; bj < 2; ++bj) gbv[ai][m][bj] = *(const unsigned long long*)(GB + (size_t)(row0 + ai * HALF + m * 16) * 4096 + c0 + bj * HALF);
#pragma unroll
        for (int ai = 0; ai < 2; ++ai)
#pragma unroll
            for (int m = 0; m < 4; ++m)
#pragma unroll
                for (int bj = 0; bj < 2; ++bj) { const size_t p = (size_t)(row0 + ai * HALF + m * 16) * 4096 + c0 + bj * HALF; const unsigned long long gb = gbv[ai][m][bj];
                    f32x4 b0 = u8x4_f((unsigned)gb), b1 = u8x4_f((unsigned)(gb >> 32));
#pragma unroll
                    for (int i = 0; i < 4; ++i) { b0[i] = fmaxf(b0[i], 1.f) * (1.f / 255.f); b1[i] = fmaxf(b1[i], 1.f) * (1.f / 255.f); }
                    st8(O + p, acc[ai][bj][m][0] * b0, acc[ai][bj][m][1] * b1); }
    }
};
template <bool BASE_F32> struct EpiRes {
    static constexpr bool PERM = true, AFTER_DRAIN = false; static constexpr int MID_T = -1;
    const void* base; bf16_t* out; const float* gvec;
    __device__ __forceinline__ void operator()(const f32x4 (&acc)[2][2][4][2], const Unit& u, int wr, int wc, int fr, int fq) const {
        const int row0 = u.pm * BM + wr * 64 + fr, col0 = u.pn * BM + wc * 32 + 8 * fq; const float* gb = gvec + (size_t)(u.pm >> 4) * 4096 + col0;
        f32x4 gv[2][2];
#pragma unroll
        for (int bj = 0; bj < 2; ++bj)
#pragma unroll
            for (int n = 0; n < 2; ++n) gv[bj][n] = *(const f32x4*)(gb + bj * HALF + n * 4);
        if constexpr (BASE_F32) {
#pragma unroll
            for (int ai = 0; ai < 2; ++ai) { f32x4 pre[4][2][2];
#pragma unroll
                for (int m = 0; m < 4; ++m)
#pragma unroll
                    for (int bj = 0; bj < 2; ++bj) { const size_t p = (size_t)(row0 + ai * HALF + m * 16) * 4096 + col0 + bj * HALF; pre[m][bj][0] = *(const f32x4*)((const float*)base + p); pre[m][bj][1] = *(const f32x4*)((const float*)base + p + 4); }
#pragma unroll
                for (int m = 0; m < 4; ++m)
#pragma unroll
                    for (int bj = 0; bj < 2; ++bj) { const size_t p = (size_t)(row0 + ai * HALF + m * 16) * 4096 + col0 + bj * HALF; st8(out + p, pre[m][bj][0] + gv[bj][0] * acc[ai][bj][m][0], pre[m][bj][1] + gv[bj][1] * acc[ai][bj][m][1]); } }
        } else {
            u32x4 pre[2][4][2];
#pragma unroll
            for (int ai = 0; ai < 2; ++ai)
#pragma unroll
                for (int m = 0; m < 4; ++m)
#pragma unroll
                    for (int bj = 0; bj < 2; ++bj) pre[ai][m][bj] = *(const u32x4*)((const bf16_t*)base + (size_t)(row0 + ai * HALF + m * 16) * 4096 + col0 + bj * HALF);
#pragma unroll
            for (int ai = 0; ai < 2; ++ai)
#pragma unroll
                for (int m = 0; m < 4; ++m)
#pragma unroll
                    for (int bj = 0; bj < 2; ++bj) { const size_t p = (size_t)(row0 + ai * HALF + m * 16) * 4096 + col0 + bj * HALF; st8(out + p, bf4_lo(pre[ai][m][bj]) + gv[bj][0] * acc[ai][bj][m][0], bf4_hi(pre[ai][m][bj]) + gv[bj][1] * acc[ai][bj][m][1]); }
        }
    }
};
struct EpiGU {
    static constexpr bool PERM = true, AFTER_DRAIN = false; static constexpr int MID_T = -1;
    bf16_t* A;
    __device__ __forceinline__ void operator()(const f32x4 (&acc)[2][2][4][2], const Unit& u, int wr, int wc, int fr, int fq) const {
        const int row0 = u.pm * BM + wr * 64 + fr; bf16_t* base = A + u.pn * HALF + wc * 32 + 8 * fq;
#pragma unroll
        for (int ai = 0; ai < 2; ++ai)
#pragma unroll
            for (int m = 0; m < 4; ++m) { const f32x4 g0 = acc[ai][0][m][0], g1 = acc[ai][0][m][1], u0 = acc[ai][1][m][0], u1 = acc[ai][1][m][1];
                st8(base + (size_t)(row0 + ai * HALF + m * 16) * 11008, g0 * sigmoid4(g0) * u0, g1 * sigmoid4(g1) * u1); }
    }
};

template <class Epi, class Sched, bool ALIGN_EPI = false, bool SP2 = false, bool F8 = false, int SCALE_W = 127, bool I8 = false>
__device__ __forceinline__ void gemm_phase(PG8_LAS unsigned char* lds, const Gemm g, const Sched& S, const Epi& E) {
    int tid_ = threadIdx.x; asm volatile("" : "+v"(tid_));
    const int tid = tid_, wid = __builtin_amdgcn_readfirstlane(tid >> 6), lane = tid & 63, wr = wid >> 2, wc = wid & 3, fr = lane & 15, fq = lane >> 4;
    const int K = g.K, nt = F8 ? K / 128 : K / BK;
    unsigned voffA[2], voffB[2];
#pragma unroll
    for (int i = 0; i < 2; ++i) { int R, C; stage_rc(tid * 16 + i * 8192, R, C); const int Rb = Epi::PERM ? ((R & ~31) + perm32(R & 31)) : R;
        voffA[i] = F8 ? (unsigned)(R * K + 2 * C) : (unsigned)(R * K + C) * 2u; voffB[i] = F8 ? (unsigned)(Rb * K + 2 * C) : (unsigned)(Rb * K + C) * 2u; }
    const size_t kstep = (size_t)(BK * 2);
    const size_t hstep = (size_t)HALF * K * (F8 ? 1 : 2);
    const size_t tstep = 2 * hstep;
    const unsigned ldsw = (unsigned)wid * 1024u;
    const int fcol = F8 ? (fq >> 1) * 32 + (fq & 1) * 16 : fq * 8;
    const int aoff = lds_byte(wr * 64 + fr, fcol), boff = lds_byte(wc * 32 + fr, fcol);
    int scale_w = SCALE_W * 0x01010101, scale_a = 0x7f7f7f7f; asm volatile("" : "+v"(scale_w), "+v"(scale_a));
#define PG8_SA(b, h) (((b) * 2 + (h)) * HTB)
#define PG8_SB(b, h) ((4 + (b) * 2 + (h)) * HTB)
#define PG8_STAGE(bufoff, gbase, voff) do { _Pragma("unroll") for (int _i = 0; _i < 2; ++_i) \
        __builtin_amdgcn_global_load_lds((const unsigned*)((const char*)(gbase) + (voff)[_i]), (PG8_LAS unsigned*)(lds + (bufoff) + ldsw + _i * 8192), 16, 0, 0); } while (0)
#define PG8_RD16(off) (*(const PG8_LAS i32x4_t*)(lds + (off)))
#define PG8_LDA(dst, b, h) do { if constexpr (F8) { _Pragma("unroll") for (int m = 0; m < 4; ++m) dst##8[m] = PG8_CAT8(PG8_RD16(PG8_SA(b, h) + aoff + m * 2048), PG8_RD16(PG8_SA(b, h) + aoff + m * 2048 + 16)); } \
    else { _Pragma("unroll") for (int m = 0; m < 4; ++m) _Pragma("unroll") for (int k = 0; k < 2; ++k) dst[m][k] = *(const PG8_LAS bf16x8*)(lds + PG8_SA(b, h) + aoff + m * 2048 + k * 1024); } } while (0)
#define PG8_LDB(dst, b, h) do { if constexpr (F8) { _Pragma("unroll") for (int n = 0; n < 2; ++n) dst##8[n] = PG8_CAT8(PG8_RD16(PG8_SB(b, h) + boff + n * 2048), PG8_RD16(PG8_SB(b, h) + boff + n * 2048 + 16)); } \
    else { _Pragma("unroll") for (int n = 0; n < 2; ++n) _Pragma("unroll") for (int k = 0; k < 2; ++k) dst[n][k] = *(const PG8_LAS bf16x8*)(lds + PG8_SB(b, h) + boff + n * 2048 + k * 1024); } } while (0)
#define PG8_CAT8(lo, hi) __builtin_shufflevector(lo, hi, 0, 1, 2, 3, 4, 5, 6, 7)
#define PG8_LO4(x) __builtin_shufflevector(x, x, 0, 1, 2, 3)
#define PG8_HI4(x) __builtin_shufflevector(x, x, 4, 5, 6, 7)
#define PG8_MMA(ai, bj, At, Bt) do { __builtin_amdgcn_s_setprio(1); if constexpr (I8) { _Pragma("unroll") for (int m = 0; m < 4; ++m) _Pragma("unroll") for (int n = 0; n < 2; ++n) { \
        i32x4_t c_ = __builtin_bit_cast(i32x4_t, acc[ai][bj][m][n]); c_ = __builtin_amdgcn_mfma_i32_16x16x64_i8(PG8_LO4(Bt##8[n]), PG8_LO4(At##8[m]), c_, 0, 0, 0); \
        c_ = __builtin_amdgcn_mfma_i32_16x16x64_i8(PG8_HI4(Bt##8[n]), PG8_HI4(At##8[m]), c_, 0, 0, 0); acc[ai][bj][m][n] = __builtin_bit_cast(f32x4, c_); } } \
      else if constexpr (F8) { _Pragma("unroll") for (int m = 0; m < 4; ++m) _Pragma("unroll") for (int n = 0; n < 2; ++n) \
        asm volatile("v_mfma_scale_f32_16x16x128_f8f6f4 %0, %1, %2, %0, %3, %4 op_sel_hi:[0,0,0]" : "+v"(acc[ai][bj][m][n]) : "v"(Bt##8[n]), "v"(At##8[m]), "v"(scale_w), "v"(scale_a)); } \
      else { _Pragma("unroll") for (int m = 0; m < 4; ++m) _Pragma("unroll") for (int n = 0; n < 2; ++n) _Pragma("unroll") for (int k = 0; k < 2; ++k) \
        acc[ai][bj][m][n] = __builtin_amdgcn_mfma_f32_16x16x32_bf16(Bt[n][k], At[m][k], acc[ai][bj][m][n], 0, 0, 0); } __builtin_amdgcn_s_setprio(0); } while (0)
#define PG8_WAIT_V(n) asm volatile("s_waitcnt vmcnt(" #n ")" ::: "memory")
#define PG8_WAIT_L(n) asm volatile("s_waitcnt lgkmcnt(" #n ")" ::: "memory")
#define PG8_BAR __builtin_amdgcn_s_barrier()
#define PG8_SCHED __builtin_amdgcn_sched_barrier(0)
    Unit cur, nxt; int ui = 0;
    if (!S.next(0, cur)) return;
    f32x4 acc[2][2][4][2];
#pragma unroll
    for (int a = 0; a < 2; ++a)
#pragma unroll
        for (int b = 0; b < 2; ++b)
#pragma unroll
            for (int m = 0; m < 4; ++m)
#pragma unroll
                for (int n = 0; n < 2; ++n) acc[a][b][m][n] = (f32x4){0.f, 0.f, 0.f, 0.f};
    bf16x8 At[4][2], B0[2][2], B1[2][2]; i32x8_t At8[4], B08[2], B18[2];
    const char* cA = (const char*)g.A + (size_t)cur.pm * tstep; const char* cB = (const char*)g.Bt + (size_t)cur.pn * tstep;
    S.a_ready(cur);
    if constexpr (SP2) {
        PG8_STAGE(PG8_SB(0, 0), cB, voffB); PG8_STAGE(PG8_SB(0, 1), cB + hstep, voffB); PG8_STAGE(PG8_SA(0, 0), cA, voffA); PG8_STAGE(PG8_SA(0, 1), cA + hstep, voffA);
        if (wr == 1) PG8_BAR;
        PG8_WAIT_V(2); PG8_BAR;
        PG8_STAGE(PG8_SB(1, 0), cB + kstep, voffB); PG8_STAGE(PG8_SA(1, 0), cA + kstep, voffA); PG8_STAGE(PG8_SB(1, 1), cB + hstep + kstep, voffB);
        PG8_WAIT_V(6); PG8_BAR;
    } else {
        PG8_STAGE(PG8_SB(0, 0), cB, voffB); PG8_STAGE(PG8_SA(0, 0), cA, voffA); PG8_STAGE(PG8_SB(0, 1), cB + hstep, voffB); PG8_STAGE(PG8_SA(0, 1), cA + hstep, voffA);
        if (wr == 1) PG8_BAR;
        PG8_WAIT_V(4); PG8_BAR;
        PG8_STAGE(PG8_SB(1, 0), cB + kstep, voffB); PG8_STAGE(PG8_SA(1, 0), cA + kstep, voffA); PG8_STAGE(PG8_SB(1, 1), cB + hstep + kstep, voffB);
        PG8_WAIT_V(6); PG8_BAR;
    }
    for (;;) {
        const bool has_next = S.next(ui + 1, nxt);
        const char* nA = has_next ? (const char*)g.A + (size_t)nxt.pm * tstep : cA; const char* nB = has_next ? (const char*)g.Bt + (size_t)nxt.pn * tstep : cB;
        for (int t = 0; t < nt; t += 2) {
            if constexpr (Epi::MID_T >= 0) { if (t == Epi::MID_T) E.mid(acc, cur, wr, wc, fr, fq); }
            const bool last = (t == nt - 2);
            const char* a1 = cA + (size_t)(t + 1) * kstep;
            const char* a2 = last ? nA : cA + (size_t)(t + 2) * kstep; const char* b2 = last ? nB : cB + (size_t)(t + 2) * kstep;
            const char* a3 = a2 + kstep; const char* b3 = b2 + kstep;
            if (last && has_next) S.a_ready(nxt);
            if constexpr (SP2) {
            PG8_LDB(B0, 0, 0); PG8_LDB(B1, 0, 1); PG8_SCHED; PG8_LDA(At, 0, 0); PG8_STAGE(PG8_SA(1, 1), a1 + hstep, voffA);
            PG8_WAIT_V(8); PG8_WAIT_L(0); PG8_BAR; PG8_MMA(0, 0, At, B0); PG8_MMA(0, 1, At, B1); PG8_BAR; PG8_SCHED;
            PG8_LDA(At, 0, 1); PG8_STAGE(PG8_SB(0, 0), b2, voffB); PG8_STAGE(PG8_SB(0, 1), b2 + hstep, voffB); PG8_STAGE(PG8_SA(0, 0), a2, voffA);
            PG8_WAIT_V(8); PG8_WAIT_L(0); PG8_BAR; PG8_MMA(1, 0, At, B0); PG8_MMA(1, 1, At, B1); PG8_BAR; PG8_SCHED;
            PG8_LDB(B0, 1, 0); PG8_LDB(B1, 1, 1); PG8_SCHED; PG8_LDA(At, 1, 0); PG8_STAGE(PG8_SA(0, 1), a2 + hstep, voffA);
            PG8_WAIT_V(8); PG8_WAIT_L(0); PG8_BAR; PG8_MMA(0, 0, At, B0); PG8_MMA(0, 1, At, B1); PG8_BAR; PG8_SCHED;
            PG8_LDA(At, 1, 1); PG8_STAGE(PG8_SB(1, 0), b3, voffB); PG8_STAGE(PG8_SB(1, 1), b3 + hstep, voffB); PG8_STAGE(PG8_SA(1, 0), a3, voffA);
            PG8_WAIT_V(8); PG8_WAIT_L(0); PG8_BAR; PG8_MMA(1, 0, At, B0); PG8_MMA(1, 1, At, B1); PG8_BAR; PG8_SCHED;
            } else {
            PG8_LDB(B0, 0, 0); PG8_SCHED; PG8_LDA(At, 0, 0); PG8_STAGE(PG8_SA(1, 1), a1 + hstep, voffA);
            PG8_WAIT_L(8); PG8_BAR; PG8_WAIT_L(0); PG8_MMA(0, 0, At, B0); PG8_BAR; PG8_SCHED;
            PG8_LDB(B1, 0, 1); PG8_STAGE(PG8_SB(0, 0), b2, voffB);
            PG8_BAR; PG8_WAIT_L(0); PG8_MMA(0, 1, At, B1); PG8_BAR;
            PG8_LDA(At, 0, 1); PG8_STAGE(PG8_SA(0, 0), a2, voffA);
            PG8_BAR; PG8_WAIT_L(0); PG8_MMA(1, 0, At, B0); PG8_BAR; PG8_SCHED;
            PG8_STAGE(PG8_SB(0, 1), b2 + hstep, voffB);
            PG8_WAIT_V(6); PG8_BAR; PG8_MMA(1, 1, At, B1); PG8_BAR;
            PG8_LDB(B0, 1, 0); PG8_SCHED; PG8_LDA(At, 1, 0); PG8_STAGE(PG8_SA(0, 1), a2 + hstep, voffA);
            PG8_WAIT_L(8); PG8_BAR; PG8_WAIT_L(0); PG8_MMA(0, 0, At, B0); PG8_BAR; PG8_SCHED;
            PG8_LDB(B1, 1, 1); PG8_STAGE(PG8_SB(1, 0), b3, voffB);
            PG8_BAR; PG8_WAIT_L(0); PG8_MMA(0, 1, At, B1); PG8_BAR;
            PG8_LDA(At, 1, 1); PG8_STAGE(PG8_SA(1, 0), a3, voffA);
            PG8_BAR; PG8_WAIT_L(0); PG8_MMA(1, 0, At, B0); PG8_BAR; PG8_SCHED;
            PG8_STAGE(PG8_SB(1, 1), b3 + hstep, voffB);
            PG8_WAIT_V(6); PG8_BAR; PG8_MMA(1, 1, At, B1); PG8_BAR;
            }
        }
        if constexpr (F8) asm volatile("s_nop 15\n\ts_nop 15" ::: "memory");
        if constexpr (I8) {
            const int r0_ = cur.pm * BM + wr * 64 + fr, c0_ = cur.pn * BM + wc * 32 + 8 * fq;
#pragma unroll
            for (int a = 0; a < 2; ++a)
#pragma unroll
                for (int m = 0; m < 4; ++m) { const float sa_ = g.sa[r0_ + a * HALF + m * 16] * (1.f / 127.f);
#pragma unroll
                    for (int b = 0; b < 2; ++b)
#pragma unroll
                        for (int n = 0; n < 2; ++n) { const f32x4 sw_ = *(const f32x4*)(g.sw + c0_ + b * HALF + n * 4); const i32x4_t c_ = __builtin_bit_cast(i32x4_t, acc[a][b][m][n]);
                            acc[a][b][m][n] = (f32x4){(float)c_.x * sa_ * sw_.x, (float)c_.y * sa_ * sw_.y, (float)c_.z * sa_ * sw_.z, (float)c_.w * sa_ * sw_.w}; } } }
        if constexpr (ALIGN_EPI) { if (wr == 0) PG8_BAR; }
        if constexpr (!Epi::AFTER_DRAIN) { int fr_ = fr, fq_ = fq; asm volatile("" : "+v"(fr_), "+v"(fq_));
            E(acc, cur, wr, wc, fr_, fq_); S.done(cur); }
        if (!has_next) break;
#pragma unroll
        for (int a = 0; a < 2; ++a)
#pragma unroll
            for (int b = 0; b < 2; ++b)
#pragma unroll
                for (int m = 0; m < 4; ++m)
#pragma unroll
                    for (int n = 0; n < 2; ++n) acc[a][b][m][n] = (f32x4){0.f, 0.f, 0.f, 0.f};
        cur = nxt; cA = nA; cB = nB; ++ui;
        if constexpr (ALIGN_EPI) { if (wr == 1) PG8_BAR; }
    }
    PG8_WAIT_V(0);
    if constexpr (!ALIGN_EPI) { if (wr == 0) PG8_BAR; }
    PG8_BAR;
    if constexpr (Epi::AFTER_DRAIN) { E.fused(acc, cur, wr, wc, fr, fq, lds, wid, lane); S.done(cur); }
#undef PG8_SA
#undef PG8_SB
#undef PG8_STAGE
#undef PG8_LDA
#undef PG8_LDB
#undef PG8_MMA
#undef PG8_CAT8
#undef PG8_LO4
#undef PG8_HI4
#undef PG8_RD16
#undef PG8_WAIT_V
#undef PG8_WAIT_L
#undef PG8_BAR
#undef PG8_SCHED
}
}
namespace att {
typedef unsigned short bf16;
using bf16x8 = __attribute__((ext_vector_type(8))) short;
using s16x4  = __attribute__((ext_vector_type(4))) short;
using f32x16 = __attribute__((ext_vector_type(16))) float;
using u32x4  = __attribute__((ext_vector_type(4))) unsigned;
constexpr int SEQ = 4096, MTOK = 16384;
constexpr int NW = 8, QBLK = 32, KVBLK = 64;
constexpr float SCALE_MLA = 0.07216878364870323f;
constexpr float SCALE_DIL = 0.08838834764831845f;
constexpr float THR = 8.f;
constexpr float THR_MLA = 5.f;
constexpr int L_V = 0, L_KN = 32768, L_KR = 65536, L_WS = 81920, ATT_LDS_BYTES = 83968;
#define KSWZ(row, colB) ((row) * 256 + ((colB) ^ (((row) & 7) << 4)))
#define KRSWZ(row, c) ((row) * 128 + ((((c) ^ ((row) >> 1)) & 7) << 4))
#define SBAR() __builtin_amdgcn_sched_barrier(0)
__device__ __forceinline__ int crow(int r, int hi) { return (r & 3) + 8 * (r >> 2) + 4 * hi; }
__device__ __forceinline__ unsigned cvtpk(float lo, float hi) { unsigned r; asm volatile("v_cvt_pk_bf16_f32 %0, %1, %2" : "=v"(r) : "v"(lo), "v"(hi)); return r; }
__device__ __forceinline__ bf16x8 ld8(const bf16* p) { return *reinterpret_cast<const bf16x8*>(p); }

template <bool MLA> __device__ __forceinline__ void partialSM(f32x16& p0, f32x16& p1, float& m_reg, float& mn, float& alpha) {
  constexpr float SCALE = MLA ? SCALE_MLA : SCALE_DIL;
  constexpr float C = SCALE * 1.4426950408889634f;
  float pmax = p0[0];
#pragma unroll
  for (int r = 1; r < 16; ++r) pmax = fmaxf(pmax, p0[r]);
#pragma unroll
  for (int r = 0; r < 16; ++r) pmax = fmaxf(pmax, p1[r]);
  { auto rr = __builtin_amdgcn_permlane32_swap(__float_as_uint(pmax), __float_as_uint(pmax), false, false);
    pmax = fmaxf(__uint_as_float(rr[0]), __uint_as_float(rr[1])); }
  constexpr float THR_ = MLA ? THR_MLA : THR;
  if (__builtin_expect(__all(pmax - m_reg <= THR_ / SCALE), 1)) { mn = m_reg; alpha = 1.f; }
  else { mn = fmaxf(m_reg, pmax); alpha = __builtin_amdgcn_exp2f((m_reg - mn) * C); m_reg = mn; }
  float mnC = -mn * C;
#pragma unroll
  for (int r = 0; r < 16; ++r) p0[r] = fmaf(p0[r], C, mnC);
#pragma unroll
  for (int r = 0; r < 16; ++r) p1[r] = fmaf(p1[r], C, mnC);
#pragma unroll
  for (int r = 0; r < 16; ++r) p0[r] = __builtin_amdgcn_exp2f(p0[r]);
}
__device__ __forceinline__ void finishSM(f32x16& p0, f32x16& p1, float alpha, float& l_reg, bf16x8& pa0, bf16x8& pa1, bf16x8& pa2, bf16x8& pa3) {
#pragma unroll
  for (int r = 0; r < 16; ++r) p1[r] = __builtin_amdgcn_exp2f(p1[r]);
  float ps = 0;
#pragma unroll
  for (int r = 0; r < 16; ++r) ps += p0[r];
#pragma unroll
  for (int r = 0; r < 16; ++r) ps += p1[r];
  { auto rr = __builtin_amdgcn_permlane32_swap(__float_as_uint(ps), __float_as_uint(ps), false, false);
    ps = __uint_as_float(rr[0]) + __uint_as_float(rr[1]); }
  l_reg = l_reg * alpha + ps;
#define PK4(P, BASE, OUT) do { unsigned a0 = cvtpk(P[BASE + 0], P[BASE + 1]), a1 = cvtpk(P[BASE + 2], P[BASE + 3]);   \
    unsigned b0 = cvtpk(P[BASE + 4], P[BASE + 5]), b1 = cvtpk(P[BASE + 6], P[BASE + 7]);                              \
    auto r0 = __builtin_amdgcn_permlane32_swap(a0, b0, false, false); auto r1 = __builtin_amdgcn_permlane32_swap(a1, b1, false, false); \
    u32x4 w = {r0[0], r1[0], r0[1], r1[1]}; OUT = *reinterpret_cast<bf16x8*>(&w); } while (0)
  PK4(p0, 0, pa0); PK4(p0, 8, pa1); PK4(p1, 0, pa2); PK4(p1, 8, pa3);
#undef PK4
}
typedef int i32x8p __attribute__((ext_vector_type(8)));
__device__ __forceinline__ void finishSM_f8(f32x16& p0, f32x16& p1, float alpha, float& l_reg, i32x8p& pa) {
#pragma unroll
  for (int r = 0; r < 16; ++r) p1[r] = __builtin_amdgcn_exp2f(p1[r]);
  float ps = 0;
#pragma unroll
  for (int r = 0; r < 16; ++r) ps += p0[r];
#pragma unroll
  for (int r = 0; r < 16; ++r) ps += p1[r];
  { auto rr = __builtin_amdgcn_permlane32_swap(__float_as_uint(ps), __float_as_uint(ps), false, false);
    ps = __uint_as_float(rr[0]) + __uint_as_float(rr[1]); }
  l_reg = l_reg * alpha + ps;
#pragma unroll
  for (int k = 0; k < 4; ++k) { int w = __builtin_amdgcn_cvt_pk_fp8_f32(p0[4 * k], p0[4 * k + 1], 0, false); w = __builtin_amdgcn_cvt_pk_fp8_f32(p0[4 * k + 2], p0[4 * k + 3], w, true); pa[k] = w;
    int v = __builtin_amdgcn_cvt_pk_fp8_f32(p1[4 * k], p1[4 * k + 1], 0, false); v = __builtin_amdgcn_cvt_pk_fp8_f32(p1[4 * k + 2], p1[4 * k + 3], v, true); pa[4 + k] = v; }
}
__host__ __device__ __forceinline__ int vpos(int t) { return 32 * ((t >> 2) & 1) + (t & 3) + 4 * ((t >> 3) & 3) + 16 * (t >> 5); }
template <int NR> __device__ __forceinline__ void qkt(f32x16& p0, f32x16& p1, const char* Kn, const char* Kr, const bf16x8* qr, int r32, int hi) {
  p0 = f32x16{}; p1 = f32x16{};
#pragma unroll
  for (int d0 = 0; d0 < 8; ++d0) { int cb = (d0 * 16 + hi * 8) * 2;
    bf16x8 b0 = *reinterpret_cast<const bf16x8*>(Kn + KSWZ(r32, cb));
    bf16x8 b1 = *reinterpret_cast<const bf16x8*>(Kn + KSWZ(32 + r32, cb));
    p0 = __builtin_amdgcn_mfma_f32_32x32x16_bf16(b0, qr[d0], p0, 0, 0, 0);
    p1 = __builtin_amdgcn_mfma_f32_32x32x16_bf16(b1, qr[d0], p1, 0, 0, 0); }
#pragma unroll
  for (int d0 = 0; d0 < NR; ++d0) { int c = d0 * 2 + hi;
    bf16x8 b0 = *reinterpret_cast<const bf16x8*>(Kr + KRSWZ(r32, c));
    bf16x8 b1 = *reinterpret_cast<const bf16x8*>(Kr + KRSWZ(32 + r32, c));
    p0 = __builtin_amdgcn_mfma_f32_32x32x16_bf16(b0, qr[8 + d0], p0, 0, 0, 0);
    p1 = __builtin_amdgcn_mfma_f32_32x32x16_bf16(b1, qr[8 + d0], p1, 0, 0, 0); }
}
__device__ __forceinline__ int v_st(int k, int c) { const int kk = (k & ~0xC) | ((k & 4) << 1) | ((k & 8) >> 1); return ((kk >> 3) * 4 + (c >> 5)) * 512 + ((kk & 7) * 32 + (c & 31)) * 2; }
__device__ __forceinline__ int v_rd_base(int lane) { return ((lane & 3) << 3) | (((lane >> 2) & 3) << 6) | (((lane >> 4) & 1) << 5) | (((lane >> 5) & 1) << 8); }
constexpr int v_rd_off(int d0, int ks, int half) { return d0 * 512 + ks * 4096 + half * 2048; }
template <int OFF> __device__ __forceinline__ s16x4 tr_read(int vb) {
  s16x4 r; asm volatile("ds_read_b64_tr_b16 %0, %1 offset:%2" : "=&v"(r) : "v"(vb), "i"(OFF) : "memory"); return r;
}
template <int D0> __device__ __forceinline__ void pv_one(f32x16& od, int vb, bf16x8 pa0, bf16x8 pa1, bf16x8 pa2, bf16x8 pa3) {
  const s16x4 l0 = tr_read<v_rd_off(D0, 0, 0)>(vb), h0 = tr_read<v_rd_off(D0, 0, 1)>(vb), l1 = tr_read<v_rd_off(D0, 1, 0)>(vb), h1 = tr_read<v_rd_off(D0, 1, 1)>(vb);
  const s16x4 l2 = tr_read<v_rd_off(D0, 2, 0)>(vb), h2 = tr_read<v_rd_off(D0, 2, 1)>(vb), l3 = tr_read<v_rd_off(D0, 3, 0)>(vb), h3 = tr_read<v_rd_off(D0, 3, 1)>(vb);
  asm volatile("s_waitcnt lgkmcnt(0)" ::: "memory"); SBAR();
#define PK(L, H) (bf16x8){L[0], L[1], L[2], L[3], H[0], H[1], H[2], H[3]}
  od = __builtin_amdgcn_mfma_f32_32x32x16_bf16(pa0, PK(l0, h0), od, 0, 0, 0);
  od = __builtin_amdgcn_mfma_f32_32x32x16_bf16(pa1, PK(l1, h1), od, 0, 0, 0);
  od = __builtin_amdgcn_mfma_f32_32x32x16_bf16(pa2, PK(l2, h2), od, 0, 0, 0);
  od = __builtin_amdgcn_mfma_f32_32x32x16_bf16(pa3, PK(l3, h3), od, 0, 0, 0);
#undef PK
}
__device__ __forceinline__ void pv_d0(f32x16* o, int vb, bf16x8 pa0, bf16x8 pa1, bf16x8 pa2, bf16x8 pa3) {
  pv_one<0>(o[0], vb, pa0, pa1, pa2, pa3); pv_one<1>(o[1], vb, pa0, pa1, pa2, pa3); pv_one<2>(o[2], vb, pa0, pa1, pa2, pa3); pv_one<3>(o[3], vb, pa0, pa1, pa2, pa3);
}
__device__ __forceinline__ void store_o_bf16(const f32x16* o, float l_reg, float* wsf, char* stg, bf16* Ow, long rstride, int lane_in, int, int) {
  int lane = lane_in; asm volatile("" : "+v"(lane)); const int r32 = lane & 31, hi = lane >> 5;
  if (hi == 0) wsf[r32] = l_reg; asm volatile("s_waitcnt lgkmcnt(0)" ::: "memory");
  float rli[16];
#pragma unroll
  for (int r = 0; r < 16; ++r) rli[r] = __builtin_amdgcn_rcpf(wsf[crow(r, hi)]);
  unsigned short* st = (unsigned short*)stg;
#pragma unroll
  for (int r = 0; r < 16; ++r) { const int orow = crow(r, hi);
#pragma unroll
    for (int d0 = 0; d0 < 4; ++d0) { const float v = o[d0][r] * rli[r]; st[orow * 128 + d0 * 32 + r32] = (unsigned short)(cvtpk(v, v) & 0xffffu); } }
  asm volatile("s_waitcnt lgkmcnt(0)" ::: "memory");
#pragma unroll
  for (int i = 0; i < 8; ++i) { const int row = i * 4 + (lane >> 4), ch = lane & 15; const u32x4 v = *(const u32x4*)(stg + row * 256 + ch * 16); *(u32x4*)(Ow + (long)row * rstride + ch * 8) = v; }
}

typedef __attribute__((address_space(3))) char* lds_ptr;
typedef short v4i16_t __attribute__((ext_vector_type(4)));
__device__ __forceinline__ bf16x8 ldsf(lds_ptr p, int off) { return *(const __attribute__((address_space(3))) bf16x8*)(p + off); }
__device__ __forceinline__ s16x4 vtr(lds_ptr p, int off) { return __builtin_bit_cast(s16x4, __builtin_amdgcn_ds_read_tr16_b64_v4i16((__attribute__((address_space(3))) v4i16_t*)(p + off))); }
template <int S> __device__ __forceinline__ void kld(bf16x8& lo, bf16x8& hi_, lds_ptr Kn, lds_ptr Kr, int rown, int tn, int rowr, int tr) {
  if constexpr (S < 8) { const int off = rown + (((S & 3) * 32) ^ tn) + (S >> 2) * 128; lo = ldsf(Kn, off); hi_ = ldsf(Kn, off + 8192); }
  else { const int off = rowr + (((S - 8) * 32) ^ tr); lo = ldsf(Kr, off); hi_ = ldsf(Kr, off + 4096); }
}
template <int NS> __device__ __forceinline__ void qkt_ring(f32x16& p0, f32x16& p1, lds_ptr Kn, lds_ptr Kr, const bf16x8* qr, int r32, int hi) {
  const int rown = r32 * 256, tn = (hi * 16) ^ ((r32 & 7) << 4), rowr = r32 * 128, tr = (hi ^ ((r32 >> 1) & 7)) << 4;
  bf16x8 a0, a1, b0, b1, c0, c1;
  p0 = f32x16{}; p1 = f32x16{};
  kld<0>(a0, a1, Kn, Kr, rown, tn, rowr, tr); kld<1>(b0, b1, Kn, Kr, rown, tn, rowr, tr);
#define QSTEP(S, C0, C1, N0, N1) do { if constexpr ((S) < NS) { if constexpr ((S) + 2 < NS) kld<((S) + 2 < NS ? (S) + 2 : 0)>(N0, N1, Kn, Kr, rown, tn, rowr, tr); SBAR(); \
    p0 = __builtin_amdgcn_mfma_f32_32x32x16_bf16(C0, qr[(S) < NS ? (S) : 0], p0, 0, 0, 0); p1 = __builtin_amdgcn_mfma_f32_32x32x16_bf16(C1, qr[(S) < NS ? (S) : 0], p1, 0, 0, 0); SBAR(); } } while (0)
  QSTEP(0, a0, a1, c0, c1); QSTEP(1, b0, b1, a0, a1); QSTEP(2, c0, c1, b0, b1); QSTEP(3, a0, a1, c0, c1); QSTEP(4, b0, b1, a0, a1); QSTEP(5, c0, c1, b0, b1);
  QSTEP(6, a0, a1, c0, c1); QSTEP(7, b0, b1, a0, a1); QSTEP(8, c0, c1, b0, b1); QSTEP(9, a0, a1, c0, c1); QSTEP(10, b0, b1, a0, a1); QSTEP(11, c0, c1, b0, b1);
#undef QSTEP
}
#define VOFF(i, half) v_rd_off((i) >> 2, (i) & 3, half)
__device__ __forceinline__ void pv_ring_pre(lds_ptr vp, s16x4& la, s16x4& ha, s16x4& lb, s16x4& hb) { la = vtr(vp, VOFF(0, 0)); ha = vtr(vp, VOFF(0, 1)); lb = vtr(vp, VOFF(1, 0)); hb = vtr(vp, VOFF(1, 1)); }
__device__ __forceinline__ void pv_ring(f32x16* o, lds_ptr vp, s16x4 la, s16x4 ha, s16x4 lb, s16x4 hb, bf16x8 pa0, bf16x8 pa1, bf16x8 pa2, bf16x8 pa3) {
  s16x4 lc, hc;
#define PKV(L, H) (bf16x8){L[0], L[1], L[2], L[3], H[0], H[1], H[2], H[3]}
#define PSTEP(I, PA, CL, CH, NL, NH) do { if constexpr ((I) + 2 < 16) { NL = vtr(vp, VOFF(((I) + 2) & 15, 0)); NH = vtr(vp, VOFF(((I) + 2) & 15, 1)); } SBAR(); \
    o[(I) >> 2] = __builtin_amdgcn_mfma_f32_32x32x16_bf16(PA, PKV(CL, CH), o[(I) >> 2], 0, 0, 0); SBAR(); } while (0)
  PSTEP(0, pa0, la, ha, lc, hc);  PSTEP(1, pa1, lb, hb, la, ha);  PSTEP(2, pa2, lc, hc, lb, hb);  PSTEP(3, pa3, la, ha, lc, hc);
  PSTEP(4, pa0, lb, hb, la, ha);  PSTEP(5, pa1, lc, hc, lb, hb);  PSTEP(6, pa2, la, ha, lc, hc);  PSTEP(7, pa3, lb, hb, la, ha);
  PSTEP(8, pa0, lc, hc, lb, hb);  PSTEP(9, pa1, la, ha, lc, hc);  PSTEP(10, pa2, lb, hb, la, ha); PSTEP(11, pa3, lc, hc, lb, hb);
  PSTEP(12, pa0, la, ha, lc, hc); PSTEP(13, pa1, lb, hb, la, ha); PSTEP(14, pa2, lc, hc, lb, hb); PSTEP(15, pa3, la, ha, lc, hc);
#undef PSTEP
#undef PKV
}
constexpr int M_V = 0, M_KN = 24576, M_KR = 49152, M_WS = 65536, MLA_LDS_BYTES = 67584;
typedef int i32x4_t __attribute__((ext_vector_type(4)));
typedef int i32x8_t __attribute__((ext_vector_type(8)));
__device__ __forceinline__ void glds16(const void* gsrc, unsigned lds_dst) { unsigned keep;
  asm volatile("s_mov_b32 %0, m0\n\ts_mov_b32 m0, %2\n\ts_nop 0\n\tglobal_load_lds_dwordx4 %1, off\n\ts_mov_b32 m0, %0" : "=&s"(keep) : "v"(gsrc), "s"(lds_dst) : "memory"); }
#define WAIT_BAR(N) asm volatile("s_waitcnt vmcnt(" #N ") lgkmcnt(0)\n\ts_barrier" ::: "memory")
__device__ __forceinline__ i32x4_t ldsq(lds_ptr p, int off) { return *(const __attribute__((address_space(3))) i32x4_t*)(p + off); }
#define CAT8(lo, hi) __builtin_shufflevector(lo, hi, 0, 1, 2, 3, 4, 5, 6, 7)
__device__ __forceinline__ void qkt_f8(f32x16& p0, f32x16& p1, lds_ptr Kn, lds_ptr Kr, const i32x8_t* q8, int r32, int hi, int sc) {
  const int swn = (r32 >> 1) & 7, swr = (r32 >> 2) & 3, rown = r32 * 128, rowr = r32 * 64;
  i32x8_t kf[6];
#pragma unroll
  for (int kb = 0; kb < 2; ++kb) {
#pragma unroll
    for (int c = 0; c < 2; ++c) { const int ci = c * 4 + 2 * hi; kf[kb * 3 + c] = CAT8(ldsq(Kn, kb * 4096 + rown + ((ci ^ swn) << 4)), ldsq(Kn, kb * 4096 + rown + (((ci + 1) ^ swn) << 4))); }
    { const int ci = 2 * hi; kf[kb * 3 + 2] = CAT8(ldsq(Kr, kb * 2048 + rowr + ((ci ^ swr) << 4)), ldsq(Kr, kb * 2048 + rowr + (((ci + 1) ^ swr) << 4))); }
  }
#define MF0(P, A, B) asm volatile("v_mfma_scale_f32_32x32x64_f8f6f4 %0, %1, %2, 0, %3, %3 op_sel_hi:[0,0,0]" : "=&v"(P) : "v"(A), "v"(B), "v"(sc))
#define MF1(P, A, B) asm volatile("v_mfma_scale_f32_32x32x64_f8f6f4 %0, %1, %2, %0, %3, %3 op_sel_hi:[0,0,0]" : "+v"(P) : "v"(A), "v"(B), "v"(sc))
  MF0(p0, kf[0], q8[0]); MF0(p1, kf[3], q8[0]); MF1(p0, kf[1], q8[1]); MF1(p1, kf[4], q8[1]); MF1(p0, kf[2], q8[2]); MF1(p1, kf[5], q8[2]);
  asm volatile("s_nop 15\n\ts_nop 7" : "+v"(p0), "+v"(p1));
#undef MF0
#undef MF1
}
__device__ __forceinline__ void pv_f8(f32x16* o, lds_ptr Vt, i32x8_t pa, int r32, int hi, int sc) {
  i32x8_t vf[4];
#pragma unroll
  for (int d0 = 0; d0 < 4; ++d0) { const int d = 32 * d0 + r32, sw = (d >> 2) & 3, ci = 2 * hi; vf[d0] = CAT8(ldsq(Vt, d * 64 + ((ci ^ sw) << 4)), ldsq(Vt, d * 64 + (((ci + 1) ^ sw) << 4))); }
#pragma unroll
  for (int d0 = 0; d0 < 4; ++d0) asm volatile("v_mfma_scale_f32_32x32x64_f8f6f4 %0, %1, %2, %0, %3, %3 op_sel_hi:[0,0,0]" : "+v"(o[d0]) : "v"(pa), "v"(vf[d0]), "v"(sc));
}
__device__ __forceinline__ void mla_unit(const unsigned char* __restrict__ Q8b, const unsigned char* __restrict__ K8h, const unsigned char* __restrict__ Vth, const unsigned char* __restrict__ KR8h, bf16* __restrict__ Ob, char* lds) {
  constexpr int LDQ = 192, LDK = 128, LDR = 64, LDO = 3072, SHM_V = 8192, SHM_K = 8192, SHM_R = 4096;
  const int tid = threadIdx.x, wid = __builtin_amdgcn_readfirstlane(tid >> 6), lane = tid & 63, r32 = lane & 31, hi = lane >> 5;
  const lds_ptr l3 = (lds_ptr)lds; const unsigned lds0 = (unsigned)(uintptr_t)lds;
  float* ws = (float*)(lds + M_WS) + wid * 64; float* al_l = ws + 32;
  float m_reg = -1e30f, l_reg = 0; f32x16 o[4] = {}; i32x8_t q8[3];
  int sc = 0x7f7f7f7f; asm volatile("" : "+v"(sc));
  const unsigned char *pk, *pr, *pv;
  { const int rk = 8 * wid + (lane >> 3); pk = K8h + (long)rk * LDK + (((lane & 7) ^ ((rk >> 1) & 7)) << 4);
    const int rr = 8 * wid + ((lane & 31) >> 2); pr = KR8h + (long)rr * LDR + (((lane & 3) ^ ((rr >> 2) & 3)) << 4);
    const int dv_ = 16 * wid + (lane >> 2); pv = Vth + (long)dv_ * 64 + (((lane & 3) ^ ((dv_ >> 2) & 3)) << 4); }
#define DMA_K(slot) do { const unsigned dk = (unsigned)__builtin_amdgcn_readfirstlane((int)(lds0 + M_KN + (slot) * SHM_K + wid * 1024)), dr = (unsigned)__builtin_amdgcn_readfirstlane((int)(lds0 + M_KR + (slot) * SHM_R + wid * 512)); \
    glds16(pk, dk); if (lane < 32) glds16(pr, dr); pk += KVBLK * LDK; pr += KVBLK * LDR; } while (0)
#define DMA_V(slot) do { const unsigned dv = (unsigned)__builtin_amdgcn_readfirstlane((int)(lds0 + M_V + (slot) * SHM_V + wid * 1024)); glds16(pv, dv); pv += 8192; } while (0)
  DMA_V(0); DMA_K(0); DMA_K(1);
  { const unsigned char* Qw = Q8b + (long)(wid * QBLK + r32) * LDQ + 32 * hi;
#pragma unroll
    for (int c = 0; c < 3; ++c) q8[c] = CAT8(*(const i32x4_t*)(Qw + c * 64), *(const i32x4_t*)(Qw + c * 64 + 16)); }
#define RESC(a) do { if (__any((a) < 1.f)) { if (hi == 0) al_l[r32] = (a); asm volatile("s_waitcnt lgkmcnt(0)" ::: "memory"); \
    _Pragma("unroll") for (int d = 0; d < 4; ++d) _Pragma("unroll") for (int r = 0; r < 16; ++r) o[d][r] *= al_l[crow(r, hi)]; } } while (0)
  f32x16 p0, p1; float mn, al; i32x8_t pa8 = {}; constexpr int NT = SEQ / KVBLK;
  WAIT_BAR(2);
  const bool late = wid >= 4;
  int s_cur = 0, s_nx1 = 1, s_nx2 = 2, s_prev = 2;
#pragma clang loop unroll(disable)
  for (int j = 0; j < NT; ++j) {
    const bool more2 = (j + 2 < NT);
    if (j + 1 < NT) DMA_V(s_nx1);
    if (more2) DMA_K(s_nx2);
    SBAR();
    if (late) { if (j > 0) pv_f8(o, l3 + M_V + s_prev * SHM_V, pa8, r32, hi, sc); }
    SBAR();
    qkt_f8(p0, p1, l3 + M_KN + s_cur * SHM_K, l3 + M_KR + s_cur * SHM_R, q8, r32, hi, sc);
    partialSM<true>(p0, p1, m_reg, mn, al); RESC(al);
    finishSM_f8(p0, p1, al, l_reg, pa8); SBAR();
    if (!late) pv_f8(o, l3 + M_V + s_cur * SHM_V, pa8, r32, hi, sc);
    SBAR();
    if (more2) WAIT_BAR(2); else WAIT_BAR(0);
    s_prev = s_cur; s_cur = s_nx1; s_nx1 = s_nx2; s_nx2 = (s_nx2 == 2) ? 0 : s_nx2 + 1;
  }
  if (late) pv_f8(o, l3 + M_V + s_prev * SHM_V, pa8, r32, hi, sc);
  asm volatile("s_nop 15\n\ts_nop 7" : "+v"(o[0]), "+v"(o[1]), "+v"(o[2]), "+v"(o[3]));
  WAIT_BAR(0);
  store_o_bf16(o, l_reg, ws, lds + wid * 8192, Ob + (long)(wid * QBLK) * LDO, LDO, lane, r32, hi);
  __syncthreads();
#undef DMA_K
#undef DMA_V
}
#undef CAT8
#undef WAIT_BAR

__device__ __forceinline__ void dil_unit(int b, int g, int h, int rho, int blk, const bf16* __restrict__ QD, const bf16* __restrict__ KD, const bf16* __restrict__ VD, bf16* __restrict__ PD, float* __restrict__ LSE, char* lds) {
  constexpr float C = SCALE_DIL * 1.4426950408889634f;
  const int d = (g == 0) ? 1 : (g == 1 ? 4 : 16), L = SEQ / d, t0 = blk * 256;
  const int tid = threadIdx.x, wid = __builtin_amdgcn_readfirstlane(tid >> 6), lane = tid & 63, r32 = lane & 31, hi = lane >> 5;
  const lds_ptr l3 = (lds_ptr)lds; char* V_lds = lds + L_V; char* K_lds = lds + L_KN;
  float* ws = (float*)(lds + L_WS) + wid * 64; float* al_l = ws + 32;
  const long tokbase = (long)b * SEQ; const long hbase = ((long)(b * 24 + g * 8 + h) * SEQ) * 128;
  float m_reg = -1e30f, l_reg = 0; f32x16 o[4] = {}; bf16x8 qr[8];
  const int tauq = t0 + wid * QBLK + r32;
  { const bf16* Qw = QD + hbase + (rho + (long)d * tauq) * 128 + hi * 8;
#pragma unroll
    for (int d0 = 0; d0 < 8; ++d0) qr[d0] = ld8(Qw + d0 * 16); }
  const int kt0 = (t0 == 0) ? 1 : 0, kt1 = ((L - t0) >> 6) < 5 ? ((L - t0) >> 6) : 5;
  bf16x8 s_ka, s_kb, s_va, s_vb;
#define DLOAD(kt_) do { int t_ = tid; asm volatile("" : "+v"(t_)); const int sr = t_ >> 4, sc = (t_ & 15) * 8, kb_ = t0 - 64 + 64 * (kt_); int ta = kb_ + sr, tb = ta + 32; \
    ta = ta < 0 ? 0 : (ta >= L ? L - 1 : ta); tb = tb < 0 ? 0 : (tb >= L ? L - 1 : tb); \
    const long oa = hbase + (rho + (long)d * ta) * 128 + sc, ob = hbase + (rho + (long)d * tb) * 128 + sc; s_ka = ld8(KD + oa); s_kb = ld8(KD + ob); s_va = ld8(VD + oa); s_vb = ld8(VD + ob); } while (0)
#define DWRITE(buf) do { int t_ = tid; asm volatile("" : "+v"(t_)); const int sr = t_ >> 4, sc = (t_ & 15) * 8, vst0 = v_st(sr, sc), kc = sc * 2; \
    *(bf16x8*)(V_lds + (buf) * 16384 + vst0) = s_va; *(bf16x8*)(V_lds + (buf) * 16384 + vst0 + 8192) = s_vb; *(bf16x8*)(K_lds + (buf) * 16384 + KSWZ(sr, kc)) = s_ka; *(bf16x8*)(K_lds + (buf) * 16384 + KSWZ(sr, kc) + 8192) = s_kb; } while (0)
  DLOAD(kt0); DWRITE(0); __syncthreads();
  int buf = 0;
  for (int kt = kt0; kt <= kt1; ++kt) {
    const bool more = kt < kt1;
    if (more) DLOAD(kt + 1);
    SBAR();
    if (kt >= (wid >> 1) && kt <= (wid >> 1) + 2) {
      f32x16 p0, p1; float mn, al; bf16x8 pa0, pa1, pa2, pa3; const int kbase = t0 - 64 + 64 * kt;
      qkt_ring<8>(p0, p1, l3 + L_KN + buf * 16384, l3 + L_KN, qr, r32, hi);
      s16x4 vla, vha, vlb, vhb; const lds_ptr vp_ = l3 + L_V + buf * 16384 + v_rd_base(lane); pv_ring_pre(vp_, vla, vha, vlb, vhb);
      const int dl0 = kbase - tauq;
#pragma unroll
      for (int r = 0; r < 16; ++r) { const int kk = crow(r, hi); const int dl = dl0 + kk, tp = kbase + kk;
        if (!(dl >= -64 && dl <= 64 && tp >= 0 && tp < L)) p0[r] = -1e30f;
        if (!(dl + 32 >= -64 && dl + 32 <= 64 && tp + 32 >= 0 && tp + 32 < L)) p1[r] = -1e30f; }
      partialSM<false>(p0, p1, m_reg, mn, al);
      RESC(al);
      finishSM(p0, p1, al, l_reg, pa0, pa1, pa2, pa3); SBAR();
      pv_ring(o, vp_, vla, vha, vlb, vhb, pa0, pa1, pa2, pa3);
    }
    if (more) DWRITE(buf ^ 1);
    __syncthreads();
    buf ^= 1;
  }
  if (hi == 0) LSE[((long)g * MTOK + tokbase + rho + (long)d * tauq) * 8 + h] = m_reg * C + __builtin_amdgcn_logf(l_reg);
  store_o_bf16(o, l_reg, ws, lds + wid * 8192, PD + ((long)g * MTOK + tokbase + rho + (long)d * (t0 + wid * QBLK)) * 1024 + h * 128, (long)d * 1024, lane, r32, hi);
  __syncthreads();
#undef DLOAD
#undef DWRITE
#undef RESC
}
#undef SBAR
}

#define GAS __attribute__((address_space(1)))
#define LAS __attribute__((address_space(3)))
typedef unsigned short bf16;
typedef unsigned v4u __attribute__((ext_vector_type(4)));
typedef float f32x4 __attribute__((ext_vector_type(4)));
typedef short bf16x8 __attribute__((ext_vector_type(8)));
typedef GAS unsigned gu32;
typedef GAS unsigned long long gu64;
#define RLX_AGENT __ATOMIC_RELAXED, __HIP_MEMORY_SCOPE_AGENT
#define LDS_WAIT() asm volatile("s_waitcnt lgkmcnt(0)" ::: "memory")
#define VM_WAIT() asm volatile("s_waitcnt vmcnt(0)" ::: "memory")
__device__ __forceinline__ unsigned long long rt() { return __builtin_amdgcn_s_memrealtime(); }
__device__ __forceinline__ unsigned f2bf(float f) { unsigned u = __builtin_bit_cast(unsigned, f); return (u + 0x7fffu + ((u >> 16) & 1u)) >> 16; }
__device__ __forceinline__ unsigned pk2(float lo, float hi) { return f2bf(lo) | (f2bf(hi) << 16); }

#define XB_TMO      128
#define XB_XCNT(j)  (256  + 64 * (j))
#define XB_XSUB(j)  (1280 + 64 * (j))
#define XB_XGEN(j)  (2304 + 64 * (j))
#define XB_TOP      3328
#define XB_TOPGEN   3392
#define XCD_BAR_WORDS 3456
#define XB_SPIN_CAP (1u << 18)

__device__ __forceinline__ unsigned xb_ld(unsigned* p)              { return __hip_atomic_load(p, __ATOMIC_RELAXED, __HIP_MEMORY_SCOPE_AGENT); }
__device__ __forceinline__ unsigned xb_add(unsigned* p, unsigned v) { return __hip_atomic_fetch_add(p, v, __ATOMIC_RELAXED, __HIP_MEMORY_SCOPE_AGENT); }
__device__ __forceinline__ unsigned xb_xcc_id() { return (unsigned)__builtin_amdgcn_s_getreg((3 << 11) | 20) & 0xFu; }
#define XB_SPIN(cond, bar) do { unsigned _sp = 0; while (cond) { __builtin_amdgcn_s_sleep(1); \
    if ((++_sp & 255u) == 0u) { if (xb_ld(&(bar)[XB_TMO])) break; if (_sp > XB_SPIN_CAP) { atomicAdd(&(bar)[XB_TMO], 1u); break; } } } } while (0)

struct XcdBarrier {
    unsigned* bar; unsigned x;
    volatile LAS unsigned* st;
};

__device__ __forceinline__ XcdBarrier xcd_barrier_post(unsigned* bar, volatile LAS unsigned* st) {
    XcdBarrier b; b.bar = bar; b.x = xb_xcc_id(); b.st = st;
    if (threadIdx.x == 0) (void)xb_add(&bar[XB_XCNT(b.x)], 1u);
    return b;
}
__device__ __forceinline__ void xcd_barrier_complete(unsigned* bar, unsigned x, unsigned& nloc, unsigned& nx) {
    const unsigned G = gridDim.x * gridDim.y * gridDim.z;
    unsigned sum, cnt, mine, sp = 0u;
    for (;;) {
        sum = 0u; cnt = 0u; mine = 0u;
#pragma unroll
        for (unsigned j = 0; j < 16; ++j) { const unsigned c = xb_ld(&bar[XB_XCNT(j)]); sum += c; cnt += (c > 0u) ? 1u : 0u; mine = (j == x) ? c : mine; }
        if (sum == G) break;
        __builtin_amdgcn_s_sleep(1);
        if ((++sp & 255u) == 0u) { if (xb_ld(&bar[XB_TMO])) break; if (sp > XB_SPIN_CAP) { atomicAdd(&bar[XB_TMO], 1u); break; } }
    }
    nloc = mine > 0u ? mine : 1u; nx = cnt > 0u ? cnt : 1u;
}

__device__ __forceinline__ void xcd_barrier(const XcdBarrier& b) {
    asm volatile("s_waitcnt vmcnt(0)" ::: "memory");
    __syncthreads();
    if (threadIdx.x == 0) {
        unsigned* bar = b.bar;
        __builtin_amdgcn_s_waitcnt(0);
        unsigned nloc = b.st[0], nx = b.st[1];
        if (nloc == 0u) { xcd_barrier_complete(bar, b.x, nloc, nx); b.st[0] = nloc; b.st[1] = nx; }
        const unsigned old = xb_add(&bar[XB_XSUB(b.x)], 1u);
        const unsigned gen = old / nloc;
        if (old + 1u == (gen + 1u) * nloc) {
            __builtin_amdgcn_fence(__ATOMIC_RELEASE, "agent");
            asm volatile("s_waitcnt vmcnt(0)" ::: "memory");
            const unsigned og = xb_add(&bar[XB_TOP], 1u);
            const unsigned tg = og / nx;
            if (og + 1u == (tg + 1u) * nx) xb_add(&bar[XB_TOPGEN], 1u);
            else XB_SPIN(xb_ld(&bar[XB_TOPGEN]) == tg, bar);
            __builtin_amdgcn_fence(__ATOMIC_ACQUIRE, "agent");
            xb_add(&bar[XB_XGEN(b.x)], 1u);
            asm volatile("s_waitcnt vmcnt(0)" ::: "memory");
        } else {
            XB_SPIN(xb_ld(&bar[XB_XGEN(b.x)]) == gen, bar);
            __builtin_amdgcn_fence(__ATOMIC_ACQUIRE, "agent");
            asm volatile("s_waitcnt vmcnt(0)" ::: "memory");
        }
    }
    __syncthreads();
}

constexpr int NWAVES = 8;
constexpr int BATCH = 4, SEQ = 4096, DM = 4096, M = BATCH * SEQ;
constexpr int QRANK = 1024, KVRANK = 512, DFF = 11008, IN_TOTAL = 19008, N_IN = 19200  , N_MOD = 6 * DM;
constexpr float NORM_EPS = 1e-6f;
#ifndef PG_ALIGN
#define PG_ALIGN true
#endif
#ifndef PG_SP2
#define PG_SP2 true
#endif
#ifdef SELFCHECK
#define HB_OR_NULL(p) (p)
#else
#define HB_OR_NULL(p) (pg8::P3_NBF > 0 ? (p) : nullptr)
#endif
#ifndef CHK_MASK
#define CHK_MASK 0xffffffff
#endif
#ifndef MK_N_LAUNCHES
#define MK_N_LAUNCHES 1
#endif
constexpr int PER_PHASE = 14;
constexpr int N_LAUNCHES = MK_N_LAUNCHES;
static_assert(N_LAUNCHES == 1 || N_LAUNCHES == PER_PHASE, "MK_N_LAUNCHES is 1 or 14");

constexpr size_t MiB = 1u << 20;
constexpr size_t WS_CTL = 0, CTL_ZERO_BYTES = 1 * MiB;
constexpr size_t WS_MOD = 1 * MiB;
constexpr size_t WS_VEC = WS_MOD + 4 * N_MOD * 4;
constexpr size_t WS_COSF = 2 * MiB, WS_SINF = 6 * MiB;
constexpr size_t WS_COSR = 10 * MiB, WS_SINR = 12 * MiB;
constexpr size_t WS_KROPE = 14 * MiB;
constexpr size_t WS_LSE = 16 * MiB;
constexpr size_t WS_MODP = 18 * MiB;
constexpr int KSPLIT = 64;
constexpr size_t WS_WIN = 48 * MiB, WS_WUQ = 198 * MiB, WS_WUKV = 204 * MiB, WS_WPA = 208 * MiB, WS_WPB = 224 * MiB, WS_WOUT = 232 * MiB, WS_WGU = 264 * MiB, WS_WDN = 436 * MiB;
constexpr size_t WS_A = 522 * MiB;
constexpr size_t WS_QD = 650 * MiB, WS_KD = 746 * MiB, WS_VD = 842 * MiB;
constexpr size_t WS_GA = 938 * MiB, WS_GB = 1066 * MiB;
constexpr size_t WS_ZQ = 1194 * MiB, WS_ZKV = 1226 * MiB, WS_ZKR = 1242 * MiB, WS_QN = 1250 * MiB, WS_KVN = 1282 * MiB;
constexpr size_t WS_PD = 1194 * MiB;
constexpr size_t WS_KV = 1298 * MiB;
constexpr size_t WS_YA = 1426 * MiB, WS_YB = 1490 * MiB;
constexpr size_t WS_X1B = 1194 * MiB, WS_X2B = 1322 * MiB;
constexpr size_t WS_H8 = 1298 * MiB;
constexpr size_t WS_END = 1522 * MiB;
static_assert(WS_WIN + (size_t)N_IN * DM * 2 <= WS_WUQ && WS_WGU + (size_t)2 * DFF * DM * 2 <= WS_WDN && WS_WDN + (size_t)DM * DFF * 2 <= WS_A, "weights map");
static_assert(WS_QD + (size_t)M * DFF * 2 <= WS_ZQ && WS_PD + (size_t)3 * M * 1024 * 2 <= WS_KV && WS_KV + (size_t)M * 4096 * 2 <= WS_YA && WS_YB + (size_t)M * 1024 * 2 <= WS_END, "activation map");
static_assert(WS_MODP + (size_t)KSPLIT * 4 * N_MOD * 4 <= WS_WIN && WS_VEC + 6 * 4 * DM * 4 <= WS_COSF, "misc map");
constexpr int CW_BAR = 4096;
constexpr int P11_T8 = 86;

constexpr int RING_OFF = 0, RING_BYTES = 131072;
constexpr int LDSCTL_OFF = RING_BYTES, MISC_OFF = LDSCTL_OFF + 320;
constexpr int LDS_BYTES = 147456;
static_assert(MISC_OFF + 128 <= LDS_BYTES && att::ATT_LDS_BYTES <= RING_BYTES && att::MLA_LDS_BYTES <= RING_BYTES, "LDS map");

__device__ const float INVF[64] = {
1.000000000e+00f, 8.659643531e-01f, 7.498942018e-01f, 6.493816376e-01f, 5.623413324e-01f, 4.869675338e-01f, 4.216965139e-01f, 3.651741147e-01f, 3.162277639e-01f, 2.738419771e-01f, 2.371373773e-01f, 2.053525001e-01f, 1.778279394e-01f, 1.539926529e-01f, 1.333521456e-01f, 1.154781953e-01f,
1.000000015e-01f, 8.659642935e-02f, 7.498942316e-02f, 6.493816525e-02f, 5.623413250e-02f, 4.869675264e-02f, 4.216964915e-02f, 3.651741147e-02f, 3.162277490e-02f, 2.738419548e-02f, 2.371373773e-02f, 2.053525113e-02f, 1.778279431e-02f, 1.539926510e-02f, 1.333521400e-02f, 1.154781971e-02f,
9.999999776e-03f, 8.659643121e-03f, 7.498942316e-03f, 6.493816152e-03f, 5.623413250e-03f, 4.869675264e-03f, 4.216964822e-03f, 3.651741194e-03f, 3.162277630e-03f, 2.738419687e-03f, 2.371373819e-03f, 2.053525066e-03f, 1.778279431e-03f, 1.539926510e-03f, 1.333521446e-03f, 1.154782018e-03f,
1.000000047e-03f, 8.659643354e-04f, 7.498941850e-04f, 6.493816036e-04f, 5.623413017e-04f, 4.869675322e-04f, 4.216965172e-04f, 3.651741135e-04f, 3.162277571e-04f, 2.738419571e-04f, 2.371373703e-04f, 2.053525095e-04f, 1.778279402e-04f, 1.539926598e-04f, 1.333521504e-04f, 1.154782003e-04f };

struct Frame {
    LAS unsigned char* lds;
    volatile LAS unsigned* MISC;
    gu32* ctl;
    int tid, lane, wave;
    int vcu, G;
};
__device__ __forceinline__ float wave_sum(float v) {
#pragma unroll
    for (int o = 1; o < 64; o <<= 1) v += __shfl_xor(v, o);
    return v;
}
__device__ __forceinline__ float wave_max(float v) {
#pragma unroll
    for (int o = 1; o < 64; o <<= 1) v = fmaxf(v, __shfl_xor(v, o));
    return v;
}
__device__ __forceinline__ unsigned pk4_i8(float a, float b, float c, float d) {
    const int ia = __float2int_rn(a), ib = __float2int_rn(b), ic = __float2int_rn(c), id = __float2int_rn(d);
    return ((unsigned)ia & 0xffu) | (((unsigned)ib & 0xffu) << 8) | (((unsigned)ic & 0xffu) << 16) | ((unsigned)id << 24); }
__device__ __forceinline__ void sincos_d(double a, float& s, float& c) {
    const double n = __builtin_rint(a * 0.63661977236758134308);
    const double r = (a - n * 1.57079632673412561417e+00) - n * 6.07710050650619224932e-11;
    const double z = r * r;
    const double sp = r + r * z * (-1.66666666666666324348e-01 + z * (8.33333333332248946124e-03 + z * (-1.98412698298579493134e-04 + z * (2.75573137070700676789e-06 + z * (-2.50507602534068634195e-08 + z * 1.58969099521155010221e-10)))));
    const double cp = 1.0 - 0.5 * z + z * z * (4.16666666666666019037e-02 + z * (-1.38888888888741095749e-03 + z * (2.48015872894767294178e-05 + z * (-2.75573143513906633035e-07 + z * (2.08757232129817482790e-09 + z * -1.13596475577881948265e-11)))));
    const int q = ((int)n) & 3;
    const double ss = (q & 1) ? cp : sp, cc = (q & 1) ? sp : cp;
    s = (float)((q & 2) ? -ss : ss); c = (float)(((q + 1) & 2) ? -cc : cc);
}
constexpr int NBF = pg8::P3_NBF;
__device__ __forceinline__ int win_row8(int r);
__device__ __forceinline__ int map_row_in(int n) {
    if (n < 1536) return n;
    if (n < 1600) { const int r = n - 1536; return 74 * 256 + (r >> 5) * 128 + (r & 31); }
    if (n < 10816) { const int r = n - 1600, t = r / 3072, rr = r - t * 3072;
        if (t < 2) { const int hd = rr >> 7, dd = rr & 127; return (6 + t * 12 + (hd >> 1)) * 256 + (dd >> 6) * 128 + (hd & 1) * 64 + (dd & 63); }
        return 30 * 256 + rr; }
    return 42 * 256 + (n - 10816);
}
__device__ __forceinline__ int map_row(int mode, int n) {
    if (mode == 1) return map_row_in(n);
    if (mode == 2) { const int h = n / 192, dd = n - h * 192; if (dd < 128) return h * 128 + dd; const int r = dd - 128; return (8 + (h >> 2)) * 256 + (r >> 5) * 128 + (h & 3) * 32 + (r & 31); }
    if (mode == 5) return map_row_in(n) - 6 * 256;
    if (mode == 6) return win_row8(map_row_in(n));
    if (mode == 3) return (n >> 7) * 256 + (n & 127);
    if (mode == 4) return (n >> 7) * 256 + 128 + (n & 127);
    return n;
}
__device__ __forceinline__ int win_row8(int r) { const int t = r >> 8; return ((t < 6 ? t : t - NBF) << 8) | (r & 255); }
__device__ __forceinline__ void p0_transpose_item(const float* W, int K, int N, bf16* WT, int mode, LAS float* scr, int item, int lane, int ldw = 0) {
    const int nblk = N / 32, kb = item / nblk, nb = item % nblk, k0 = 64 * kb, n0 = 32 * nb;
    float v[32];
#pragma unroll
    for (int i = 0; i < 32; ++i) { const int kk = 2 * i + (lane >> 5); v[i] = W[(size_t)(k0 + kk) * N + n0 + (lane & 31)]; }
#pragma unroll
    for (int i = 0; i < 32; ++i) { const int kk = 2 * i + (lane >> 5); scr[kk * 33 + (lane & 31)] = v[i]; }
    LDS_WAIT(); asm volatile("" ::: "memory");
    const int c = lane & 7;
#pragma unroll
    for (int j = 0; j < 4; ++j) { const int n = (lane >> 3) + 8 * j; const LAS float* s = scr + (8 * c) * 33 + n;
        v4u o; o.x = pk2(s[0 * 33], s[1 * 33]); o.y = pk2(s[2 * 33], s[3 * 33]); o.z = pk2(s[4 * 33], s[5 * 33]); o.w = pk2(s[6 * 33], s[7 * 33]);
        *(GAS v4u*)(WT + (size_t)map_row(mode, n0 + n) * (ldw ? ldw : K) + k0 + 8 * c) = o; }
    LDS_WAIT(); asm volatile("" ::: "memory");
}
__device__ __forceinline__ unsigned pk4_f8(float a, float b, float c, float d) { int w = __builtin_amdgcn_cvt_pk_fp8_f32(a, b, 0, false); w = __builtin_amdgcn_cvt_pk_fp8_f32(c, d, w, true); return (unsigned)w; }
__device__ __forceinline__ void p0_transpose_item_f8(const float* W, int K, int N, unsigned char* W8, int mode, float wscale, LAS float* scr, int item, int lane) {
    const int nblk = N / 32, kb = item / nblk, nb = item % nblk, k0 = 64 * kb, n0 = 32 * nb;
    float v[32];
#pragma unroll
    for (int i = 0; i < 32; ++i) { const int kk = 2 * i + (lane >> 5); v[i] = W[(size_t)(k0 + kk) * N + n0 + (lane & 31)]; }
#pragma unroll
    for (int i = 0; i < 32; ++i) { const int kk = 2 * i + (lane >> 5); scr[kk * 33 + (lane & 31)] = v[i] * wscale; }
    LDS_WAIT(); asm volatile("" ::: "memory");
    const int n = lane >> 1, half = lane & 1; const LAS float* s = scr + (32 * half) * 33 + n;
    v4u o0, o1;
    o0.x = pk4_f8(s[0 * 33], s[1 * 33], s[2 * 33], s[3 * 33]);     o0.y = pk4_f8(s[4 * 33], s[5 * 33], s[6 * 33], s[7 * 33]);     o0.z = pk4_f8(s[8 * 33], s[9 * 33], s[10 * 33], s[11 * 33]);   o0.w = pk4_f8(s[12 * 33], s[13 * 33], s[14 * 33], s[15 * 33]);
    o1.x = pk4_f8(s[16 * 33], s[17 * 33], s[18 * 33], s[19 * 33]); o1.y = pk4_f8(s[20 * 33], s[21 * 33], s[22 * 33], s[23 * 33]); o1.z = pk4_f8(s[24 * 33], s[25 * 33], s[26 * 33], s[27 * 33]); o1.w = pk4_f8(s[28 * 33], s[29 * 33], s[30 * 33], s[31 * 33]);
    GAS v4u* dst = (GAS v4u*)(W8 + (size_t)map_row(mode, n0 + n) * K + k0 + 32 * half); dst[0] = o0; dst[1] = o1;
    LDS_WAIT(); asm volatile("" ::: "memory");
}
__device__ __forceinline__ void wht64_k(float (&v)[32], int lane) {
#pragma unroll
    for (int s = 1; s < 32; s <<= 1)
#pragma unroll
        for (int i = 0; i < 32; ++i) if (!(i & s)) { const float a = v[i], b = v[i | s]; v[i] = a + b; v[i | s] = a - b; }
    const bool hiP = (lane & 32) != 0;
#pragma unroll
    for (int i = 0; i < 32; ++i) { const float o = __shfl_xor(v[i], 32); v[i] = (hiP ? o - v[i] : v[i] + o) * 0.125f; }
}
__device__ __forceinline__ void p0_colmax_item(const float* W, int N, float* CM, int mode, int item, int lane, bool rot = false) {
    const int nblk = N / 32, kb = item / nblk, nb = item % nblk, k0 = 64 * kb, n0 = 32 * nb;
    float v[32];
#pragma unroll
    for (int i = 0; i < 32; ++i) { const int kk = 2 * i + (lane >> 5); v[i] = W[(size_t)(k0 + kk) * N + n0 + (lane & 31)]; }
    if (rot) wht64_k(v, lane);
    float m = 0.f;
#pragma unroll
    for (int i = 0; i < 32; ++i) m = fmaxf(m, fabsf(v[i]));
    __hip_atomic_fetch_max((unsigned*)CM + map_row(mode, n0 + (lane & 31)), __float_as_uint(m), __ATOMIC_RELAXED, __HIP_MEMORY_SCOPE_AGENT);
}
__device__ __forceinline__ void p0_transpose_item_i8(const float* W, int K, int N, unsigned char* W8, int mode, const float* CM, LAS float* scr, int item, int lane, bool rot = false) {
    const int nblk = N / 32, kb = item / nblk, nb = item % nblk, k0 = 64 * kb, n0 = 32 * nb;
    float v[32];
#pragma unroll
    for (int i = 0; i < 32; ++i) { const int kk = 2 * i + (lane >> 5); v[i] = W[(size_t)(k0 + kk) * N + n0 + (lane & 31)]; }
    if (rot) wht64_k(v, lane);
#pragma unroll
    for (int i = 0; i < 32; ++i) { const int kk = 2 * i + (lane >> 5); scr[kk * 33 + (lane & 31)] = v[i]; }
    LDS_WAIT(); asm volatile("" ::: "memory");
    const int n = lane >> 1, half = lane & 1; const LAS float* s = scr + (32 * half) * 33 + n; const int row = map_row(mode, n0 + n);
    const float q = 127.f / fmaxf(__hip_atomic_load(CM + row, __ATOMIC_RELAXED, __HIP_MEMORY_SCOPE_AGENT), 1e-30f);
    v4u o0, o1;
    o0.x = pk4_i8(s[0 * 33] * q, s[1 * 33] * q, s[2 * 33] * q, s[3 * 33] * q);     o0.y = pk4_i8(s[4 * 33] * q, s[5 * 33] * q, s[6 * 33] * q, s[7 * 33] * q);     o0.z = pk4_i8(s[8 * 33] * q, s[9 * 33] * q, s[10 * 33] * q, s[11 * 33] * q);   o0.w = pk4_i8(s[12 * 33] * q, s[13 * 33] * q, s[14 * 33] * q, s[15 * 33] * q);
    o1.x = pk4_i8(s[16 * 33] * q, s[17 * 33] * q, s[18 * 33] * q, s[19 * 33] * q); o1.y = pk4_i8(s[20 * 33] * q, s[21 * 33] * q, s[22 * 33] * q, s[23 * 33] * q); o1.z = pk4_i8(s[24 * 33] * q, s[25 * 33] * q, s[26 * 33] * q, s[27 * 33] * q); o1.w = pk4_i8(s[28 * 33] * q, s[29 * 33] * q, s[30 * 33] * q, s[31 * 33] * q);
    GAS v4u* dst = (GAS v4u*)(W8 + (size_t)row * K + k0 + 32 * half); dst[0] = o0; dst[1] = o1;
    LDS_WAIT(); asm volatile("" ::: "memory");
}
__device__ __forceinline__ void wht64_rows4(f32x4 (&v)[16], int lane);
__device__ __forceinline__ void normmod_row(const float* xrow, const float* gm, const float* sh, bf16* orow, int lane, unsigned* o8row = nullptr, float* qstep = nullptr) {
    const GAS f32x4* xr = (const GAS f32x4*)xrow + lane;
    f32x4 v[16]; float s = 0.f;
#pragma unroll
    for (int j = 0; j < 16; ++j) { v[j] = xr[64 * j]; s += (v[j].x * v[j].x + v[j].y * v[j].y) + (v[j].z * v[j].z + v[j].w * v[j].w); }
    const float rstd = 1.f / sqrtf(wave_sum(s) * (1.f / DM) + NORM_EPS);
    GAS unsigned long long* o8 = (GAS unsigned long long*)orow + lane;
    const GAS f32x4* g4 = (const GAS f32x4*)gm + lane; const GAS f32x4* s4 = (const GAS f32x4*)sh + lane;
    if (qstep) {
        float am = 0.f;
#pragma unroll
        for (int j = 0; j < 16; ++j) { const f32x4 g = g4[64 * j], b = s4[64 * j]; v[j] = v[j] * rstd * g + b; am = fmaxf(am, fmaxf(fmaxf(fabsf(v[j].x), fabsf(v[j].y)), fmaxf(fabsf(v[j].z), fabsf(v[j].w)))); }
        if (orow) {
#pragma unroll
            for (int j = 0; j < 16; ++j) o8[64 * j] = (unsigned long long)pk2(v[j].x, v[j].y) | ((unsigned long long)pk2(v[j].z, v[j].w) << 32); }
        wht64_rows4(v, lane); am = 0.f;
#pragma unroll
        for (int j = 0; j < 16; ++j) am = fmaxf(am, fmaxf(fmaxf(fabsf(v[j].x), fabsf(v[j].y)), fmaxf(fabsf(v[j].z), fabsf(v[j].w))));
        am = fmaxf(wave_max(am), 1e-30f); const float inv = 127.f / am; if (lane == 0) *qstep = am * (1.f / 127.f);
#pragma unroll
        for (int j = 0; j < 16; ++j) ((GAS unsigned*)o8row)[lane + 64 * j] = pk4_i8(v[j].x * inv, v[j].y * inv, v[j].z * inv, v[j].w * inv);
        return; }
#pragma unroll
    for (int j = 0; j < 16; ++j) { const f32x4 g = g4[64 * j], b = s4[64 * j]; const f32x4 y = v[j] * rstd * g + b;
        if (orow) o8[64 * j] = (unsigned long long)pk2(y.x, y.y) | ((unsigned long long)pk2(y.z, y.w) << 32);
        if (o8row) ((GAS unsigned*)o8row)[lane + 64 * j] = pk4_f8(y.x, y.y, y.z, y.w); }
}

__device__ __forceinline__ void wht64_rows8(f32x4 (&v)[16], int lane) {
#pragma unroll
    for (int j = 0; j < 8; ++j) { float t[8] = {v[2 * j].x, v[2 * j].y, v[2 * j].z, v[2 * j].w, v[2 * j + 1].x, v[2 * j + 1].y, v[2 * j + 1].z, v[2 * j + 1].w};
#pragma unroll
        for (int s = 1; s < 8; s <<= 1)
#pragma unroll
            for (int i = 0; i < 8; ++i) if (!(i & s)) { const float a_ = t[i], b_ = t[i | s]; t[i] = a_ + b_; t[i | s] = a_ - b_; }
#pragma unroll
        for (int mk = 1; mk < 8; mk <<= 1) { const bool up = (lane & mk) != 0;
#pragma unroll
            for (int i = 0; i < 8; ++i) { const float o = __shfl_xor(t[i], mk); t[i] = up ? o - t[i] : t[i] + o; } }
        v[2 * j] = (f32x4){t[0], t[1], t[2], t[3]} * 0.125f; v[2 * j + 1] = (f32x4){t[4], t[5], t[6], t[7]} * 0.125f; }
}
__device__ __forceinline__ void wht64_rows4(f32x4 (&v)[16], int lane) {
#pragma unroll
    for (int j = 0; j < 16; ++j) { float t[4] = {v[j].x, v[j].y, v[j].z, v[j].w};
#pragma unroll
        for (int s = 1; s < 4; s <<= 1)
#pragma unroll
            for (int i = 0; i < 4; ++i) if (!(i & s)) { const float a_ = t[i], b_ = t[i | s]; t[i] = a_ + b_; t[i | s] = a_ - b_; }
#pragma unroll
        for (int mk = 1; mk < 16; mk <<= 1) { const bool up = (lane & mk) != 0;
#pragma unroll
            for (int i = 0; i < 4; ++i) { const float o = __shfl_xor(t[i], mk); t[i] = up ? o - t[i] : t[i] + o; } }
        v[j] = (f32x4){t[0], t[1], t[2], t[3]} * 0.125f; }
}
__device__ __forceinline__ void normmod_row_b(const bf16* xrow, const float* gm, const float* sh, bf16* orow, unsigned char* qrow, float* qstep, int lane) {
    const GAS v4u* xr = (const GAS v4u*)xrow + lane;
    f32x4 v[16]; float s = 0.f;
#pragma unroll
    for (int j = 0; j < 8; ++j) { const v4u w = xr[64 * j]; v[2 * j] = pg8::bf4_lo(w); v[2 * j + 1] = pg8::bf4_hi(w); }
#pragma unroll
    for (int j = 0; j < 16; ++j) s += (v[j].x * v[j].x + v[j].y * v[j].y) + (v[j].z * v[j].z + v[j].w * v[j].w);
    const float rstd = 1.f / sqrtf(wave_sum(s) * (1.f / DM) + NORM_EPS);
    float am = 0.f;
#pragma unroll
    for (int j = 0; j < 8; ++j) { const GAS f32x4* g4 = (const GAS f32x4*)gm + 2 * (lane + 64 * j); const GAS f32x4* s4 = (const GAS f32x4*)sh + 2 * (lane + 64 * j);
        v[2 * j] = v[2 * j] * rstd * g4[0] + s4[0]; v[2 * j + 1] = v[2 * j + 1] * rstd * g4[1] + s4[1]; }
    if (orow) { GAS v4u* o16 = (GAS v4u*)orow + lane;
#pragma unroll
        for (int j = 0; j < 8; ++j) { v4u o; o.x = pk2(v[2 * j].x, v[2 * j].y); o.y = pk2(v[2 * j].z, v[2 * j].w); o.z = pk2(v[2 * j + 1].x, v[2 * j + 1].y); o.w = pk2(v[2 * j + 1].z, v[2 * j + 1].w); o16[64 * j] = o; } }
    wht64_rows8(v, lane);
#pragma unroll
    for (int j = 0; j < 16; ++j) am = fmaxf(am, fmaxf(fmaxf(fabsf(v[j].x), fabsf(v[j].y)), fmaxf(fabsf(v[j].z), fabsf(v[j].w))));
    am = fmaxf(wave_max(am), 1e-30f); const float inv = 127.f / am; if (lane == 0) *qstep = am * (1.f / 127.f);
    GAS unsigned long long* o8 = (GAS unsigned long long*)qrow + lane;
#pragma unroll
    for (int j = 0; j < 8; ++j) o8[64 * j] = (unsigned long long)pk4_i8(v[2 * j].x * inv, v[2 * j].y * inv, v[2 * j].z * inv, v[2 * j].w * inv) | ((unsigned long long)pk4_i8(v[2 * j + 1].x * inv, v[2 * j + 1].y * inv, v[2 * j + 1].z * inv, v[2 * j + 1].w * inv) << 32);
}

__device__ __forceinline__ void quant_row_b(const bf16* xrow, unsigned char* qrow, float* qstep, int lane) {
    const GAS v4u* xr = (const GAS v4u*)xrow + lane;
    f32x4 v[16]; float am = 0.f;
#pragma unroll
    for (int j = 0; j < 8; ++j) { const v4u w = xr[64 * j]; v[2 * j] = pg8::bf4_lo(w); v[2 * j + 1] = pg8::bf4_hi(w); }
    wht64_rows8(v, lane);
#pragma unroll
    for (int j = 0; j < 16; ++j) am = fmaxf(am, fmaxf(fmaxf(fabsf(v[j].x), fabsf(v[j].y)), fmaxf(fabsf(v[j].z), fabsf(v[j].w))));
    am = fmaxf(wave_max(am), 1e-30f); const float inv = 127.f / am; if (lane == 0) *qstep = am * (1.f / 127.f);
    GAS unsigned long long* o8 = (GAS unsigned long long*)qrow + lane;
#pragma unroll
    for (int j = 0; j < 8; ++j) o8[64 * j] = (unsigned long long)pk4_i8(v[2 * j].x * inv, v[2 * j].y * inv, v[2 * j].z * inv, v[2 * j].w * inv) | ((unsigned long long)pk4_i8(v[2 * j + 1].x * inv, v[2 * j + 1].y * inv, v[2 * j + 1].z * inv, v[2 * j + 1].w * inv) << 32);
}

#ifdef SELFCHECK
#ifndef CHK_BREAK
#define CHK_BREAK 0
#endif
#define Z_REL 0.08f
#define Z_ABSX 8.f
namespace chk {
constexpr int CW_CHK = 2;
#define BRK(bit, v) (((CHK_BREAK >> (bit)) & 1) ? (v) * 1.1f + 0.1f : (v))
__device__ __forceinline__ unsigned hsh(unsigned x) { x *= 2654435761u; x ^= x >> 15; x *= 2246822519u; x ^= x >> 13; x *= 3266489917u; x ^= x >> 16; return x; }
__device__ __forceinline__ float bfv(const bf16* p) { return __uint_as_float(((unsigned)*p) << 16); }
__device__ __forceinline__ float f8v(const unsigned char* p) { const unsigned b = *p, e = (b >> 3) & 15u, m = b & 7u; const float mag = e ? exp2f((float)e - 7.f) * (1.f + (float)m * 0.125f) : (float)m * 0.001953125f; return (b & 128u) ? -mag : mag; }
__device__ __forceinline__ float wsum(float v) {
#pragma unroll
    for (int o = 1; o < 64; o <<= 1) v += __shfl_xor(v, o);
    return v; }
__device__ __forceinline__ void fail(gu32* ctl, int bit) { __hip_atomic_fetch_or((unsigned*)(ctl + CW_CHK), 1u << bit, __ATOMIC_RELAXED, __HIP_MEMORY_SCOPE_AGENT); }
__device__ __forceinline__ bool close(float got, float ref, float rel, float abs_) { const float d = fabsf(got - ref); return d <= rel * fabsf(ref) + abs_ && d == d; }
__device__ __forceinline__ float sigm(float x) { return 1.f / (1.f + expf(-x)); }
__device__ __forceinline__ float mod_ref(const float* cvec, const float* w_ada, const float* b_ada, int b, int j, int lane) {
    float s = 0.f; for (int k = lane; k < 4096; k += 64) { const float cv = cvec[b * 4096 + k]; s += (cv / (1.f + expf(-cv))) * w_ada[(size_t)k * 24576 + j]; }
    return wsum(s) + b_ada[j]; }
__device__ __forceinline__ float dot_col(const bf16* arow, const float* W, int K, int N, int n, int lane) {
    float s = 0.f; for (int k = lane; k < K; k += 64) s += bfv(arow + k) * W[(size_t)k * N + n];
    return wsum(s); }
__device__ __forceinline__ void rope_cs(int pos, int i, int dim, float& c, float& s) { const float inv = exp2f(-(float)(2 * i) / (float)dim * 13.287712379549449f); const float ang = (float)pos * inv; sincos_d((double)ang, s, c); }

__device__ __forceinline__ void chk_h(gu32* ctl, const float* x, const float* cvec, const float* w_ada, const float* b_ada, const float* norm1_g, const bf16* HB, const float* VEC, int gw, int NGW, int lane) {
    for (int sidx = gw; sidx < 512; sidx += NGW) { const unsigned h = hsh(sidx + 1000); const int row = h & 16383, col = (h >> 14) & 4095, b = row >> 12;
        float ss = 0.f; for (int k = lane; k < 4096; k += 64) { const float v = x[(size_t)row * 4096 + k]; ss += v * v; }
        const float rstd = 1.f / sqrtf(wsum(ss) / 4096.f + 1e-6f);
        const float sh1 = mod_ref(cvec, w_ada, b_ada, b, col, lane), sc1 = mod_ref(cvec, w_ada, b_ada, b, 4096 + col, lane), g1 = mod_ref(cvec, w_ada, b_ada, b, 8192 + col, lane);
        const float ref = x[(size_t)row * 4096 + col] * rstd * norm1_g[col] * (1.f + sc1) + sh1;
        if (!close(bfv(HB + (size_t)row * 4096 + col), ref, 0.01f, 0.01f)) fail(ctl, 0);
        if (!close(VEC[(2 * 4 + b) * 4096 + col], g1, 1e-3f, 1e-4f)) fail(ctl, 7); } }
__device__ __forceinline__ void chk_z(gu32* ctl, const bf16* HB, const float* w_in, const int* positions, const bf16* ZQ, const bf16* ZKV, const bf16* ZKR, const bf16* QD, const bf16* KD, const bf16* VD, const bf16* GA, const bf16* GB, int gw, int NGW, int lane) {
    for (int sidx = gw; sidx < 4096; sidx += NGW) { const unsigned h = hsh(sidx + 5000); const int row = h & 16383; int n = (int)((h >> 14) % 19008u);
        if ((sidx & 3) == 0) n = 1536 + (int)((h >> 14) & 63);
        const int b = row >> 12, s = row & 4095; const bf16* hrow = HB + (size_t)row * 4096;
        const float z = dot_col(hrow, w_in, 4096, 19008, n, lane); float got, ref = z, at = 0.03f;
        if (n < 1024) got = bfv(ZQ + (size_t)row * 1024 + n);
        else if (n < 1536) got = bfv(ZKV + (size_t)row * 512 + (n - 1024));
        else if (n < 1600) { const int r = n - 1536; got = bfv(ZKR + (size_t)row * 256 + (r >> 5) * 128 + (r & 31)); }
        else if (n < 10816) { const int r = n - 1600, t = r / 3072, rr = r % 3072, g8 = rr >> 7, d = rr & 127; const bf16* buf = t == 0 ? QD : (t == 1 ? KD : VD);
            got = bfv(buf + ((size_t)(b * 24 + g8) * 4096 + s) * 128 + d);
            if (t < 2) { const int i = d & 63; float c, sn; rope_cs(positions[row], i, 128, c, sn); const float zp = dot_col(hrow, w_in, 4096, 19008, d < 64 ? n + 64 : n - 64, lane);
                ref = d < 64 ? z * c - zp * sn : z * c + zp * sn; } }
        else { const int r = n - 10816; got = (float)((const unsigned char*)(r < 4096 ? GA : GB))[(size_t)row * 4096 + (r & 4095)] * (1.f / 255.f); ref = sigm(z); at = 0.008f; }
        if (!close(BRK(1, got), ref, Z_REL, at * Z_ABSX)) fail(ctl, 1);
        if (lane == 0 && n < 10816) { atomicAdd((float*)(ctl + 8), (got - ref) * (got - ref)); atomicAdd((float*)(ctl + 9), ref * ref); } } }
__device__ __forceinline__ void chk_p4(gu32* ctl, const bf16* ZQ, const bf16* ZKV, const bf16* ZKR, const float* qg, const float* kvg, const int* positions, const bf16* QN, const bf16* KVN, const unsigned char* KR8, int gw, int NGW, int lane) {
    for (int sidx = gw; sidx < 1024; sidx += NGW) { const unsigned h = hsh(sidx + 9000); const int row = h & 16383;
        float ss = 0.f; for (int k = lane; k < 1024; k += 64) { const float v = bfv(ZQ + (size_t)row * 1024 + k); ss += v * v; }
        const float rq = 1.f / sqrtf(wsum(ss) / 1024.f + 1e-6f); const int cq = lane * 16 + ((h >> 14) & 15);
        if (!close(bfv(QN + (size_t)row * 1024 + cq), bfv(ZQ + (size_t)row * 1024 + cq) * rq * qg[cq], 0.01f, 0.01f)) fail(ctl, 2);
        ss = 0.f; for (int k = lane; k < 512; k += 64) { const float v = bfv(ZKV + (size_t)row * 512 + k); ss += v * v; }
        const float rk = 1.f / sqrtf(wsum(ss) / 512.f + 1e-6f); const int ck = lane * 8 + ((h >> 18) & 7);
        if (!close(bfv(KVN + (size_t)row * 512 + ck), bfv(ZKV + (size_t)row * 512 + ck) * rk * kvg[ck], 0.01f, 0.01f)) fail(ctl, 2);
        { const int d = lane, i = d & 31; float c, sn; rope_cs(positions[row], i, 64, c, sn);
          const float x1 = bfv(ZKR + (size_t)row * 256 + i), x2 = bfv(ZKR + (size_t)row * 256 + 128 + i); const float ref = d < 32 ? x1 * c - x2 * sn : x2 * c + x1 * sn;
          if (!close(f8v(KR8 + (size_t)row * 64 + d), ref, 0.07f, 0.02f)) fail(ctl, 2); } } }
__device__ __forceinline__ void chk_p5(gu32* ctl, const bf16* QN, const bf16* KVN, const float* w_uq, const float* w_ukv, const int* positions, const unsigned char* Q8, const unsigned char* K8, const unsigned char* V8T, int gw, int NGW, int lane) {
    for (int sidx = gw; sidx < 2048; sidx += NGW) { const unsigned h = hsh(sidx + 13000); const int row = h & 16383, b = row >> 12, s = row & 4095;
        { const int n = (int)((h >> 14) % 3072u), hd = n / 192, c = n % 192; const bf16* arow = QN + (size_t)row * 1024; float ref = dot_col(arow, w_uq, 1024, 3072, n, lane);
          if (c >= 128) { const int r = c - 128, i = r & 31; float cs, sn; rope_cs(positions[row], i, 64, cs, sn); const float zp = dot_col(arow, w_uq, 1024, 3072, r < 32 ? n + 32 : n - 32, lane); ref = r < 32 ? ref * cs - zp * sn : ref * cs + zp * sn; }
          if (!close(f8v(Q8 + ((size_t)(b * 16 + hd) * 4096 + s) * 192 + c), ref, 0.08f, 0.04f)) fail(ctl, 3); }
        { const int n = (int)((h >> 9) & 4095); const float ref = dot_col(KVN + (size_t)row * 512, w_ukv, 512, 4096, n, lane);
          const int hd2 = n >> 8, cc = n & 255; const size_t ro = ((size_t)(b * 16 + hd2) * 4096 + s) * 128;
          if (cc < 128) { if (!close(f8v(K8 + ro + cc), ref, 0.08f, 0.04f)) fail(ctl, 3); } else { const int dd = cc - 128; if (!close(f8v(V8T + (((size_t)(b * 16 + hd2) * 64 + (s >> 6)) * 128 + dd) * 64 + att::vpos(s & 63)), ref, 0.08f, 0.04f)) fail(ctl, 3); } } } }
__device__ __forceinline__ void chk_mla(gu32* ctl, const unsigned char* Q8, const unsigned char* K8, const unsigned char* V8T, const unsigned char* KR8, const bf16* Y, LAS float* scr, int sample, int tid) {
    const unsigned h = hsh(sample + 17000); const int b = h & 3, hd = (h >> 2) & 15, row = (h >> 6) & 4095;
    LAS float* q = scr; LAS float* sc = scr + 256; LAS float* red = scr + 256 + 4096;
    __syncthreads();
    if (tid < 192) q[tid] = f8v(Q8 + ((size_t)(b * 16 + hd) * 4096 + row) * 192 + tid);
    __syncthreads();
    float mx = -1e30f;
    for (int k = tid; k < 4096; k += 512) { const unsigned char* kr = K8 + ((size_t)(b * 16 + hd) * 4096 + k) * 128; const unsigned char* rr = KR8 + ((size_t)b * 4096 + k) * 64; float s = 0.f;
        for (int d = 0; d < 128; ++d) s += q[d] * f8v(kr + d);
        for (int d = 0; d < 64; ++d) s += q[128 + d] * f8v(rr + d);
        s *= 0.07216878364870323f; sc[k] = s; mx = fmaxf(mx, s); }
    red[tid] = mx; __syncthreads();
    for (int o = 256; o > 0; o >>= 1) { if (tid < o) red[tid] = fmaxf(red[tid], red[tid + o]); __syncthreads(); }
    mx = red[0]; __syncthreads();
    float sm = 0.f; for (int k = tid; k < 4096; k += 512) { const float p = expf(sc[k] - mx); sc[k] = p; sm += p; }
    red[tid] = sm; __syncthreads();
    for (int o = 256; o > 0; o >>= 1) { if (tid < o) red[tid] += red[tid + o]; __syncthreads(); }
    sm = red[0]; __syncthreads();
    const int d = tid & 127, part = tid >> 7; float acc = 0.f;
    for (int k = part * 1024; k < part * 1024 + 1024; ++k) acc += sc[k] * f8v(V8T + (((size_t)(b * 16 + hd) * 64 + (k >> 6)) * 128 + d) * 64 + att::vpos(k & 63));
    red[tid] = acc; __syncthreads();
    if (tid < 128) { const float ref = (red[tid] + red[tid + 128] + red[tid + 256] + red[tid + 384]) / sm; red[tid] = ref; }
    __syncthreads();
    float r2 = 0.f; for (int i = 0; i < 128; ++i) r2 += red[i] * red[i]; const float rms = sqrtf(r2 / 128.f);
    if (tid < 128) { const float got = bfv(Y + ((size_t)b * 4096 + row) * 3072 + hd * 128 + tid); if (!close(BRK(4, got), red[tid], 0.06f, 0.06f * rms)) fail(ctl, 4);     }
    __syncthreads();
}
__device__ __forceinline__ void chk_dil(gu32* ctl, const bf16* QD, const bf16* KD, const bf16* VD, const bf16* Y, LAS float* scr, int sample, int tid) {
    const unsigned h = hsh(sample + 23000); const int b = h & 3, hd = (h >> 2) & 7; int s = (h >> 5) & 4095; if ((sample & 7) == 0) s = (sample >> 3) & 63; if ((sample & 7) == 1) s = 4095 - ((sample >> 3) & 63);
    LAS float* sc = scr; LAS float* red = scr + 512;
    __syncthreads();
    float v = -1e30f;
    if (tid < 387) { const int g = tid / 129, j = tid % 129, dd = g == 0 ? 1 : (g == 1 ? 4 : 16), idx = s + (j - 64) * dd;
        if (idx >= 0 && idx < 4096) { const bf16* qp = QD + ((size_t)(b * 24 + g * 8 + hd) * 4096 + s) * 128; const bf16* kp = KD + ((size_t)(b * 24 + g * 8 + hd) * 4096 + idx) * 128; float a = 0.f;
            for (int d = 0; d < 128; ++d) a += bfv(qp + d) * bfv(kp + d);
            v = a * 0.08838834764831845f; } }
    if (tid < 387) sc[tid] = v;
    red[tid] = v; __syncthreads();
    for (int o = 256; o > 0; o >>= 1) { if (tid < o) red[tid] = fmaxf(red[tid], red[tid + o]); __syncthreads(); }
    const float mx = red[0]; __syncthreads();
    float p = 0.f; if (tid < 387 && v > -1e29f) p = expf(v - mx); if (tid < 387) sc[tid] = p;
    red[tid] = p; __syncthreads();
    for (int o = 256; o > 0; o >>= 1) { if (tid < o) red[tid] += red[tid + o]; __syncthreads(); }
    const float sm = red[0]; __syncthreads();
    if (tid < 128) { float acc = 0.f;
        for (int t = 0; t < 387; ++t) { const int g = t / 129, j = t % 129, dd = g == 0 ? 1 : (g == 1 ? 4 : 16), idx = s + (j - 64) * dd; if (idx < 0 || idx >= 4096) continue;
            acc += sc[t] * bfv(VD + ((size_t)(b * 24 + g * 8 + hd) * 4096 + idx) * 128 + tid); }
        red[tid] = acc / sm; }
    __syncthreads();
    float r2 = 0.f; for (int i = 0; i < 128; ++i) r2 += red[i] * red[i]; const float rms = sqrtf(r2 / 128.f);
    if (tid < 128) { const float got = bfv(Y + ((size_t)b * 4096 + s) * 3072 + 2048 + hd * 128 + tid); if (!close(BRK(5, got), red[tid], 0.03f, 0.03f * rms)) fail(ctl, 5); }
    __syncthreads();
}
__device__ __forceinline__ void chk_mix(gu32* ctl, const bf16* Y, const bf16* GA, const bf16* GB, const float* wpa, const float* wpb, const bf16* MIXED, int gw, int NGW, int lane) {
    for (int sidx = gw; sidx < 2048; sidx += NGW) { const unsigned h = hsh(sidx + 29000); const int row = h & 16383, col = (h >> 14) & 4095; const bf16* yr = Y + (size_t)row * 3072;
        const float pa = dot_col(yr, wpa, 2048, 4096, col, lane), pb = dot_col(yr + 2048, wpb, 1024, 4096, col, lane);
        const float ref = (float)((const unsigned char*)GA)[(size_t)row * 4096 + col] * (1.f / 255.f) * pa + fmaxf((float)((const unsigned char*)GB)[(size_t)row * 4096 + col], 1.f) * (1.f / 255.f) * pb;
        if (!close(bfv(MIXED + (size_t)row * 4096 + col), ref, 0.03f, 0.002f)) fail(ctl, 6); } }
__device__ __forceinline__ void chk_x1(gu32* ctl, const float* x, const bf16* MIXED, const float* w_out, const float* VEC, const bf16* X1B, int gw, int NGW, int lane) {
    for (int sidx = gw; sidx < 8192; sidx += NGW) { const unsigned h = hsh(sidx + 31000); const int row = h & 16383, col = (h >> 14) & 4095, b = row >> 12; const float xv = x[(size_t)row * 4096 + col];
        if (fabsf(xv) > 0.12f) continue;
        const float br = VEC[(2 * 4 + b) * 4096 + col] * dot_col(MIXED + (size_t)row * 4096, w_out, 4096, 4096, col, lane);
        if (!close(bfv(X1B + (size_t)row * 4096 + col) - xv, br, 0.15f, 0.003f)) fail(ctl, 8);
        if (lane == 0) { atomicAdd((float*)(ctl + 10), br * br); atomicAdd((float*)(ctl + 11), 1.f); } } }
}
#endif

struct Args { const float* in[19]; float* out; unsigned char* ws; int ph_lo, ph_hi, li, pad; };
__global__ void __launch_bounds__(NWAVES * 64, 2) mk_fwd(Args args) {
    extern __shared__ __attribute__((aligned(16))) unsigned char lds[];
    Frame F;
    F.lds = (LAS unsigned char*)lds;
    F.MISC = (volatile LAS unsigned*)(F.lds + MISC_OFF);
    F.tid = threadIdx.x; F.lane = F.tid & 63; F.wave = __builtin_amdgcn_readfirstlane(F.tid >> 6);
    F.G = gridDim.x; { const int bx = blockIdx.x; F.vcu = (F.G % 8 == 0) ? (bx % 8) * (F.G / 8) + bx / 8 : bx; }
    unsigned char* ws = args.ws;
    F.ctl = (gu32*)(ws + WS_CTL);
    const float* x = args.in[0]; const float* cvec = args.in[1]; const int* positions = (const int*)args.in[2];
    const float* w_ada = args.in[3]; const float* b_ada = args.in[4]; const float* norm1_g = args.in[5]; const float* w_in = args.in[6];
    const float* q_norm_g = args.in[7]; const float* w_uq = args.in[8]; const float* kv_norm_g = args.in[9]; const float* w_ukv = args.in[10];
    const float* w_proj_a = args.in[11]; const float* w_proj_b = args.in[12]; const float* w_out = args.in[13]; const float* norm2_g = args.in[14];
    const float* w_gate = args.in[15]; const float* w_up = args.in[16]; const float* w_down = args.in[17]; const float* final_g = args.in[18];
    float* out = args.out;
    float* MOD = (float*)(ws + WS_MOD); float* VEC = (float*)(ws + WS_VEC); float* MODP = (float*)(ws + WS_MODP);
    float* COSF = (float*)(ws + WS_COSF); float* SINF = (float*)(ws + WS_SINF); float* COSR = (float*)(ws + WS_COSR); float* SINR = (float*)(ws + WS_SINR);
    bf16* KROPE = (bf16*)(ws + WS_KROPE); float* LSE = (float*)(ws + WS_LSE);
    unsigned char* WOUT8 = ws + WS_WOUT; unsigned char* MIXQ = ws + WS_VD; float* CM3 = (float*)(ws + WS_CTL + 384 * 1024); float* SA3 = (float*)(ws + WS_CTL + 768 * 1024);
    unsigned char* WGU8 = ws + WS_WGU; unsigned char* H2Q = ws + WS_X2B;
    float* CM1 = (float*)(ws + WS_CTL + 128 * 1024); float* CM2 = (float*)(ws + WS_CTL + 256 * 1024); float* SA1 = (float*)(ws + WS_CTL + 512 * 1024); float* SA2 = (float*)(ws + WS_CTL + 640 * 1024);
    unsigned char* WIN8 = ws + WS_WIN + (NBF > 0 ? 80 : 0) * MiB;     unsigned char* H8 = ws + WS_H8;
    bf16 *WIN = (bf16*)(ws + WS_WIN), *WUQ = (bf16*)(ws + WS_WUQ), *WUKV = (bf16*)(ws + WS_WUKV), *WPA = (bf16*)(ws + WS_WPA), *WPB = (bf16*)(ws + WS_WPB), *WOUT = (bf16*)(ws + WS_WOUT), *WGU = (bf16*)(ws + WS_WGU), *WDN = (bf16*)(ws + WS_WDN);
    bf16 *HB = (bf16*)(ws + WS_A), *QB = (bf16*)(ws + WS_A), *H2 = (bf16*)(ws + WS_A);
    bf16 *QD = (bf16*)(ws + WS_QD), *KD = (bf16*)(ws + WS_KD), *VD = (bf16*)(ws + WS_VD), *MIXED = (bf16*)(ws + WS_QD), *AFF = (bf16*)(ws + WS_QD);
    bf16 *GA = (bf16*)(ws + WS_GA), *GB = (bf16*)(ws + WS_GB);
    bf16 *ZQ = (bf16*)(ws + WS_ZQ), *ZKV = (bf16*)(ws + WS_ZKV), *ZKR = (bf16*)(ws + WS_ZKR), *QN = (bf16*)(ws + WS_QN), *KVN = (bf16*)(ws + WS_KVN), *PD = (bf16*)(ws + WS_PD);
    unsigned char* Q8 = ws + WS_A; unsigned char* K8 = ws + WS_KV; unsigned char* V8T = ws + WS_KV + 32 * MiB; unsigned char* KR8 = ws + WS_KROPE;
    bf16 *KV = (bf16*)(ws + WS_KV), *YA = (bf16*)(ws + WS_YA), *YB = (bf16*)(ws + WS_YB), *X1B = (bf16*)(ws + WS_X1B), *X2B = (bf16*)(ws + WS_X2B);

    for (int u = F.tid; u < (LDS_BYTES - LDSCTL_OFF) / 4; u += NWAVES * 64) ((LAS unsigned*)(F.lds + LDSCTL_OFF))[u] = 0u;
    __syncthreads();
    XcdBarrier bar; bar.bar = (unsigned*)(F.ctl + CW_BAR); bar.x = 0; bar.st = nullptr;
    if (N_LAUNCHES == 1) bar = xcd_barrier_post((unsigned*)(F.ctl + CW_BAR), F.MISC + 8);
#define GRID_BAR() do { if (N_LAUNCHES == 1) xcd_barrier(bar); } while (0)
    const int lo = args.ph_lo, hi = args.ph_hi;
#ifndef PHASE_MASK
#define PHASE_MASK 0x3fff
#endif
#define IN(k) (((PHASE_MASK >> (k)) & 1) && lo <= (k) && (k) < hi)
#define BOTH(k) (IN(k) && IN((k) + 1))
#ifndef REPEAT_MASK
#define REPEAT_MASK 0
#endif
#define REP(k)
#define RPT(k) ((REPEAT_MASK >> (k)) & 1)
    const int gw = F.vcu * NWAVES + F.wave, NGW = F.G * NWAVES;
    const int NGT = F.G * NWAVES * 64;
#define OPQ_TID() ({ int t_ = (int)threadIdx.x; asm volatile("" : "+v"(t_)); t_; })
#define gt ((int)blockIdx.x * (NWAVES * 64) + OPQ_TID())
#define LANE() (OPQ_TID() & 63)

    if (IN(0)) { REP(0) {
        { LAS float* scv = (LAS float*)(F.lds + RING_OFF);
          for (int it = blockIdx.x; it < KSPLIT * 12; it += F.G) {
              const int kc = it / 12, cb = it % 12;
              __syncthreads();
              if (OPQ_TID() < 256) { const int k = OPQ_TID() >> 2, b = OPQ_TID() & 3; const float cv = cvec[b * DM + kc * 64 + k]; scv[k * 4 + b] = cv / (1.f + expf(-cv)); }
              __syncthreads();
              const int col = cb * 2048 + 4 * OPQ_TID();
              f32x4 a0 = {0.f, 0.f, 0.f, 0.f}, a1 = a0, a2 = a0, a3 = a0;
              const float* wp = w_ada + (size_t)(kc * 64) * N_MOD + col;
#pragma unroll 8
              for (int k = 0; k < 64; ++k) { const f32x4 w = *(const GAS f32x4*)(wp + (size_t)k * N_MOD); const f32x4 s = *(const LAS f32x4*)(scv + k * 4);
                  a0 += s.x * w; a1 += s.y * w; a2 += s.z * w; a3 += s.w * w; }
              float* mp = MODP + (size_t)(kc * 4) * N_MOD + col;
              *(GAS f32x4*)(mp) = a0; *(GAS f32x4*)(mp + N_MOD) = a1; *(GAS f32x4*)(mp + 2 * N_MOD) = a2; *(GAS f32x4*)(mp + 3 * N_MOD) = a3;
          }
          __syncthreads(); }
        for (int e = gt; e < M * 64; e += NGT) { const int row = e >> 6, i = e & 63; const float ang = (float)positions[row] * INVF[i]; float s, c; sincos_d((double)ang, s, c); COSF[e] = c; SINF[e] = s; }
        for (int e = gt; e < M * 32; e += NGT) { const int row = e >> 5, i = e & 31; const float ang = (float)positions[row] * INVF[2 * i]; float s, c; sincos_d((double)ang, s, c); COSR[e] = c; SINR[e] = s; }
        for (int e = gt; e < 192 * (DM / 16); e += NGT) { const int rr = e / (DM / 16), c16 = e % (DM / 16); const int row = (74 - NBF) * 256 + (rr / 96) * 128 + 32 + (rr % 96);
            *(GAS v4u*)(WIN8 + (size_t)row * DM + c16 * 16) = (v4u){0u, 0u, 0u, 0u}; }
        { LAS float* scr = (LAS float*)(F.lds + RING_OFF + F.wave * 16384);
          constexpr int I_IN = (DM / 64) * (IN_TOTAL / 32), I_UQ = (QRANK / 64) * (3072 / 32), I_UKV = (KVRANK / 64) * (4096 / 32), I_PA = (2048 / 64) * (DM / 32), I_PB = (1024 / 64) * (DM / 32),
                        I_OUT = (DM / 64) * (DM / 32), I_G = (DM / 64) * (DFF / 32), I_DN = (DFF / 64) * (DM / 32);
          constexpr int NITEMS = I_IN + I_UQ + I_UKV + I_PA + I_PB + I_OUT + 2 * I_G;
          for (int it = gw; it < NITEMS * (1 + RPT(0)); it += NGW) {
              int r = it % NITEMS;
              if (r < I_IN) { const int n0_ = 32 * (r % (IN_TOTAL / 32));
                  if (n0_ >= 1600 && n0_ < 1600 + NBF * 256) p0_transpose_item(w_in, DM, IN_TOTAL, WIN, 5, scr, r, LANE()); else p0_colmax_item(w_in, IN_TOTAL, CM1, 6, r, LANE(), true);
                  continue; } r -= I_IN;
              if (r < I_UQ) { p0_transpose_item(w_uq, QRANK, 3072, WUQ, 2, scr, r, LANE()); continue; } r -= I_UQ;
              if (r < I_UKV) { p0_transpose_item(w_ukv, KVRANK, 4096, WUKV, 0, scr, r, LANE()); continue; } r -= I_UKV;
              if (r < I_PA) { p0_transpose_item(w_proj_a, 2048, DM, WPA, 0, scr, r, LANE(), 3072); continue; } r -= I_PA;
              if (r < I_PB) { p0_transpose_item(w_proj_b, 1024, DM, WPA + 2048, 0, scr, r, LANE(), 3072); continue; } r -= I_PB;
              if (r < I_OUT) { p0_colmax_item(w_out, DM, CM3, 0, r, LANE(), true); continue; } r -= I_OUT;
              if (r < I_G) { if (((32 * (r % (DFF / 32))) >> 7) < P11_T8) p0_colmax_item(w_gate, DFF, CM2, 3, r, LANE(), true); else p0_transpose_item(w_gate, DM, DFF, WGU, 3, scr, r, LANE()); continue; } r -= I_G;
              if (((32 * (r % (DFF / 32))) >> 7) < P11_T8) p0_colmax_item(w_up, DFF, CM2, 4, r, LANE(), true); else p0_transpose_item(w_up, DM, DFF, WGU, 4, scr, r, LANE());
          } }
        }
        if (BOTH(0)) GRID_BAR();
    }
    if (IN(1)) { REP(1) {
        for (int e = gt; e < BATCH * N_MOD; e += NGT) { const int b = e / N_MOD, j = e - b * N_MOD, ch = j >> 12, col = j & (DM - 1);
            float s = b_ada[j];
#pragma unroll 16
            for (int kc = 0; kc < KSPLIT; ++kc) s += MODP[(size_t)(kc * 4 + b) * N_MOD + j];
            MOD[(size_t)b * N_MOD + j] = s;
            const int slot = ch == 0 ? 1 : (ch == 1 ? 0 : (ch == 2 ? 2 : (ch == 3 ? 4 : (ch == 4 ? 3 : 5))));
            VEC[(slot * 4 + b) * DM + col] = ch == 1 ? norm1_g[col] * (1.f + s) : (ch == 4 ? norm2_g[col] * (1.f + s) : s); }
        { LAS float* scr = (LAS float*)(F.lds + RING_OFF + F.wave * 16384); constexpr int I_IN = (DM / 64) * (IN_TOTAL / 32);
          for (int it = gw; it < I_IN; it += NGW) p0_transpose_item_i8(w_in, DM, IN_TOTAL, WIN8, 6, CM1, scr, it, LANE(), true);
          constexpr int I_OUT = (DM / 64) * (DM / 32);
          for (int it = gw; it < I_OUT; it += NGW) p0_transpose_item_i8(w_out, DM, DM, WOUT8, 0, CM3, scr, it, LANE(), true);
          constexpr int I_G = (DM / 64) * (DFF / 32);
          for (int it = gw; it < 2 * I_G; it += NGW) { const int r = it < I_G ? it : it - I_G; if (((32 * (r % (DFF / 32))) >> 7) >= P11_T8) continue;
              if (it < I_G) p0_transpose_item_i8(w_gate, DM, DFF, WGU8, 3, CM2, scr, r, LANE(), true); else p0_transpose_item_i8(w_up, DM, DFF, WGU8, 4, CM2, scr, r, LANE(), true); } }
        }
        if (BOTH(1)) GRID_BAR();
    }
    if (IN(2)) { REP(2) {
        for (int m0 = gw; m0 < M * (1 + RPT(2)); m0 += NGW) { const int m = m0 & (M - 1), b = m >> 12; normmod_row(x + (size_t)m * DM, VEC + (0 * 4 + b) * DM, VEC + (1 * 4 + b) * DM, HB_OR_NULL(HB + (size_t)m * DM), LANE(), (unsigned*)(H8 + (size_t)m * DM), SA1 + m); }
        }
        if (BOTH(2)) GRID_BAR();
    }
    if (IN(3)) { REP(3) {
#ifdef SELFCHECK
        chk::chk_h(F.ctl, x, cvec, w_ada, b_ada, norm1_g, HB, VEC, gw, NGW, LANE());
#endif
        if constexpr (NBF > 0) { pg8::Gemm g{HB, WIN, M, NBF * 256, DM}; pg8::StaticOrder S; S.init(M, NBF * 256, F.G, (int)blockIdx.x);
          pg8::EpiZ E{ZQ, ZKV, QD, KD, VD, GA, GB, ZKR, COSF, SINF, 1};
          pg8::gemm_phase<pg8::EpiZ, pg8::StaticOrder, PG_ALIGN, PG_SP2>(F.lds + RING_OFF, g, S, E);
          if constexpr (RPT(3)) { pg8::gemm_phase<pg8::EpiZ, pg8::StaticOrder, PG_ALIGN, PG_SP2>(F.lds + RING_OFF, g, S, E); } }
        { pg8::Gemm g{(const pg8::bf16_t*)H8, (const pg8::bf16_t*)WIN8, M, (75 - NBF) * 256, DM, SA1, CM1}; pg8::StaticOrder S; S.init(M, (75 - NBF) * 256, F.G, (int)blockIdx.x);
          pg8::EpiZ E{ZQ, ZKV, QD, KD, VD, GA, GB, ZKR, COSF, SINF, 2};
          pg8::gemm_phase<pg8::EpiZ, pg8::StaticOrder, PG_ALIGN, PG_SP2, true, 121, true>(F.lds + RING_OFF, g, S, E);
          if constexpr (RPT(3)) { pg8::gemm_phase<pg8::EpiZ, pg8::StaticOrder, PG_ALIGN, PG_SP2, true, 121, true>(F.lds + RING_OFF, g, S, E); } }
        }
        if (BOTH(3)) GRID_BAR();
    }
    if (IN(4)) { REP(4) {
#ifdef SELFCHECK
        chk::chk_z(F.ctl, HB, w_in, positions, ZQ, ZKV, ZKR, QD, KD, VD, GA, GB, gw, NGW, LANE());
#endif
        for (int m = gw; m < M; m += NGW) {
            { const GAS v4u* zp = (const GAS v4u*)(ZQ + (size_t)m * QRANK); v4u a = zp[LANE()], b2 = zp[64 + LANE()];
              float f[16]; f[0] = pg8::bf_lo(a.x); f[1] = pg8::bf_hi(a.x); f[2] = pg8::bf_lo(a.y); f[3] = pg8::bf_hi(a.y); f[4] = pg8::bf_lo(a.z); f[5] = pg8::bf_hi(a.z); f[6] = pg8::bf_lo(a.w); f[7] = pg8::bf_hi(a.w);
              f[8] = pg8::bf_lo(b2.x); f[9] = pg8::bf_hi(b2.x); f[10] = pg8::bf_lo(b2.y); f[11] = pg8::bf_hi(b2.y); f[12] = pg8::bf_lo(b2.z); f[13] = pg8::bf_hi(b2.z); f[14] = pg8::bf_lo(b2.w); f[15] = pg8::bf_hi(b2.w);
              float s = 0.f;
#pragma unroll
              for (int i = 0; i < 16; ++i) s += f[i] * f[i];
              const float rstd = 1.f / sqrtf(wave_sum(s) * (1.f / QRANK) + NORM_EPS);
              const float* g0 = q_norm_g + 8 * LANE(); const float* g1 = q_norm_g + 512 + 8 * LANE();
              v4u o0, o1;
              o0.x = pk2(f[0] * rstd * g0[0], f[1] * rstd * g0[1]); o0.y = pk2(f[2] * rstd * g0[2], f[3] * rstd * g0[3]); o0.z = pk2(f[4] * rstd * g0[4], f[5] * rstd * g0[5]); o0.w = pk2(f[6] * rstd * g0[6], f[7] * rstd * g0[7]);
              o1.x = pk2(f[8] * rstd * g1[0], f[9] * rstd * g1[1]); o1.y = pk2(f[10] * rstd * g1[2], f[11] * rstd * g1[3]); o1.z = pk2(f[12] * rstd * g1[4], f[13] * rstd * g1[5]); o1.w = pk2(f[14] * rstd * g1[6], f[15] * rstd * g1[7]);
              GAS v4u* op = (GAS v4u*)(QN + (size_t)m * QRANK); op[LANE()] = o0; op[64 + LANE()] = o1; }
            { const GAS v4u* zp = (const GAS v4u*)(ZKV + (size_t)m * KVRANK); v4u a = zp[LANE()];
              float f[8]; f[0] = pg8::bf_lo(a.x); f[1] = pg8::bf_hi(a.x); f[2] = pg8::bf_lo(a.y); f[3] = pg8::bf_hi(a.y); f[4] = pg8::bf_lo(a.z); f[5] = pg8::bf_hi(a.z); f[6] = pg8::bf_lo(a.w); f[7] = pg8::bf_hi(a.w);
              float s = 0.f;
#pragma unroll
              for (int i = 0; i < 8; ++i) s += f[i] * f[i];
              const float rstd = 1.f / sqrtf(wave_sum(s) * (1.f / KVRANK) + NORM_EPS);
              const float* g0 = kv_norm_g + 8 * LANE(); v4u o0;
              o0.x = pk2(f[0] * rstd * g0[0], f[1] * rstd * g0[1]); o0.y = pk2(f[2] * rstd * g0[2], f[3] * rstd * g0[3]); o0.z = pk2(f[4] * rstd * g0[4], f[5] * rstd * g0[5]); o0.w = pk2(f[6] * rstd * g0[6], f[7] * rstd * g0[7]);
              ((GAS v4u*)(KVN + (size_t)m * KVRANK))[LANE()] = o0; }
            if (LANE() < 32) { const int i = LANE(); const float x1 = pg8::bf_lo((unsigned)ZKR[(size_t)m * 256 + i]), x2 = pg8::bf_lo((unsigned)ZKR[(size_t)m * 256 + 128 + i]);
              const float c = COSR[(size_t)m * 32 + i], s = SINR[(size_t)m * 32 + i];
              const unsigned w8 = (unsigned)__builtin_amdgcn_cvt_pk_fp8_f32(x1 * c - x2 * s, x2 * c + x1 * s, 0, false);
              KR8[(size_t)m * 64 + i] = (unsigned char)(w8 & 0xffu); KR8[(size_t)m * 64 + 32 + i] = (unsigned char)((w8 >> 8) & 0xffu); }
        }
        }
        if (BOTH(4)) GRID_BAR();
    }
    if (IN(5)) { REP(5) {
#ifdef SELFCHECK
        chk::chk_p4(F.ctl, ZQ, ZKV, ZKR, q_norm_g, kv_norm_g, positions, QN, KVN, KR8, gw, NGW, LANE());
#endif
        { pg8::Gemm g{QN, WUQ, M, 3072, QRANK}; pg8::StaticOrder S; S.init(M, 3072, F.G, (int)blockIdx.x);
          pg8::EpiQ E{Q8, COSR, SINR};
          pg8::gemm_phase<pg8::EpiQ, pg8::StaticOrder, PG_ALIGN, PG_SP2>(F.lds + RING_OFF, g, S, E); if constexpr (RPT(5)) { pg8::gemm_phase<pg8::EpiQ, pg8::StaticOrder, PG_ALIGN, PG_SP2>(F.lds + RING_OFF, g, S, E); } }
        { pg8::Gemm g{KVN, WUKV, M, 4096, KVRANK}; pg8::StaticOrder S; S.init(M, 4096, F.G, (int)blockIdx.x);
          pg8::EpiKV E{K8, V8T};
          pg8::gemm_phase<pg8::EpiKV, pg8::StaticOrder, PG_ALIGN, PG_SP2>(F.lds + RING_OFF, g, S, E); if constexpr (RPT(5)) { pg8::gemm_phase<pg8::EpiKV, pg8::StaticOrder, PG_ALIGN, PG_SP2>(F.lds + RING_OFF, g, S, E); } }
        }
        if (BOTH(5)) GRID_BAR();
    }
    if (IN(6)) { REP(6) {
#ifdef SELFCHECK
        chk::chk_p5(F.ctl, QN, KVN, w_uq, w_ukv, positions, Q8, K8, V8T, gw, NGW, LANE());
#endif
        char* albs = (char*)lds + RING_OFF;
#ifndef NO_MLA
        for (int i0 = 0; i0 < 4 * (1 + (RPT(6) | RPT(15))); ++i0) { const int i = i0 & 3; const int v = F.vcu; const int xcd = v >> 5, vl = v & 31; const int bh = xcd * 8 + i * 2 + (vl >> 4), qb = vl & 15;
            if (F.G != 256) break;
            const int b = bh >> 4, h = bh & 15; const long r0 = (long)b * SEQ;
            att::mla_unit(Q8 + ((long)bh * SEQ + qb * 256) * 192, K8 + (long)bh * SEQ * 128, V8T + (long)bh * SEQ * 128, KR8 + r0 * 64, YA + (r0 + qb * 256) * 3072 + h * 128, albs); }
#endif
#ifndef NO_DIL
        for (int i = 0; i < 6 * (1 + (RPT(6) | RPT(14))); ++i) { const int U = (int)blockIdx.x + F.G * (i % 6); if (U >= 1536) continue;
            const int bgh = U >> 4, sub = U & 15, b = bgh / 24, g = (bgh % 24) >> 3, h = bgh & 7;
            const int rho = (g == 0) ? 0 : (g == 1 ? (sub >> 2) : sub), blk = (g == 0) ? sub : (g == 1 ? (sub & 3) : 0);
            att::dil_unit(b, g, h, rho, blk, QD, KD, VD, PD, LSE, albs); }
#endif
        }
        if (BOTH(6)) GRID_BAR();
    }
    if (IN(7)) { REP(7) {
        for (int e = gt; e < M * 128; e += NGT) { const int tok = e >> 7, c8 = e & 127, h = c8 >> 4;
            const float l0 = LSE[((size_t)0 * M + tok) * 8 + h], l1 = LSE[((size_t)1 * M + tok) * 8 + h], l2 = LSE[((size_t)2 * M + tok) * 8 + h];
            const float mx = fmaxf(l0, fmaxf(l1, l2)); float w0 = __builtin_amdgcn_exp2f(l0 - mx), w1 = __builtin_amdgcn_exp2f(l1 - mx), w2 = __builtin_amdgcn_exp2f(l2 - mx);
            const float inv = 1.f / (w0 + w1 + w2); w0 *= inv; w1 *= inv; w2 *= inv;
            const v4u p0 = *(const GAS v4u*)(PD + ((size_t)0 * M + tok) * 1024 + c8 * 8), p1 = *(const GAS v4u*)(PD + ((size_t)1 * M + tok) * 1024 + c8 * 8), p2 = *(const GAS v4u*)(PD + ((size_t)2 * M + tok) * 1024 + c8 * 8);
            v4u o;
            o.x = pk2(w0 * pg8::bf_lo(p0.x) + w1 * pg8::bf_lo(p1.x) + w2 * pg8::bf_lo(p2.x), w0 * pg8::bf_hi(p0.x) + w1 * pg8::bf_hi(p1.x) + w2 * pg8::bf_hi(p2.x));
            o.y = pk2(w0 * pg8::bf_lo(p0.y) + w1 * pg8::bf_lo(p1.y) + w2 * pg8::bf_lo(p2.y), w0 * pg8::bf_hi(p0.y) + w1 * pg8::bf_hi(p1.y) + w2 * pg8::bf_hi(p2.y));
            o.z = pk2(w0 * pg8::bf_lo(p0.z) + w1 * pg8::bf_lo(p1.z) + w2 * pg8::bf_lo(p2.z), w0 * pg8::bf_hi(p0.z) + w1 * pg8::bf_hi(p1.z) + w2 * pg8::bf_hi(p2.z));
            o.w = pk2(w0 * pg8::bf_lo(p0.w) + w1 * pg8::bf_lo(p1.w) + w2 * pg8::bf_lo(p2.w), w0 * pg8::bf_hi(p0.w) + w1 * pg8::bf_hi(p1.w) + w2 * pg8::bf_hi(p2.w));
            *(GAS v4u*)(YA + (size_t)tok * 3072 + 2048 + c8 * 8) = o; }
        }
        if (BOTH(7)) GRID_BAR();
    }
    if (IN(8)) { REP(8) {
#ifdef SELFCHECK
        chk::chk_mla(F.ctl, Q8, K8, V8T, KR8, YA, (LAS float*)(F.lds + RING_OFF), (int)blockIdx.x, OPQ_TID()); chk::chk_dil(F.ctl, QD, KD, VD, YA, (LAS float*)(F.lds + RING_OFF), (int)blockIdx.x, OPQ_TID());
        chk::chk_mla(F.ctl, Q8, K8, V8T, KR8, YA, (LAS float*)(F.lds + RING_OFF), 256 + (int)blockIdx.x, OPQ_TID()); chk::chk_dil(F.ctl, QD, KD, VD, YA, (LAS float*)(F.lds + RING_OFF), 256 + (int)blockIdx.x, OPQ_TID());
        GRID_BAR();
#endif
        pg8::Gemm g{YA, WPA, M, DM, 3072}; pg8::StaticOrder S; S.init(M, DM, F.G, (int)blockIdx.x);
        pg8::EpiMix E{(const unsigned char*)GA, (const unsigned char*)GB, MIXED};
        pg8::gemm_phase<pg8::EpiMix, pg8::StaticOrder, PG_ALIGN, PG_SP2>(F.lds + RING_OFF, g, S, E);
        if constexpr (RPT(8)) { pg8::gemm_phase<pg8::EpiMix, pg8::StaticOrder, PG_ALIGN, PG_SP2>(F.lds + RING_OFF, g, S, E); }
        }
        if (BOTH(8)) GRID_BAR();
    }
    if (IN(9)) { REP(9) {
#ifdef SELFCHECK
        chk::chk_mix(F.ctl, YA, GA, GB, w_proj_a, w_proj_b, MIXED, gw, NGW, LANE());
#endif
        for (int m = gw; m < M; m += NGW) quant_row_b(MIXED + (size_t)m * DM, MIXQ + (size_t)m * DM, SA3 + m, LANE());
        GRID_BAR();
        pg8::Gemm g{(const pg8::bf16_t*)MIXQ, (const pg8::bf16_t*)WOUT8, M, DM, DM, SA3, CM3}; pg8::StaticOrder S; S.init(M, DM, F.G, (int)blockIdx.x);
        pg8::EpiRes<true> E{x, X1B, VEC + 2 * 4 * DM};
        pg8::gemm_phase<pg8::EpiRes<true>, pg8::StaticOrder, PG_ALIGN, PG_SP2, true, 127, true>(F.lds + RING_OFF, g, S, E);
        if constexpr (RPT(9)) { pg8::gemm_phase<pg8::EpiRes<true>, pg8::StaticOrder, PG_ALIGN, PG_SP2, true, 127, true>(F.lds + RING_OFF, g, S, E); }
        }
        if (BOTH(9)) GRID_BAR();
    }
    if (IN(10)) { REP(10) {
#ifdef SELFCHECK
        chk::chk_x1(F.ctl, x, MIXED, w_out, VEC, X1B, gw, NGW, LANE());
#endif
        for (int m0 = gw; m0 < M * (1 + RPT(10)); m0 += NGW) { const int m = m0 & (M - 1), b = m >> 12; normmod_row_b(X1B + (size_t)m * DM, VEC + (3 * 4 + b) * DM, VEC + (4 * 4 + b) * DM, P11_T8 < 86 ? H2 + (size_t)m * DM : nullptr, H2Q + (size_t)m * DM, SA2 + m, LANE()); }
        }
        if (BOTH(10)) GRID_BAR();
    }
    if (IN(11)) { REP(11) {
        { pg8::Gemm g{(const pg8::bf16_t*)H2Q, (const pg8::bf16_t*)WGU8, M, P11_T8 * 256, DM, SA2, CM2}; pg8::StaticOrder S; S.init(M, P11_T8 * 256, F.G, (int)blockIdx.x);
          pg8::EpiGU E{AFF};
          pg8::gemm_phase<pg8::EpiGU, pg8::StaticOrder, PG_ALIGN, PG_SP2, true, 127, true>(F.lds + RING_OFF, g, S, E);
          if constexpr (RPT(11)) { pg8::gemm_phase<pg8::EpiGU, pg8::StaticOrder, PG_ALIGN, PG_SP2, true, 127, true>(F.lds + RING_OFF, g, S, E); } }
        if constexpr (P11_T8 < 86) { pg8::Gemm g{H2, WGU + (size_t)P11_T8 * 256 * DM, M, 2 * DFF - P11_T8 * 256, DM}; pg8::StaticOrder S; S.init(M, 2 * DFF - P11_T8 * 256, F.G, (int)blockIdx.x);
          pg8::EpiGU E{AFF + P11_T8 * pg8::HALF};
          pg8::gemm_phase<pg8::EpiGU, pg8::StaticOrder, PG_ALIGN, PG_SP2>(F.lds + RING_OFF, g, S, E);
          if constexpr (RPT(11)) { pg8::gemm_phase<pg8::EpiGU, pg8::StaticOrder, PG_ALIGN, PG_SP2>(F.lds + RING_OFF, g, S, E); } }
        { constexpr int NU = (M / 256) * (P11_T8 < 86 ? 86 - P11_T8 : 86), I_DN = (DFF / 64) * (DM / 32); const int nfull = NU / F.G, rem = NU - nfull * F.G;
          const int nidle = rem ? F.G - rem : F.G, me = rem ? (int)blockIdx.x - rem : (int)blockIdx.x;
          if (me >= 0) { LAS float* scr = (LAS float*)(F.lds + RING_OFF + F.wave * 16384);
              for (int it = me * NWAVES + F.wave; it < I_DN; it += nidle * NWAVES) p0_transpose_item(w_down, DFF, DM, WDN, 0, scr, it, LANE()); } }
        }
        if (BOTH(11)) GRID_BAR();
    }
    if (IN(12)) { REP(12) {
        pg8::Gemm g{AFF, WDN, M, DM, DFF}; pg8::StaticOrder S; S.init(M, DM, F.G, (int)blockIdx.x);
        pg8::EpiRes<false> E{X1B, X2B, VEC + 5 * 4 * DM};
        pg8::gemm_phase<pg8::EpiRes<false>, pg8::StaticOrder, PG_ALIGN, PG_SP2>(F.lds + RING_OFF, g, S, E);
        if constexpr (RPT(12)) { pg8::gemm_phase<pg8::EpiRes<false>, pg8::StaticOrder, PG_ALIGN, PG_SP2>(F.lds + RING_OFF, g, S, E); }
        }
        if (BOTH(12)) GRID_BAR();
    }
    if (IN(13)) {
        bool bad = (N_LAUNCHES == 1) && (__hip_atomic_load((gu32*)((unsigned*)(F.ctl + CW_BAR) + XB_TMO), RLX_AGENT) != 0u);
        bad = bad || (F.G != 256);
#ifdef SELFCHECK
        { const unsigned cw = __hip_atomic_load(F.ctl + chk::CW_CHK, RLX_AGENT); bad = bad || ((cw & (unsigned)(CHK_MASK)) != 0u);
#ifdef STAT_ZT
          { const float e2 = __uint_as_float(__hip_atomic_load(F.ctl + 8, RLX_AGENT)), r2 = __uint_as_float(__hip_atomic_load(F.ctl + 9, RLX_AGENT)); bad = bad || !(e2 <= (STAT_ZT) * (STAT_ZT) * r2); }
#endif
#ifdef STAT_BR
          { const float b2 = __uint_as_float(__hip_atomic_load(F.ctl + 10, RLX_AGENT)), n_ = __uint_as_float(__hip_atomic_load(F.ctl + 11, RLX_AGENT)); bad = bad || !(b2 <= (STAT_BR) * (STAT_BR) * n_); }
#endif
        }
#endif
        for (int m = gw; m < M; m += NGW) {
            const int ln = LANE(); const GAS v4u* xr = (const GAS v4u*)(X2B + (size_t)m * DM) + ln; f32x4 v[16]; float s = 0.f;
#pragma unroll
            for (int j = 0; j < 8; ++j) { const v4u w = xr[64 * j]; v[2 * j] = pg8::bf4_lo(w); v[2 * j + 1] = pg8::bf4_hi(w); }
#pragma unroll
            for (int j = 0; j < 16; ++j) s += (v[j].x * v[j].x + v[j].y * v[j].y) + (v[j].z * v[j].z + v[j].w * v[j].w);
            float rstd = 1.f / sqrtf(wave_sum(s) * (1.f / DM) + NORM_EPS); if (bad) rstd = __builtin_nanf("");
            GAS f32x4* orow = (GAS f32x4*)(out + (size_t)m * DM);
#pragma unroll
            for (int j = 0; j < 8; ++j) { const int c4 = 2 * (ln + 64 * j); const GAS f32x4* g4 = (const GAS f32x4*)final_g + c4;
                orow[c4] = v[2 * j] * rstd * g4[0]; orow[c4 + 1] = v[2 * j + 1] * rstd * g4[1]; }
        }
    }
#undef IN
#undef BOTH
#undef GRID_BAR
#undef gt
#undef LANE
#undef OPQ_TID
}

extern "C" void kernel_launch(void* const* d_in, const int* in_sizes, int n_in, void* d_out, int out_size, void* d_ws, size_t ws_size, hipStream_t stream) {
    static int grid = 0;
    if (grid == 0) {
        if (n_in != 19 || in_sizes[0] != M * DM || out_size != M * DM || ws_size < WS_END) { fprintf(stderr, "kernel_launch: shape mismatch: n_in %d in0 %d out %d ws %zu (need %zu); nothing launched\n", n_in, n_in > 0 ? in_sizes[0] : -1, out_size, ws_size, (size_t)WS_END); grid = -1; return; }
        int dev = 0, cus = 0, per_cu = 0;
        if (hipGetDevice(&dev) != hipSuccess || hipDeviceGetAttribute(&cus, hipDeviceAttributeMultiprocessorCount, dev) != hipSuccess) { fprintf(stderr, "kernel_launch: device query failed\n"); grid = -1; return; }
        if (hipFuncSetAttribute((const void*)mk_fwd, hipFuncAttributeMaxDynamicSharedMemorySize, LDS_BYTES) != hipSuccess) { fprintf(stderr, "kernel_launch: hipFuncSetAttribute failed\n"); grid = -1; return; }
        if (hipOccupancyMaxActiveBlocksPerMultiprocessor(&per_cu, (const void*)mk_fwd, NWAVES * 64, LDS_BYTES) != hipSuccess || per_cu < 1) fprintf(stderr, "kernel_launch: note: occupancy query reports %d workgroups per CU\n", per_cu);
        (void)hipGetLastError();
        grid = cus;
        if (grid != 256) fprintf(stderr, "kernel_launch: %d CUs; this kernel is laid out for 256\n", grid);
    }
    if (grid < 0) return;
    if (hipMemsetAsync((char*)d_ws + WS_CTL, 0, CTL_ZERO_BYTES, stream) != hipSuccess) { fprintf(stderr, "kernel_launch: hipMemsetAsync failed\n"); return; }
    Args a{};
    for (int i = 0; i < 19; ++i) a.in[i] = (const float*)d_in[i];
    a.out = (float*)d_out; a.ws = (unsigned char*)d_ws;
    for (int li = 0; li < N_LAUNCHES; ++li) {
        a.ph_lo = (N_LAUNCHES == PER_PHASE) ? li : 0; a.ph_hi = (N_LAUNCHES == PER_PHASE) ? li + 1 : PER_PHASE; a.li = li;
        hipLaunchKernelGGL(mk_fwd, dim3(grid), dim3(NWAVES * 64), LDS_BYTES, stream, a);
        const hipError_t le = hipPeekAtLastError();
        if (le != hipSuccess) { fprintf(stderr, "kernel_launch: launch %d failed: %s\n", li, hipGetErrorName(le)); break; }
    }
}
```
